# Optimizing an MI355X kernel written in HIP

```python
import jax, jax.numpy as jnp
from jax import lax
import numpy as np

D_MODEL = 1024
BATCH = 1
SEQ = 16384
DEPTH = 1

CHUNK = 64
MIX_WIDTH = D_MODEL
RWKV_WIDTH = 512
RWKV_HEAD = 64
RWKV_HEADS = RWKV_WIDTH // RWKV_HEAD
DECAY_LORA = 64
AAA_LORA = 64
GATE_LORA = 128
SGU_WIDTH = MIX_WIDTH - RWKV_WIDTH
SGU_GROUPS = 8
SGU_BLOCK = 2 * CHUNK
RWKV_IN = 3 * RWKV_WIDTH + DECAY_LORA + AAA_LORA + GATE_LORA
IN_WIDTH = RWKV_IN + 2 * SGU_WIDTH
MEM_LEN = 256
XA_HEADS = 4
XA_HEAD_DIM = D_MODEL // XA_HEADS
D_FF = ((8 * D_MODEL // 3 + 255) // 256) * 256
RMS_EPS = 1e-6
LN_EPS = 1e-5
LNX_EPS = 64e-5

kernel_name = "hybrid_rwkv7_gmlp_memxattn_block"


def rmsnorm(x, g):
    xf = x.astype(jnp.float32)
    y = xf * lax.rsqrt(jnp.mean(xf * xf, axis=-1, keepdims=True) + RMS_EPS)
    return (y * g.astype(jnp.float32)).astype(x.dtype)


def token_shift(h):
    return jnp.pad(h, ((0, 0), (1, 0), (0, 0)))[:, :-1]


def wkv7_scan(r, w, k, v, kk, a):
    B, T, H, N = r.shape

    def step(S, inp):
        r_t, w_t, k_t, v_t, kk_t, a_t = inp
        sa = jnp.einsum('bhvk,bhk->bhv', S, -kk_t)
        S = (S * w_t[:, :, None, :]
             + sa[..., None] * (kk_t * a_t)[:, :, None, :]
             + v_t[..., None] * k_t[:, :, None, :])
        y = jnp.einsum('bhvk,bhk->bhv', S, r_t)
        return S, y

    xs = tuple(jnp.moveaxis(t, 1, 0) for t in (r, w, k, v, kk, a))
    S0 = jnp.zeros((B, H, N, N), jnp.float32)
    _, ys = lax.scan(step, S0, xs)
    return jnp.moveaxis(ys, 0, 1)


def rwkv7_group(h, shift_mu, w0, w_lora_up, a0, a_lora_up, g_lora_up, k_k, k_a, r_k, lnx_w, lnx_b):
    B, T, _ = h.shape
    f32 = jnp.float32
    h = h + (token_shift(h) - h) * shift_mu
    c = np.cumsum([RWKV_WIDTH, RWKV_WIDTH, RWKV_WIDTH, DECAY_LORA, AAA_LORA])
    r, k, v, wd, ad, gd = jnp.split(h, [int(i) for i in c], axis=-1)
    w_log = -jax.nn.softplus(-(w0 + jnp.tanh(wd) @ w_lora_up).astype(f32)) - 0.5
    decay = jnp.exp(-jnp.exp(w_log))
    a = jax.nn.sigmoid((a0 + ad @ a_lora_up).astype(f32))
    g = (jax.nn.sigmoid(gd) @ g_lora_up).astype(f32)
    heads = lambda t: t.reshape(B, T, RWKV_HEADS, RWKV_HEAD)
    kk = heads((k * k_k).astype(f32))
    kk = kk / jnp.maximum(jnp.sqrt(jnp.sum(kk * kk, axis=-1, keepdims=True)), 1e-12)
    k = k.astype(f32) * (1.0 + (a - 1.0) * k_a.astype(f32))
    rh, kh, vh = heads(r.astype(f32)), heads(k), heads(v.astype(f32))
    y = wkv7_scan(rh, heads(decay), kh, vh, kk, heads(a))
    mu = jnp.mean(y, axis=-1, keepdims=True)
    var = jnp.mean(jnp.square(y - mu), axis=-1, keepdims=True)
    y = ((y - mu) * lax.rsqrt(var + LNX_EPS)).reshape(B, T, RWKV_WIDTH)
    y = y * lnx_w.astype(f32) + lnx_b.astype(f32)
    bonus = (jnp.sum(rh * kh * r_k.astype(f32), axis=-1, keepdims=True) * vh).reshape(B, T, RWKV_WIDTH)
    return ((y + bonus) * g).astype(h.dtype)


def sgu_group(h, ln_w, ln_b, w_spatial, b_spatial):
    B, T, _ = h.shape
    u, v = jnp.split(jax.nn.gelu(h), 2, axis=-1)
    vf = v.astype(jnp.float32)
    mu = jnp.mean(vf, axis=-1, keepdims=True)
    var = jnp.mean(jnp.square(vf - mu), axis=-1, keepdims=True)
    v = ((vf - mu) * lax.rsqrt(var + LN_EPS) * ln_w + ln_b).astype(h.dtype)
    vb = v.reshape(B, T // SGU_BLOCK, SGU_BLOCK, SGU_GROUPS, SGU_WIDTH // SGU_GROUPS)
    mask = jnp.tril(jnp.ones((SGU_BLOCK, SGU_BLOCK), dtype=bool))
    ws = jnp.where(mask[None], w_spatial, jnp.zeros_like(w_spatial))
    mixed = jnp.einsum('gij,bnjgc->bnigc', ws, vb) + b_spatial.T[None, None, :, :, None]
    return u * mixed.reshape(B, T, SGU_WIDTH)


def mem_cross_attn(h, mem, mem_g, wq, wk, wv, wo):
    B, T, _ = h.shape
    m = rmsnorm(mem, mem_g)
    q = (h @ wq).reshape(B, T, XA_HEADS, XA_HEAD_DIM)
    k = (m @ wk).reshape(B, MEM_LEN, XA_HEADS, XA_HEAD_DIM)
    v = (m @ wv).reshape(B, MEM_LEN, XA_HEADS, XA_HEAD_DIM)
    s = jnp.einsum('bshd,bmhd->bhsm', q, k).astype(jnp.float32) * (XA_HEAD_DIM ** -0.5)
    p = jax.nn.softmax(s, axis=-1).astype(v.dtype)
    o = jnp.einsum('bhsm,bmhd->bshd', p, v).reshape(B, T, D_MODEL)
    return o @ wo


def swiglu(h, w_gate, w_up, w_down):
    return (jax.nn.silu(h @ w_gate) * (h @ w_up)) @ w_down


def setup_inputs(seed: int = 0) -> dict:
    key = jax.random.key(seed)
    ks = jax.random.split(key, 32)
    L = DEPTH
    nrm = lambda k, shape, s: jax.random.normal(k, shape, jnp.float32) * s
    gain = lambda k, shape: 1.0 + 0.02 * jax.random.normal(k, shape, jnp.float32)
    return {
        "x": nrm(ks[0], (BATCH, SEQ, D_MODEL), 1.0),
        "mem": nrm(ks[1], (BATCH, MEM_LEN, D_MODEL), 1.0),
        "norm1_g": gain(ks[2], (L, D_MODEL)),
        "w_in": nrm(ks[3], (L, D_MODEL, IN_WIDTH), D_MODEL ** -0.5),
        "shift_mu": jax.random.uniform(ks[4], (L, RWKV_IN), jnp.float32),
        "w0": jax.random.uniform(ks[5], (L, RWKV_WIDTH), jnp.float32, -5.0, 1.0),
        "w_lora_up": nrm(ks[6], (L, DECAY_LORA, RWKV_WIDTH), 0.1 * DECAY_LORA ** -0.5),
        "a0": nrm(ks[7], (L, RWKV_WIDTH), 0.1),
        "a_lora_up": nrm(ks[8], (L, AAA_LORA, RWKV_WIDTH), 0.1 * AAA_LORA ** -0.5),
        "g_lora_up": nrm(ks[9], (L, GATE_LORA, RWKV_WIDTH), GATE_LORA ** -0.5),
        "k_k": 0.85 + 0.05 * jax.random.normal(ks[10], (L, RWKV_WIDTH), jnp.float32),
        "k_a": 1.0 + 0.05 * jax.random.normal(ks[11], (L, RWKV_WIDTH), jnp.float32),
        "r_k": nrm(ks[12], (L, RWKV_HEADS, RWKV_HEAD), 0.1),
        "lnx_w": gain(ks[13], (L, RWKV_WIDTH)),
        "lnx_b": nrm(ks[14], (L, RWKV_WIDTH), 0.02),
        "sgu_ln_w": gain(ks[15], (L, SGU_WIDTH)),
        "sgu_ln_b": nrm(ks[16], (L, SGU_WIDTH), 0.02),
        "w_spatial": nrm(ks[17], (L, SGU_GROUPS, SGU_BLOCK, SGU_BLOCK), SGU_BLOCK ** -0.5),
        "b_spatial": gain(ks[18], (L, SGU_GROUPS, SGU_BLOCK)),
        "w_out": nrm(ks[19], (L, MIX_WIDTH, D_MODEL), MIX_WIDTH ** -0.5),
        "norm2_g": gain(ks[20], (L, D_MODEL)),
        "mem_norm_g": gain(ks[21], (L, D_MODEL)),
        "wq_x": nrm(ks[22], (L, D_MODEL, D_MODEL), D_MODEL ** -0.5),
        "wk_x": nrm(ks[23], (L, D_MODEL, D_MODEL), D_MODEL ** -0.5),
        "wv_x": nrm(ks[24], (L, D_MODEL, D_MODEL), D_MODEL ** -0.5),
        "wo_x": nrm(ks[25], (L, D_MODEL, D_MODEL), D_MODEL ** -0.5),
        "norm3_g": gain(ks[26], (L, D_MODEL)),
        "w_gate": nrm(ks[27], (L, D_MODEL, D_FF), D_MODEL ** -0.5),
        "w_up": nrm(ks[28], (L, D_MODEL, D_FF), D_MODEL ** -0.5),
        "w_down": nrm(ks[29], (L, D_FF, D_MODEL), D_FF ** -0.5),
        "norm_f_g": gain(ks[30], (D_MODEL,)),
    }


def reference(x, mem, norm1_g, w_in, shift_mu, w0, w_lora_up, a0, a_lora_up, g_lora_up,
              k_k, k_a, r_k, lnx_w, lnx_b, sgu_ln_w, sgu_ln_b, w_spatial, b_spatial, w_out,
              norm2_g, mem_norm_g, wq_x, wk_x, wv_x, wo_x, norm3_g, w_gate, w_up, w_down,
              norm_f_g):
    for l in range(DEPTH):
        z = rmsnorm(x, norm1_g[l]) @ w_in[l]
        y_rwkv = rwkv7_group(z[..., :RWKV_IN], shift_mu[l], w0[l], w_lora_up[l], a0[l],
                             a_lora_up[l], g_lora_up[l], k_k[l], k_a[l], r_k[l],
                             lnx_w[l], lnx_b[l])
        y_sgu = sgu_group(z[..., RWKV_IN:], sgu_ln_w[l], sgu_ln_b[l], w_spatial[l], b_spatial[l])
        x = x + jnp.concatenate([y_rwkv, y_sgu], axis=-1) @ w_out[l]
        x = x + mem_cross_attn(rmsnorm(x, norm2_g[l]), mem, mem_norm_g[l],
                               wq_x[l], wk_x[l], wv_x[l], wo_x[l])
        x = x + swiglu(rmsnorm(x, norm3_g[l]), w_gate[l], w_up[l], w_down[l])
    return rmsnorm(x, norm_f_g)
```

```cpp
#include <hip/hip_runtime.h>
#include <hip/hip_cooperative_groups.h>
#include <cstdio>
namespace cg = cooperative_groups;

namespace pg8 {
#define PG8_LAS __attribute__((address_space(3)))
typedef unsigned short bf16_t;
typedef short bf16x8 __attribute__((ext_vector_type(8)));
typedef float f32x4 __attribute__((ext_vector_type(4)));
typedef unsigned u32x4 __attribute__((ext_vector_type(4)));
constexpr int BM = 256, BK = 64, HALF = 128, HTB = HALF * BK * 2  , STAGE_BYTES = 8 * HTB, NXCD = 8, WGM = 8;

__host__ __device__ __forceinline__ int lds_byte(int r, int c) { const int st = (r >> 4) * 2 + (c >> 5), rr = r & 15, cc = c & 31, ob = rr * 64 + cc * 2; return st * 1024 + (ob ^ (((ob >> 9) & 1) << 5)); }
__host__ __device__ __forceinline__ void stage_rc(int b, int& R, int& C) { const int st = b / 1024, sb = b % 1024, swz = sb ^ (((sb >> 9) & 1) << 5); R = (st >> 1) * 16 + swz / 64; C = (st & 1) * 32 + (swz % 64) / 2; }
__host__ __device__ __forceinline__ int perm32(int rho) { const int n = rho >> 4, i = rho & 15; return 8 * (i >> 2) + 4 * n + (i & 3); }

struct Unit { int pm, pn; };
struct Gemm { const bf16_t* A; const bf16_t* Bt; int M, N, K; };

struct StaticOrder {
    int nM, nN, nwg, G, c;
    __host__ __device__ void init(int M, int N, int G_, int c_) { nM = M / BM; nN = N / BM; nwg = nM * nN; G = G_; c = c_; }
    __host__ __device__ bool next(int i, Unit& u) const {
        const long L = (long)i * G + c; if (L >= nwg) return false;
        int wgid = (int)L; { const int q = nwg / NXCD, r = nwg % NXCD, xcd = wgid % NXCD, off = wgid / NXCD; wgid = (xcd < r ? xcd * (q + 1) : r * (q + 1) + (xcd - r) * q) + off; }
        const int nig = WGM * nN, gid = wgid / nig, fm = gid * WGM, gsz = (nM - fm) < WGM ? (nM - fm) : WGM;
        u.pm = fm + ((wgid % nig) % gsz); u.pn = (wgid % nig) / gsz; return true;
    }
    __device__ __forceinline__ void a_ready(const Unit&) const {}
    __device__ __forceinline__ void done(const Unit&) const {}
};
__device__ __forceinline__ unsigned cvt_pk_bf16(float lo, float hi) { unsigned r; asm volatile("v_cvt_pk_bf16_f32 %0, %1, %2" : "=v"(r) : "v"(lo), "v"(hi)); return r; }
typedef float f32x2 __attribute__((ext_vector_type(2)));
__device__ __forceinline__ f32x2 gelu_pk(f32x2 v) {
    const f32x2 av = __builtin_elementwise_abs(v), d = av * 0.2316418882f + 1.0f;
    f32x2 t; t.x = __builtin_amdgcn_rcpf(d.x); t.y = __builtin_amdgcn_rcpf(d.y);
    f32x2 q = t * 0.5307027145f + (-0.7265760135f); q = q * t + 0.7107068705f; q = q * t + (-0.142248368f); q = q * t + 0.127414796f; q = q * t;
    const f32x2 s = (v * v) * (-0.72134752044f);
    f32x2 e; e.x = __builtin_amdgcn_exp2f(s.x); e.y = __builtin_amdgcn_exp2f(s.y);
    const f32x2 m = v * (q * e), r = v - m;
    f32x2 o; o.x = v.x < 0.f ? m.x : r.x; o.y = v.y < 0.f ? m.y : r.y; return o;
}

template <class Epi, class Sched, bool STAMP = false>
__device__ __forceinline__ void gemm_phase(PG8_LAS unsigned char* lds, const Gemm g, const Sched& S, const Epi& E, unsigned long long* stamps) {
    const int tid = threadIdx.x, wid = __builtin_amdgcn_readfirstlane(tid >> 6), lane = tid & 63, wr = wid >> 2, wc = wid & 3, fr = lane & 15, fq = lane >> 4;
    const int K = g.K, nt = K / BK;
    int ts_lo = 0, ts_hi = 0, nts = 0; const unsigned long long rt_entry = STAMP ? (unsigned long long)wall_clock64() : 0ull;
#define PG8_STAMP() do { if (STAMP && wid == 0 && nts < 64) { const unsigned long long _c = (unsigned long long)clock64(); \
        ts_lo = (lane == nts) ? (int)(unsigned)_c : ts_lo; ts_hi = (lane == nts) ? (int)(unsigned)(_c >> 32) : ts_hi; ++nts; } } while (0)
    PG8_STAMP();
    unsigned voffA[2], voffB[2];
#pragma unroll
    for (int i = 0; i < 2; ++i) { int R, C; stage_rc(tid * 16 + i * 8192, R, C); const int Rb = Epi::PERM ? ((R & ~31) + perm32(R & 31)) : R;
        voffA[i] = (unsigned)(R * K + C) * 2u; voffB[i] = (unsigned)(Rb * K + C) * 2u; }
    const size_t kstep = (size_t)(BK * 2);
    const size_t hstep = (size_t)HALF * K * 2;
    const size_t tstep = 2 * hstep;
    const unsigned ldsw = (unsigned)wid * 1024u;
    const int aoff = lds_byte(wr * 64 + fr, fq * 8), boff = lds_byte(wc * 32 + fr, fq * 8);
#define PG8_SA(b, h) (((b) * 2 + (h)) * HTB)
#define PG8_SB(b, h) ((4 + (b) * 2 + (h)) * HTB)
#define PG8_STAGE(bufoff, gbase, voff) do { _Pragma("unroll") for (int _i = 0; _i < 2; ++_i) \
        __builtin_amdgcn_global_load_lds((const unsigned*)((const char*)(gbase) + (voff)[_i]), (PG8_LAS unsigned*)(lds + (bufoff) + ldsw + _i * 8192), 16, 0, 0); } while (0)
#define PG8_LDA(dst, b, h) do { _Pragma("unroll") for (int m = 0; m < 4; ++m) _Pragma("unroll") for (int k = 0; k < 2; ++k) dst[m][k] = *(const PG8_LAS bf16x8*)(lds + PG8_SA(b, h) + aoff + m * 2048 + k * 1024); } while (0)
#define PG8_LDB(dst, b, h) do { _Pragma("unroll") for (int n = 0; n < 2; ++n) _Pragma("unroll") for (int k = 0; k < 2; ++k) dst[n][k] = *(const PG8_LAS bf16x8*)(lds + PG8_SB(b, h) + boff + n * 2048 + k * 1024); } while (0)
#define PG8_MMA(ai, bj, At, Bt) do { __builtin_amdgcn_s_setprio(1); _Pragma("unroll") for (int m = 0; m < 4; ++m) _Pragma("unroll") for (int n = 0; n < 2; ++n) _Pragma("unroll") for (int k = 0; k < 2; ++k) \
        acc[ai][bj][m][n] = __builtin_amdgcn_mfma_f32_16x16x32_bf16(Bt[n][k], At[m][k], acc[ai][bj][m][n], 0, 0, 0); __builtin_amdgcn_s_setprio(0); } while (0)
#define PG8_WAIT_V(n) asm volatile("s_waitcnt vmcnt(" #n ")" ::: "memory")
#define PG8_WAIT_L(n) asm volatile("s_waitcnt lgkmcnt(" #n ")" ::: "memory")
#define PG8_BAR __builtin_amdgcn_s_barrier()
#define PG8_SCHED __builtin_amdgcn_sched_barrier(0)
    Unit cur, nxt; int ui = 0;
    if (!S.next(0, cur)) return;
    f32x4 acc[2][2][4][2];
#pragma unroll
    for (int a = 0; a < 2; ++a)
#pragma unroll
        for (int b = 0; b < 2; ++b)
#pragma unroll
            for (int m = 0; m < 4; ++m)
#pragma unroll
                for (int n = 0; n < 2; ++n) acc[a][b][m][n] = (f32x4){0.f, 0.f, 0.f, 0.f};
    bf16x8 At[4][2], B0[2][2], B1[2][2];
    const char* cA = (const char*)g.A + (size_t)cur.pm * tstep; const char* cB = (const char*)g.Bt + (size_t)cur.pn * tstep;
    S.a_ready(cur);
    PG8_STAGE(PG8_SB(0, 0), cB, voffB); PG8_STAGE(PG8_SA(0, 0), cA, voffA); PG8_STAGE(PG8_SB(0, 1), cB + hstep, voffB); PG8_STAGE(PG8_SA(0, 1), cA + hstep, voffA);
    if (wr == 1) PG8_BAR;
    PG8_WAIT_V(4); PG8_BAR;
    PG8_STAGE(PG8_SB(1, 0), cB + kstep, voffB); PG8_STAGE(PG8_SA(1, 0), cA + kstep, voffA); PG8_STAGE(PG8_SB(1, 1), cB + hstep + kstep, voffB);
    PG8_WAIT_V(6); PG8_BAR;
    PG8_STAMP();
    for (;;) {
        const bool has_next = S.next(ui + 1, nxt);
        const char* nA = has_next ? (const char*)g.A + (size_t)nxt.pm * tstep : cA; const char* nB = has_next ? (const char*)g.Bt + (size_t)nxt.pn * tstep : cB;
        for (int t = 0; t < nt; t += 2) {
            const bool last = (t == nt - 2);
            const char* a1 = cA + (size_t)(t + 1) * kstep;
            const char* a2 = last ? nA : cA + (size_t)(t + 2) * kstep; const char* b2 = last ? nB : cB + (size_t)(t + 2) * kstep;
            const char* a3 = a2 + kstep; const char* b3 = b2 + kstep;
            if (last && has_next) S.a_ready(nxt);
            PG8_LDB(B0, 0, 0); PG8_SCHED; PG8_LDA(At, 0, 0); PG8_STAGE(PG8_SA(1, 1), a1 + hstep, voffA);
            PG8_WAIT_L(8); PG8_BAR; PG8_WAIT_L(0); PG8_MMA(0, 0, At, B0); PG8_BAR; PG8_SCHED;
            PG8_LDB(B1, 0, 1); PG8_STAGE(PG8_SB(0, 0), b2, voffB);
            PG8_BAR; PG8_WAIT_L(0); PG8_MMA(0, 1, At, B1); PG8_BAR;
            PG8_LDA(At, 0, 1); PG8_STAGE(PG8_SA(0, 0), a2, voffA);
            PG8_BAR; PG8_WAIT_L(0); PG8_MMA(1, 0, At, B0); PG8_BAR; PG8_SCHED;
            PG8_STAGE(PG8_SB(0, 1), b2 + hstep, voffB);
            PG8_WAIT_V(6); PG8_BAR; PG8_MMA(1, 1, At, B1); PG8_BAR;
            PG8_LDB(B0, 1, 0); PG8_SCHED; PG8_LDA(At, 1, 0); PG8_STAGE(PG8_SA(0, 1), a2 + hstep, voffA);
            PG8_WAIT_L(8); PG8_BAR; PG8_WAIT_L(0); PG8_MMA(0, 0, At, B0); PG8_BAR; PG8_SCHED;
            PG8_LDB(B1, 1, 1); PG8_STAGE(PG8_SB(1, 0), b3, voffB);
            PG8_BAR; PG8_WAIT_L(0); PG8_MMA(0, 1, At, B1); PG8_BAR;
            PG8_LDA(At, 1, 1); PG8_STAGE(PG8_SA(1, 0), a3, voffA);
            PG8_BAR; PG8_WAIT_L(0); PG8_MMA(1, 0, At, B0); PG8_BAR; PG8_SCHED;
            PG8_STAGE(PG8_SB(1, 1), b3 + hstep, voffB);
            PG8_WAIT_V(6); PG8_BAR; PG8_MMA(1, 1, At, B1); PG8_BAR;
        }
        PG8_STAMP();
        if constexpr (!Epi::AFTER_DRAIN) { E(acc, cur, wr, wc, fr, fq); S.done(cur); }
        PG8_STAMP();
        if (!has_next) break;
#pragma unroll
        for (int a = 0; a < 2; ++a)
#pragma unroll
            for (int b = 0; b < 2; ++b)
#pragma unroll
                for (int m = 0; m < 4; ++m)
#pragma unroll
                    for (int n = 0; n < 2; ++n) acc[a][b][m][n] = (f32x4){0.f, 0.f, 0.f, 0.f};
        cur = nxt; cA = nA; cB = nB; ++ui;
    }
    PG8_WAIT_V(0);
    if (wr == 0) PG8_BAR;
    PG8_BAR;
    if constexpr (Epi::AFTER_DRAIN) { E.fused(acc, cur, wr, wc, fr, fq, lds, wid, lane); S.done(cur); }
    PG8_STAMP();
    if (STAMP && wid == 0) { stamps[lane] = lane < nts ? (((unsigned long long)(unsigned)ts_hi << 32) | (unsigned)ts_lo) : 0ull;
        if (lane == 62) stamps[62] = rt_entry; if (lane == 63) stamps[63] = (unsigned long long)wall_clock64(); }
#undef PG8_STAMP
#undef PG8_SA
#undef PG8_SB
#undef PG8_STAGE
#undef PG8_LDA
#undef PG8_LDB
#undef PG8_MMA
#undef PG8_WAIT_V
#undef PG8_WAIT_L
#undef PG8_BAR
#undef PG8_SCHED
}
}

using pg8::bf16x8; using pg8::f32x4; using pg8::u32x4; using pg8::Unit;
typedef unsigned short bf16;
typedef unsigned u32x2 __attribute__((ext_vector_type(2)));
typedef float f32x2 __attribute__((ext_vector_type(2)));
#define LAS __attribute__((address_space(3)))
#define DI __device__ __forceinline__
constexpr int T = 16384, D = 1024, NIN = 2816, RIN = 1792, RW = 512, FF = 2816, MEM = 256;
constexpr int NWAVES = 8, NTHR = 512;
constexpr int LCH = 256, NC = T / LCH;
constexpr float RMS_EPS = 1e-6f;
constexpr size_t MiB = (size_t)1 << 20, KiB = 1024;
constexpr size_t WS_CTL = 0, CTL_BYTES = 1 * MiB;
constexpr size_t WS_WIN = 2 * MiB, WS_WOUT = WS_WIN + (size_t)NIN * D * 2, WS_WQ = WS_WOUT + 2 * MiB, WS_WK = WS_WQ + 2 * MiB, WS_WV = WS_WK + 2 * MiB,
                 WS_WO = WS_WV + 2 * MiB, WS_WGU = WS_WO + 2 * MiB, WS_WD = WS_WGU + (size_t)2 * FF * D * 2;
constexpr size_t WS_XB = 34 * MiB;
constexpr size_t WS_R = WS_XB, WS_V = WS_XB + 16 * MiB;
constexpr size_t WS_ZR = 66 * MiB;
constexpr size_t WS_PT = WS_ZR, WS_SLOC = WS_ZR + 8 * MiB, WS_SST = WS_ZR + 16 * MiB;
constexpr size_t WS_Q = WS_ZR, WS_HFF = WS_ZR;
constexpr size_t WS_SU = 122 * MiB;
constexpr size_t WS_OB = WS_SU;
constexpr size_t WS_MIX = 154 * MiB;
constexpr size_t WS_B = 186 * MiB;
constexpr size_t WS_KP = 218 * MiB;
constexpr size_t WS_G = 234 * MiB;
constexpr size_t WS_MB = 251 * MiB, WS_KB = WS_MB + 512 * KiB, WS_VT = WS_KB + 512 * KiB, WS_WSB = WS_VT + 512 * KiB, WS_WLT = WS_WSB + 256 * KiB,
                 WS_ALT = WS_WLT + 64 * KiB, WS_GLT = WS_ALT + 64 * KiB, WS_RS0 = WS_GLT + 128 * KiB, WS_BON = WS_RS0 + 256 * KiB, WS_END = WS_BON + 512 * KiB;
static_assert(WS_WD + (size_t)D * FF * 2 <= WS_XB && WS_END <= 256 * MiB, "ws map");
constexpr int LDS_BYTES = 147456;

DI float bf2f(unsigned b) { return __uint_as_float(b << 16); }
DI float bflo(unsigned w) { return __uint_as_float(w << 16); }
DI float bfhi(unsigned w) { return __uint_as_float(w & 0xffff0000u); }
DI unsigned pk2(float lo, float hi) { return pg8::cvt_pk_bf16(lo, hi); }
DI float wave_sum(float v) {
#pragma unroll
    for (int o = 1; o < 64; o <<= 1) v += __shfl_xor(v, o);
    return v; }
DI float sigmoidf_(float x) { return __builtin_amdgcn_rcpf(1.0f + __expf(-x)); }
DI float gelu_tanh(float v) { const float u2 = 1.5957691216f * (v + 0.044715f * v * v * v); return v * __builtin_amdgcn_rcpf(1.0f + __expf(-u2)); }
#define LDS_FENCE() asm volatile("s_waitcnt lgkmcnt(0)" ::: "memory")
#define MFMA16(a, b, c) __builtin_amdgcn_mfma_f32_16x16x32_bf16((a), (b), (c), 0, 0, 0)

struct Frame {
    unsigned char* lds; int tid, lane, wid, bid, G;
    const float* in[31]; float* out; unsigned char* ws;
};

struct EpiZ {
    static constexpr bool PERM = true, AFTER_DRAIN = false;
    bf16* zr; bf16* su; const float* rs0; float* sg1; float* sg2;
    DI void operator()(const f32x4 (&acc)[2][2][4][2], const Unit& u, int wr, int wc, int fr, int fq) const {
        const int row0 = u.pm * 256 + wr * 64 + fr; const bool isr = u.pn < 7, st = u.pn >= 9;
        bf16* base = isr ? zr : su; const int ldc = isr ? RIN : 1024; const int col0 = (isr ? u.pn : u.pn - 7) * 256 + wc * 32 + 8 * fq;
#pragma unroll
        for (int ai = 0; ai < 2; ++ai)
#pragma unroll
            for (int m = 0; m < 4; ++m) { const int r = row0 + ai * 128 + m * 16; const float rs = rs0[r]; bf16* rowp = base + (size_t)r * ldc + col0; float s1 = 0.f, s2 = 0.f;
#pragma unroll
                for (int bj = 0; bj < 2; ++bj) { f32x4 v0 = acc[ai][bj][m][0] * rs, v1 = acc[ai][bj][m][1] * rs;
                    if (!isr) {
#pragma unroll
                        for (int j = 0; j < 4; ++j) { v0[j] = gelu_tanh(v0[j]); v1[j] = gelu_tanh(v1[j]); }
#pragma unroll
                        for (int j = 0; j < 4; ++j) { s1 += v0[j] + v1[j]; s2 += v0[j] * v0[j] + v1[j] * v1[j]; } }
                    u32x4 w; w.x = pk2(v0[0], v0[1]); w.y = pk2(v0[2], v0[3]); w.z = pk2(v1[0], v1[1]); w.w = pk2(v1[2], v1[3]);
                    *(u32x4*)(rowp + bj * 128) = w; }
                if (st) { s1 += __shfl_xor(s1, 16); s1 += __shfl_xor(s1, 32); s2 += __shfl_xor(s2, 16); s2 += __shfl_xor(s2, 32);
                    if (fq == 0) { atomicAdd(sg1 + r, s1); atomicAdd(sg2 + r, s2); } } }
    }
};
struct EpiBf {
    static constexpr bool PERM = true, AFTER_DRAIN = false;
    bf16* O; int ldc; const float* ss;
    DI void operator()(const f32x4 (&acc)[2][2][4][2], const Unit& u, int wr, int wc, int fr, int fq) const {
        const int row0 = u.pm * 256 + wr * 64 + fr, col0 = u.pn * 256 + wc * 32 + 8 * fq;
#pragma unroll
        for (int ai = 0; ai < 2; ++ai)
#pragma unroll
            for (int m = 0; m < 4; ++m) { const int r = row0 + ai * 128 + m * 16; const float rs = ss ? rsqrtf(ss[r] * (1.0f / D) + RMS_EPS) : 1.0f; bf16* rowp = O + (size_t)r * ldc + col0;
#pragma unroll
                for (int bj = 0; bj < 2; ++bj) { const f32x4 v0 = acc[ai][bj][m][0] * rs, v1 = acc[ai][bj][m][1] * rs;
                    u32x4 w; w.x = pk2(v0[0], v0[1]); w.y = pk2(v0[2], v0[3]); w.z = pk2(v1[0], v1[1]); w.w = pk2(v1[2], v1[3]);
                    *(u32x4*)(rowp + bj * 128) = w; } }
    }
};
struct EpiRes {
    static constexpr bool PERM = false, AFTER_DRAIN = false;
    const float* base; float* out; bf16* xb; float* ss;
    DI void operator()(const f32x4 (&acc)[2][2][4][2], const Unit& u, int wr, int wc, int fr, int fq) const {
        const int row0 = u.pm * 256 + wr * 64 + fr, col0 = u.pn * 256 + wc * 32 + 4 * fq;
#pragma unroll
        for (int ai = 0; ai < 2; ++ai)
#pragma unroll
            for (int m = 0; m < 4; ++m) { const int r = row0 + ai * 128 + m * 16; const size_t off = (size_t)r * D + col0; float s2 = 0.f;
#pragma unroll
                for (int bj = 0; bj < 2; ++bj)
#pragma unroll
                    for (int n = 0; n < 2; ++n) { const f32x4 o = *(const f32x4*)(base + off + bj * 128 + n * 16) + acc[ai][bj][m][n];
                        *(f32x4*)(out + off + bj * 128 + n * 16) = o; s2 += (o[0] * o[0] + o[1] * o[1]) + (o[2] * o[2] + o[3] * o[3]);
                        if (xb) { u32x2 w; w.x = pk2(o[0], o[1]); w.y = pk2(o[2], o[3]); *(u32x2*)(xb + off + bj * 128 + n * 16) = w; } }
                s2 += __shfl_xor(s2, 16); s2 += __shfl_xor(s2, 32);
                if (fq == 0) atomicAdd(ss + r, s2);
                asm volatile("" ::: "memory"); }
    }
};
struct EpiSwi {
    static constexpr bool PERM = true, AFTER_DRAIN = false;
    bf16* H; const float* ss;
    DI void operator()(const f32x4 (&acc)[2][2][4][2], const Unit& u, int wr, int wc, int fr, int fq) const {
        const int row0 = u.pm * 256 + wr * 64 + fr, col0 = u.pn * 128 + wc * 32 + 8 * fq;
#pragma unroll
        for (int ai = 0; ai < 2; ++ai)
#pragma unroll
            for (int m = 0; m < 4; ++m) { const int r = row0 + ai * 128 + m * 16; const float rs = rsqrtf(ss[r] * (1.0f / D) + RMS_EPS); float h[8];
#pragma unroll
                for (int n = 0; n < 2; ++n)
#pragma unroll
                    for (int j = 0; j < 4; ++j) { const float g = acc[ai][0][m][n][j] * rs, up = acc[ai][1][m][n][j] * rs; h[4 * n + j] = g * up * sigmoidf_(g); }
                u32x4 w; w.x = pk2(h[0], h[1]); w.y = pk2(h[2], h[3]); w.z = pk2(h[4], h[5]); w.w = pk2(h[6], h[7]);
                *(u32x4*)(H + (size_t)r * FF + col0) = w; }
    }
};
struct FewOrder {
    int pm, pn; bool has;
    DI bool next(int i, Unit& u) const { if (i != 0 || !has) return false; u.pm = pm; u.pn = pn; return true; }
    DI void a_ready(const Unit&) const {}
    DI void done(const Unit&) const {}
};

DI void p0_transpose_item(const float* W, int K, int N, const float* kscale, bf16* WT, int drow0, float* scr, int kb, int nb, int lane) {
    const int k0 = 64 * kb, n0 = 32 * nb;
#pragma unroll 8
    for (int i = 0; i < 32; ++i) { const int kk = 2 * i + (lane >> 5); float v = W[(size_t)(k0 + kk) * N + n0 + (lane & 31)]; if (kscale) v *= kscale[k0 + kk]; scr[kk * 33 + (lane & 31)] = v; }
    LDS_FENCE();
    const int c = lane & 7;
#pragma unroll
    for (int j = 0; j < 4; ++j) { const int n = (lane >> 3) + 8 * j; const float* s = scr + (8 * c) * 33 + n;
        u32x4 o; o.x = pk2(s[0 * 33], s[1 * 33]); o.y = pk2(s[2 * 33], s[3 * 33]); o.z = pk2(s[4 * 33], s[5 * 33]); o.w = pk2(s[6 * 33], s[7 * 33]);
        *(u32x4*)(WT + (size_t)(drow0 + n) * K + k0 + 8 * c) = o; }
    LDS_FENCE();
}
DI void p0_prologue(Frame& F) {
    float* scr = (float*)(F.lds + F.wid * 16384);
    const int gw = F.bid * NWAVES + F.wid, NGW = F.G * NWAVES, lane = F.lane;
    unsigned char* ws = F.ws;
    constexpr int I_IN = (D / 64) * (NIN / 32), I_SQ = (D / 64) * (D / 32), I_FF = (D / 64) * (FF / 32), I_DN = (FF / 64) * (D / 32), I_L64 = 1 * (RW / 32), I_L128 = 2 * (RW / 32);
    constexpr int NITEMS = I_IN + 5 * I_SQ + 2 * I_FF + I_DN + 2 * I_L64 + I_L128;
    for (int it = gw; it < NITEMS; it += NGW) {
        int r = it;
#define TR(Wp, K_, N_, SC, DST, DROW) { constexpr int ni_ = ((K_) / 64) * ((N_) / 32); if (r < ni_) { const int kb = r / ((N_) / 32), nb = r % ((N_) / 32); const int n0 = nb * 32; (void)n0; \
            p0_transpose_item((Wp), (K_), (N_), (SC), (bf16*)(ws + (DST)), (DROW), scr, kb, nb, lane); continue; } r -= ni_; }
        TR(F.in[3], D, NIN, F.in[2], WS_WIN, n0)
        TR(F.in[19], D, D, (const float*)nullptr, WS_WOUT, n0)
        TR(F.in[22], D, D, F.in[20], WS_WQ, n0)
        TR(F.in[23], D, D, (const float*)nullptr, WS_WK, n0)
        TR(F.in[24], D, D, (const float*)nullptr, WS_WV, n0)
        TR(F.in[25], D, D, (const float*)nullptr, WS_WO, n0)
        TR(F.in[27], D, FF, F.in[26], WS_WGU, (n0 / 128) * 256 + (n0 % 128))
        TR(F.in[28], D, FF, F.in[26], WS_WGU, (n0 / 128) * 256 + 128 + (n0 % 128))
        TR(F.in[29], FF, D, (const float*)nullptr, WS_WD, n0)
        TR(F.in[6], 64, RW, (const float*)nullptr, WS_WLT, n0)
        TR(F.in[8], 64, RW, (const float*)nullptr, WS_ALT, n0)
        TR(F.in[9], 128, RW, (const float*)nullptr, WS_GLT, n0)
#undef TR
    }
    const float* x = F.in[0]; bf16* xb = (bf16*)(ws + WS_XB); float* rs0 = (float*)(ws + WS_RS0);
    for (int m = gw; m < T; m += NGW) {
        const f32x4* xr = (const f32x4*)(x + (size_t)m * D) + lane; f32x4 v[4]; float s = 0.f;
#pragma unroll
        for (int j = 0; j < 4; ++j) { v[j] = xr[64 * j]; s += (v[j][0] * v[j][0] + v[j][1] * v[j][1]) + (v[j][2] * v[j][2] + v[j][3] * v[j][3]); }
        s = wave_sum(s);
        if (lane == 0) rs0[m] = rsqrtf(s * (1.0f / D) + RMS_EPS);
        u32x2* o8 = (u32x2*)(xb + (size_t)m * D) + lane;
#pragma unroll
        for (int j = 0; j < 4; ++j) { u32x2 w; w.x = pk2(v[j][0], v[j][1]); w.y = pk2(v[j][2], v[j][3]); o8[64 * j] = w; }
    }
    const float* mem = F.in[1]; const float* mg = F.in[21]; bf16* mb = (bf16*)(ws + WS_MB);
    for (int m = gw; m < MEM; m += NGW) {
        const f32x4* xr = (const f32x4*)(mem + (size_t)m * D) + lane; f32x4 v[4]; float s = 0.f;
#pragma unroll
        for (int j = 0; j < 4; ++j) { v[j] = xr[64 * j]; s += (v[j][0] * v[j][0] + v[j][1] * v[j][1]) + (v[j][2] * v[j][2] + v[j][3] * v[j][3]); }
        s = wave_sum(s); const float rs = rsqrtf(s * (1.0f / D) + RMS_EPS);
        u32x2* o8 = (u32x2*)(mb + (size_t)m * D) + lane;
#pragma unroll
        for (int j = 0; j < 4; ++j) { const f32x4 g = ((const f32x4*)mg)[lane + 64 * j]; u32x2 w; w.x = pk2(v[j][0] * rs * g[0], v[j][1] * rs * g[1]); w.y = pk2(v[j][2] * rs * g[2], v[j][3] * rs * g[3]); o8[64 * j] = w; }
    }
    const float* wsp = F.in[17]; bf16* wsb = (bf16*)(ws + WS_WSB);
    for (int e = F.bid * NTHR + F.tid; e < 8 * 128 * 128; e += F.G * NTHR) { const int i = (e >> 7) & 127, j = e & 127; wsb[e] = (bf16)(pk2(j <= i ? wsp[e] : 0.f, 0.f) & 0xffffu); }
}

DI f32x4 load_shift4(const bf16* zrow, int col, int t, const float* mu) {
    const u32x2 a = *(const u32x2*)(zrow + col); u32x2 p = (u32x2){0u, 0u}; if (t > 0) p = *(const u32x2*)(zrow - RIN + col);
    const f32x4 m4 = *(const f32x4*)(mu + col); const f32x4 z = (f32x4){bflo(a.x), bfhi(a.x), bflo(a.y), bfhi(a.y)}, pz = (f32x4){bflo(p.x), bfhi(p.x), bflo(p.y), bfhi(p.y)};
    return z + (pz - z) * m4; }
DI void prep_phase(Frame& F) {
    unsigned char* ws = F.ws; const int tid = F.tid, lane = F.lane, h = F.wid, fr = lane & 15, fq = lane >> 4;
    const bf16* zr = (const bf16*)(ws + WS_ZR); const float* mu = F.in[4];
    const bf16* WlT = (const bf16*)(ws + WS_WLT); const bf16* AlT = (const bf16*)(ws + WS_ALT); const bf16* GlT = (const bf16*)(ws + WS_GLT);
    const float *w0 = F.in[5], *a0 = F.in[7], *k_k = F.in[10], *k_a = F.in[11], *r_k = F.in[12];
    float* Wd = F.out; float* KK = F.out + (size_t)T * RW; float* Bb = (float*)(ws + WS_B);
    bf16* Rb = (bf16*)(ws + WS_R); bf16* Vb = (bf16*)(ws + WS_V); bf16* KPb = (bf16*)(ws + WS_KP); bf16* Gb = (bf16*)(ws + WS_G); float* bonus = (float*)(ws + WS_BON);
    unsigned char* AL = F.lds;
    for (int tile = F.bid; tile < T / 64; tile += F.G) {
        const int t0 = tile * 64;
        __syncthreads();
        { const int tk = tid >> 3, cs = (tid & 7) * 32, t = t0 + tk, kind = cs < 64 ? 0 : (cs < 128 ? 1 : 2);
          const bf16* zrow = zr + (size_t)t * RIN + 1536 + cs;
#pragma unroll
          for (int q = 0; q < 4; ++q) { const u32x4 a = *(const u32x4*)(zrow + 8 * q); u32x4 p = (u32x4){0u, 0u, 0u, 0u}; if (t > 0) p = *(const u32x4*)(zrow - RIN + 8 * q);
              float o[8];
#pragma unroll
              for (int e2 = 0; e2 < 4; ++e2) { const float z0 = bflo(a[e2]), z1 = bfhi(a[e2]), p0 = bflo(p[e2]), p1 = bfhi(p[e2]);
                  const float m0 = mu[1536 + cs + 8 * q + 2 * e2], m1 = mu[1536 + cs + 8 * q + 2 * e2 + 1];
                  float h0 = z0 + (p0 - z0) * m0, h1 = z1 + (p1 - z1) * m1;
                  if (kind == 0) { h0 = 1.0f - 2.0f * __builtin_amdgcn_rcpf(1.0f + __expf(2.0f * h0)); h1 = 1.0f - 2.0f * __builtin_amdgcn_rcpf(1.0f + __expf(2.0f * h1)); }
                  if (kind == 2) { h0 = sigmoidf_(h0); h1 = sigmoidf_(h1); }
                  o[2 * e2] = h0; o[2 * e2 + 1] = h1; }
              u32x4 w; w.x = pk2(o[0], o[1]); w.y = pk2(o[2], o[3]); w.z = pk2(o[4], o[5]); w.w = pk2(o[6], o[7]);
              *(u32x4*)(AL + tk * 528 + (cs + 8 * q) * 2) = w; } }
        __syncthreads();
#pragma unroll 1
        for (int mt = 0; mt < 4; ++mt) {
            f32x4 aw[4], aa[4], ag[4];
#pragma unroll
            for (int nt = 0; nt < 4; ++nt) { aw[nt] = (f32x4){0.f, 0.f, 0.f, 0.f}; aa[nt] = aw[nt]; ag[nt] = aw[nt]; }
            const unsigned char* arow = AL + (16 * mt + fr) * 528 + 16 * fq;
#pragma unroll
            for (int ks = 0; ks < 2; ++ks) { const bf16x8 af = *(const bf16x8*)(arow + 64 * ks), af2 = *(const bf16x8*)(arow + 128 + 64 * ks);
#pragma unroll
                for (int nt = 0; nt < 4; ++nt) { const int n = 64 * h + 16 * nt + fr;
                    aw[nt] = MFMA16(*(const bf16x8*)(WlT + n * 64 + 32 * ks + 8 * fq), af, aw[nt]);
                    aa[nt] = MFMA16(*(const bf16x8*)(AlT + n * 64 + 32 * ks + 8 * fq), af2, aa[nt]); } }
#pragma unroll
            for (int ks = 0; ks < 4; ++ks) { const bf16x8 af = *(const bf16x8*)(arow + 256 + 64 * ks);
#pragma unroll
                for (int nt = 0; nt < 4; ++nt) { const int n = 64 * h + 16 * nt + fr; ag[nt] = MFMA16(*(const bf16x8*)(GlT + n * 128 + 32 * ks + 8 * fq), af, ag[nt]); } }
            const int t = t0 + 16 * mt + fr; const bf16* zrow = zr + (size_t)t * RIN;
            float kx[4][4]; float ssq = 0.f;
#pragma unroll
            for (int nt = 0; nt < 4; ++nt) { const int c = 64 * h + 16 * nt + 4 * fq; const f32x4 k4 = load_shift4(zrow, 512 + c, t, mu); const f32x4 kk4 = *(const f32x4*)(k_k + c);
#pragma unroll
                for (int e = 0; e < 4; ++e) { kx[nt][e] = k4[e]; const float q = k4[e] * kk4[e]; ssq += q * q; } }
            ssq += __shfl_xor(ssq, 16); ssq += __shfl_xor(ssq, 32);
            const float inv = 1.0f / fmaxf(sqrtf(ssq), 1e-12f); float bon = 0.f;
#pragma unroll
            for (int nt = 0; nt < 4; ++nt) { const int c = 64 * h + 16 * nt + 4 * fq; const size_t o = (size_t)t * RW + c;
                const f32x4 r4 = load_shift4(zrow, c, t, mu), v4 = load_shift4(zrow, 1024 + c, t, mu);
                const f32x4 w04 = *(const f32x4*)(w0 + c), a04 = *(const f32x4*)(a0 + c), kk4 = *(const f32x4*)(k_k + c), ka4 = *(const f32x4*)(k_a + c), rk4 = *(const f32x4*)(r_k + c);
                f32x4 dw, dk, db; float kp[4];
#pragma unroll
                for (int e = 0; e < 4; ++e) { const float wl = w04[e] + aw[nt][e]; const float nx = -wl; const float sp = nx > 20.f ? nx : log1pf(expf(nx));
                    dw[e] = expf(-expf(-sp - 0.5f));
                    const float a = 1.0f / (1.0f + expf(-(a04[e] + aa[nt][e])));
                    const float kkv = kx[nt][e] * kk4[e] * inv; dk[e] = kkv; db[e] = kkv * a;
                    kp[e] = kx[nt][e] * (1.0f + (a - 1.0f) * ka4[e]); bon += r4[e] * kp[e] * rk4[e]; }
                *(f32x4*)(Wd + o) = dw; *(f32x4*)(KK + o) = dk; *(f32x4*)(Bb + o) = db;
                u32x2 w; w.x = pk2(r4[0], r4[1]); w.y = pk2(r4[2], r4[3]); *(u32x2*)(Rb + o) = w;
                w.x = pk2(v4[0], v4[1]); w.y = pk2(v4[2], v4[3]); *(u32x2*)(Vb + o) = w;
                w.x = pk2(kp[0], kp[1]); w.y = pk2(kp[2], kp[3]); *(u32x2*)(KPb + o) = w;
                w.x = pk2(ag[nt][0], ag[nt][1]); w.y = pk2(ag[nt][2], ag[nt][3]); *(u32x2*)(Gb + o) = w;
                asm volatile("" ::: "memory"); }
            bon += __shfl_xor(bon, 16); bon += __shfl_xor(bon, 32);
            if (fq == 0) bonus[(size_t)t * 8 + h] = bon;
        }
    }
}

DI void sgu_items(Frame& F, int first, int stride) {
    unsigned char* ws = F.ws; const int lane = F.lane, fr = lane & 15, fq = lane >> 4;
    const bf16* su = (const bf16*)(ws + WS_SU); bf16* mix = (bf16*)(ws + WS_MIX); const bf16* wsb = (const bf16*)(ws + WS_WSB);
    const float* sg1 = (const float*)(ws + WS_CTL) + 3 * T; const float* sg2 = sg1 + T; const float *lnw = F.in[15], *lnb = F.in[16], *bsp = F.in[18];
    unsigned char* vnT = F.lds + F.wid * 17408;
    for (int item = first; item < 2048; item += stride) {
        const int nb = item >> 4, g = (item >> 1) & 7, hf = item & 1, KJ = 64 * (hf + 1);
        LDS_FENCE();
        { const int chunk = lane & 7, jp = lane >> 3;
          f32x4 lw0 = *(const f32x4*)(lnw + 64 * g + 8 * chunk), lw1 = *(const f32x4*)(lnw + 64 * g + 8 * chunk + 4), lb0 = *(const f32x4*)(lnb + 64 * g + 8 * chunk), lb1 = *(const f32x4*)(lnb + 64 * g + 8 * chunk + 4);
          for (int it = 0; it < KJ / 16; ++it) { const int j = 2 * (jp + 8 * it), tok = 128 * nb + j;
              const u32x4 a0 = *(const u32x4*)(su + (size_t)tok * 1024 + 512 + 64 * g + 8 * chunk), a1 = *(const u32x4*)(su + (size_t)(tok + 1) * 1024 + 512 + 64 * g + 8 * chunk);
              const float m0 = sg1[tok] * (1.0f / 512), m1 = sg1[tok + 1] * (1.0f / 512);
              const float r0 = rsqrtf(fmaxf(sg2[tok] * (1.0f / 512) - m0 * m0, 0.f) + 1e-5f), r1 = rsqrtf(fmaxf(sg2[tok + 1] * (1.0f / 512) - m1 * m1, 0.f) + 1e-5f);
#pragma unroll
              for (int e2 = 0; e2 < 4; ++e2) { const float lwA = e2 < 2 ? lw0[2 * e2] : lw1[2 * e2 - 4], lwB = e2 < 2 ? lw0[2 * e2 + 1] : lw1[2 * e2 - 3], lbA = e2 < 2 ? lb0[2 * e2] : lb1[2 * e2 - 4], lbB = e2 < 2 ? lb0[2 * e2 + 1] : lb1[2 * e2 - 3];
                  const float x0a = (bflo(a0[e2]) - m0) * r0 * lwA + lbA, x0b = (bfhi(a0[e2]) - m0) * r0 * lwB + lbB;
                  const float x1a = (bflo(a1[e2]) - m1) * r1 * lwA + lbA, x1b = (bfhi(a1[e2]) - m1) * r1 * lwB + lbB;
                  *(unsigned*)(vnT + (8 * chunk + 2 * e2) * 272 + j * 2) = pk2(x0a, x1a);
                  *(unsigned*)(vnT + (8 * chunk + 2 * e2 + 1) * 272 + j * 2) = pk2(x0b, x1b); } } }
        LDS_FENCE();
        f32x4 acc[4][4];
#pragma unroll
        for (int a = 0; a < 4; ++a)
#pragma unroll
            for (int b = 0; b < 4; ++b) acc[a][b] = (f32x4){0.f, 0.f, 0.f, 0.f};
        for (int ks = 0; ks < KJ / 32; ++ks) {
            bf16x8 bfv[4];
#pragma unroll
            for (int ct = 0; ct < 4; ++ct) bfv[ct] = *(const bf16x8*)(vnT + (16 * ct + fr) * 272 + (32 * ks + 8 * fq) * 2);
#pragma unroll
            for (int it = 0; it < 4; ++it) { const int i = 64 * hf + 16 * it + fr; const bf16x8 af = *(const bf16x8*)(wsb + (size_t)(g * 128 + i) * 128 + 32 * ks + 8 * fq);
#pragma unroll
                for (int ct = 0; ct < 4; ++ct) acc[it][ct] = MFMA16(bfv[ct], af, acc[it][ct]); } }
#pragma unroll
        for (int it = 0; it < 4; ++it) { const int i = 64 * hf + 16 * it + fr, tok = 128 * nb + i; const float bias = bsp[g * 128 + i];
#pragma unroll
            for (int ct = 0; ct < 4; ++ct) { const int c = 64 * g + 16 * ct + 4 * fq; const u32x2 uu = *(const u32x2*)(su + (size_t)tok * 1024 + c);
                u32x2 w; w.x = pk2(bflo(uu.x) * (acc[it][ct][0] + bias), bfhi(uu.x) * (acc[it][ct][1] + bias)); w.y = pk2(bflo(uu.y) * (acc[it][ct][2] + bias), bfhi(uu.y) * (acc[it][ct][3] + bias));
                *(u32x2*)(mix + (size_t)tok * 1024 + 512 + c) = w; } }
    }
}

DI float dpp_x1(float v) { return __builtin_bit_cast(float, __builtin_amdgcn_update_dpp(0, __builtin_bit_cast(int, v), 0xB1, 0xF, 0xF, true)); }
DI float dpp_x2(float v) { return __builtin_bit_cast(float, __builtin_amdgcn_update_dpp(0, __builtin_bit_cast(int, v), 0x4E, 0xF, 0xF, true)); }
DI float dpp_hm(float v) { return __builtin_bit_cast(float, __builtin_amdgcn_update_dpp(0, __builtin_bit_cast(int, v), 0x141, 0xF, 0xF, true)); }
DI float red8(float p) { p += dpp_x1(p); p += dpp_x2(p); p += dpp_hm(p); return p; }
constexpr int SC = 16, NSC = LCH / SC, SARR = SC * 64, SBUF = 6 * SARR, SGRP = 2 * SBUF + 2 * SARR;
template <bool P3> DI void scan_pass(Frame& F) {
    constexpr int RPL = P3 ? 2 : 4;
    unsigned char* ws = F.ws; const int lane = F.lane, grp = F.wid >> 2, w4 = F.wid & 3, gt = F.tid & 255, rs = lane >> 3, kg = lane & 7;
    const float* Wd = F.out; const float* KK = F.out + (size_t)T * RW; const float* Bb = (const float*)(ws + WS_B);
    const bf16* Rb = (const bf16*)(ws + WS_R); const bf16* Vb = (const bf16*)(ws + WS_V); const bf16* KPb = (const bf16*)(ws + WS_KP); const bf16* Gb = (const bf16*)(ws + WS_G);
    const float* bonus = (const float*)(ws + WS_BON); bf16* mix = (bf16*)(ws + WS_MIX);
    float* PT = (float*)(ws + WS_PT); float* SL = (float*)(ws + WS_SLOC); const float* SST = (const float*)(ws + WS_SST);
    const float *lnxw = F.in[13], *lnxb = F.in[14];
    float* gl = (float*)F.lds + grp * SGRP;
    for (int pair0 = F.bid * 2; pair0 < NC * 8; pair0 += F.G * 2) {
        const int pair = pair0 + grp, c = pair >> 3, h = pair & 7, tb = c * LCH;
        const int lstep = gt >> 4, lc4 = (gt & 15) * 4;
        f32x4 lw, lkk, lb; u32x2 lkp, lv, lr;
#define SCAN_LOAD(sc_) do { const size_t o_ = (size_t)(tb + (sc_) * SC + lstep) * RW + h * 64 + lc4; lw = *(const f32x4*)(Wd + o_); lkk = *(const f32x4*)(KK + o_); lb = *(const f32x4*)(Bb + o_); \
            lkp = *(const u32x2*)(KPb + o_); lv = *(const u32x2*)(Vb + o_); if (P3) lr = *(const u32x2*)(Rb + o_); } while (0)
#define SCAN_STORE(b_) do { float* d_ = gl + (b_) * SBUF + lstep * 64 + lc4; *(f32x4*)(d_) = lw; *(f32x4*)(d_ + SARR) = lkk; *(f32x4*)(d_ + 2 * SARR) = lb; \
            *(f32x4*)(d_ + 3 * SARR) = (f32x4){bflo(lkp.x), bfhi(lkp.x), bflo(lkp.y), bfhi(lkp.y)}; *(f32x4*)(d_ + 4 * SARR) = (f32x4){bflo(lv.x), bfhi(lv.x), bflo(lv.y), bfhi(lv.y)}; \
            if (P3) *(f32x4*)(d_ + 5 * SARR) = (f32x4){bflo(lr.x), bfhi(lr.x), bflo(lr.y), bfhi(lr.y)}; } while (0)
        const int vrow0 = (P3 ? 16 : 32) * w4 + RPL * rs;
        const bool isP = !P3 && vrow0 < 64; const int srow0 = P3 ? vrow0 : (vrow0 & 63);
        float s[RPL][8];
#pragma unroll
        for (int i = 0; i < RPL; ++i)
#pragma unroll
            for (int j = 0; j < 8; ++j) s[i][j] = 0.f;
        if (P3) {
#pragma unroll
            for (int i = 0; i < RPL; ++i) { const float* sp = SST + ((size_t)(c * 8 + h) * 64 + srow0 + i) * 64 + 8 * kg; const f32x4 a = *(const f32x4*)sp, b = *(const f32x4*)(sp + 4);
                s[i][0] = a[0]; s[i][1] = a[1]; s[i][2] = a[2]; s[i][3] = a[3]; s[i][4] = b[0]; s[i][5] = b[1]; s[i][6] = b[2]; s[i][7] = b[3]; }
        } else if (isP) {
#pragma unroll
            for (int i = 0; i < RPL; ++i)
#pragma unroll
                for (int j = 0; j < 8; ++j) s[i][j] = (srow0 + i == 8 * kg + j) ? 1.f : 0.f;
        }
        __syncthreads();
        SCAN_LOAD(0); SCAN_STORE(0);
        __syncthreads();
        for (int sc = 0; sc < NSC; ++sc) {
            const float* bf = gl + (sc & 1) * SBUF; float* yb = gl + 2 * SBUF + (sc & 1) * SARR;
            if (sc + 1 < NSC) SCAN_LOAD(sc + 1);
            if (P3 && sc > 0) {
                const float* yp = gl + 2 * SBUF + ((sc - 1) & 1) * SARR + lstep * 64 + lc4; const f32x4 y4 = *(const f32x4*)yp;
                float sm = (y4[0] + y4[1]) + (y4[2] + y4[3]); sm += __shfl_xor(sm, 1); sm += __shfl_xor(sm, 2); sm += __shfl_xor(sm, 4); sm += __shfl_xor(sm, 8);
                const float mean = sm * (1.0f / 64); const f32x4 d = y4 - mean; float q = (d[0] * d[0] + d[1] * d[1]) + (d[2] * d[2] + d[3] * d[3]);
                q += __shfl_xor(q, 1); q += __shfl_xor(q, 2); q += __shfl_xor(q, 4); q += __shfl_xor(q, 8);
                const float rstd = rsqrtf(q * (1.0f / 64) + 64e-5f); const int t = tb + (sc - 1) * SC + lstep; const size_t o = (size_t)t * RW + h * 64 + lc4;
                const f32x4 lw4 = *(const f32x4*)(lnxw + h * 64 + lc4), lb4 = *(const f32x4*)(lnxb + h * 64 + lc4); const float bo = bonus[(size_t)t * 8 + h];
                const u32x2 v2 = *(const u32x2*)(Vb + o), g2 = *(const u32x2*)(Gb + o);
                const float vv[4] = {bflo(v2.x), bfhi(v2.x), bflo(v2.y), bfhi(v2.y)}, gg[4] = {bflo(g2.x), bfhi(g2.x), bflo(g2.y), bfhi(g2.y)}; float o4[4];
#pragma unroll
                for (int e = 0; e < 4; ++e) o4[e] = (d[e] * rstd * lw4[e] + lb4[e] + bo * vv[e]) * gg[e];
                u32x2 w; w.x = pk2(o4[0], o4[1]); w.y = pk2(o4[2], o4[3]); *(u32x2*)(mix + (size_t)t * 1024 + h * 64 + lc4) = w;
            }
#pragma unroll 2
            for (int st = 0; st < SC; ++st) {
                const float* p = bf + st * 64 + 8 * kg;
                const f32x4 w0 = *(const f32x4*)p, w1 = *(const f32x4*)(p + 4), k0 = *(const f32x4*)(p + SARR), k1 = *(const f32x4*)(p + SARR + 4), b0 = *(const f32x4*)(p + 2 * SARR), b1 = *(const f32x4*)(p + 2 * SARR + 4),
                            q0 = *(const f32x4*)(p + 3 * SARR), q1 = *(const f32x4*)(p + 3 * SARR + 4);
                const float wv[8] = {w0[0], w0[1], w0[2], w0[3], w1[0], w1[1], w1[2], w1[3]}, kv[8] = {k0[0], k0[1], k0[2], k0[3], k1[0], k1[1], k1[2], k1[3]},
                            bv[8] = {b0[0], b0[1], b0[2], b0[3], b1[0], b1[1], b1[2], b1[3]}, qv[8] = {q0[0], q0[1], q0[2], q0[3], q1[0], q1[1], q1[2], q1[3]};
                float vr[RPL];
                if (RPL == 4) { const f32x4 v4 = *(const f32x4*)(bf + 4 * SARR + st * 64 + srow0); vr[0] = v4[0]; vr[1] = v4[1]; vr[RPL - 2] = v4[2]; vr[RPL - 1] = v4[3]; }
                else { const f32x2 v2 = *(const f32x2*)(bf + 4 * SARR + st * 64 + srow0); vr[0] = v2[0]; vr[1] = v2[1]; }
                if (isP) {
#pragma unroll
                    for (int i = 0; i < RPL; ++i) vr[i] = 0.f; }
                float rv[8];
                if (P3) { const f32x4 r0 = *(const f32x4*)(p + 5 * SARR), r1 = *(const f32x4*)(p + 5 * SARR + 4); rv[0] = r0[0]; rv[1] = r0[1]; rv[2] = r0[2]; rv[3] = r0[3]; rv[4] = r1[0]; rv[5] = r1[1]; rv[6] = r1[2]; rv[7] = r1[3]; }
                float yv[RPL];
#pragma unroll
                for (int i = 0; i < RPL; ++i) {
                    float pa = s[i][0] * kv[0], pb = s[i][1] * kv[1];
#pragma unroll
                    for (int j = 2; j < 8; j += 2) { pa = fmaf(s[i][j], kv[j], pa); pb = fmaf(s[i][j + 1], kv[j + 1], pb); }
                    const float nsa = -red8(pa + pb);
#pragma unroll
                    for (int j = 0; j < 8; ++j) s[i][j] = fmaf(s[i][j], wv[j], fmaf(nsa, bv[j], vr[i] * qv[j]));
                    if (P3) { float ya = s[i][0] * rv[0], yb2 = s[i][1] * rv[1];
#pragma unroll
                        for (int j = 2; j < 8; j += 2) { ya = fmaf(s[i][j], rv[j], ya); yb2 = fmaf(s[i][j + 1], rv[j + 1], yb2); }
                        yv[i] = red8(ya + yb2); }
                }
                if (P3 && kg == 0) *(f32x2*)(yb + st * 64 + srow0) = (f32x2){yv[0], yv[RPL - 1]};
            }
            if (sc + 1 < NSC) SCAN_STORE((sc + 1) & 1);
            __syncthreads();
        }
        if (P3) {
            const int sc = NSC;
            const float* yp = gl + 2 * SBUF + ((sc - 1) & 1) * SARR + lstep * 64 + lc4; const f32x4 y4 = *(const f32x4*)yp;
            float sm = (y4[0] + y4[1]) + (y4[2] + y4[3]); sm += __shfl_xor(sm, 1); sm += __shfl_xor(sm, 2); sm += __shfl_xor(sm, 4); sm += __shfl_xor(sm, 8);
            const float mean = sm * (1.0f / 64); const f32x4 d = y4 - mean; float q = (d[0] * d[0] + d[1] * d[1]) + (d[2] * d[2] + d[3] * d[3]);
            q += __shfl_xor(q, 1); q += __shfl_xor(q, 2); q += __shfl_xor(q, 4); q += __shfl_xor(q, 8);
            const float rstd = rsqrtf(q * (1.0f / 64) + 64e-5f); const int t = tb + (sc - 1) * SC + lstep; const size_t o = (size_t)t * RW + h * 64 + lc4;
            const f32x4 lw4 = *(const f32x4*)(lnxw + h * 64 + lc4), lb4 = *(const f32x4*)(lnxb + h * 64 + lc4); const float bo = bonus[(size_t)t * 8 + h];
            const u32x2 v2 = *(const u32x2*)(Vb + o), g2 = *(const u32x2*)(Gb + o);
            const float vv[4] = {bflo(v2.x), bfhi(v2.x), bflo(v2.y), bfhi(v2.y)}, gg[4] = {bflo(g2.x), bfhi(g2.x), bflo(g2.y), bfhi(g2.y)}; float o4[4];
#pragma unroll
            for (int e = 0; e < 4; ++e) o4[e] = (d[e] * rstd * lw4[e] + lb4[e] + bo * vv[e]) * gg[e];
            u32x2 w; w.x = pk2(o4[0], o4[1]); w.y = pk2(o4[2], o4[3]); *(u32x2*)(mix + (size_t)t * 1024 + h * 64 + lc4) = w;
        } else {
            if (isP) {
#pragma unroll
                for (int j = 0; j < 8; ++j) *(f32x4*)(PT + ((size_t)(c * 8 + h) * 64 + 8 * kg + j) * 64 + srow0) = (f32x4){s[0][j], s[1][j], s[RPL - 2][j], s[RPL - 1][j]};
            } else {
#pragma unroll
                for (int i = 0; i < RPL; ++i) { float* sp = SL + ((size_t)(c * 8 + h) * 64 + srow0 + i) * 64 + 8 * kg;
                    *(f32x4*)sp = (f32x4){s[i][0], s[i][1], s[i][2], s[i][3]}; *(f32x4*)(sp + 4) = (f32x4){s[i][4], s[i][5], s[i][6], s[i][7]}; }
            }
        }
#undef SCAN_LOAD
#undef SCAN_STORE
    }
}
DI void scan_pass2(Frame& F, int task) {
    unsigned char* ws = F.ws; const int lane = F.lane, fr = lane & 15, fq = lane >> 4, h = task >> 2, ib = task & 3;
    const float* PT = (const float*)(ws + WS_PT); const float* SL = (const float*)(ws + WS_SLOC); float* SST = (float*)(ws + WS_SST);
    f32x4 S[4];
#pragma unroll
    for (int j = 0; j < 4; ++j) S[j] = (f32x4){0.f, 0.f, 0.f, 0.f};
    f32x4 pv[4][4], nl[4];
#define P2_LOAD(c_, PV, NL) do { const size_t m_ = (size_t)((c_) * 8 + h) * 4096; _Pragma("unroll") for (int jt = 0; jt < 4; ++jt) { NL[jt] = *(const f32x4*)(SL + m_ + (16 * ib + fr) * 64 + 16 * jt + 4 * fq); \
        _Pragma("unroll") for (int t4 = 0; t4 < 4; ++t4) PV[jt][t4] = *(const f32x4*)(PT + m_ + (16 * jt + fr) * 64 + 16 * t4 + 4 * fq); } } while (0)
    P2_LOAD(0, pv, nl);
    for (int c = 0; c < NC; ++c) {
        const size_t m = (size_t)(c * 8 + h) * 4096;
#pragma unroll
        for (int jt = 0; jt < 4; ++jt) *(f32x4*)(SST + m + (16 * ib + fr) * 64 + 16 * jt + 4 * fq) = S[jt];
        if (c == NC - 1) break;
        f32x4 pvn[4][4], nln[4];
        const int cn = (c + 1 < NC - 1) ? c + 1 : c;
        P2_LOAD(cn, pvn, nln);
#pragma unroll
        for (int jt = 0; jt < 4; ++jt)
#pragma unroll
            for (int t4 = 0; t4 < 4; ++t4)
#pragma unroll
                for (int rg = 0; rg < 4; ++rg) nl[jt] = __builtin_amdgcn_mfma_f32_16x16x4f32(pv[jt][t4][rg], S[t4][rg], nl[jt], 0, 0, 0);
#pragma unroll
        for (int jt = 0; jt < 4; ++jt) { S[jt] = nl[jt]; nl[jt] = nln[jt];
#pragma unroll
            for (int t4 = 0; t4 < 4; ++t4) pv[jt][t4] = pvn[jt][t4]; }
    }
#undef P2_LOAD
}

DI void attn_phase(Frame& F) {
    unsigned char* ws = F.ws; const int tid = F.tid, lane = F.lane, wid = F.wid, fr = lane & 15, fq = lane >> 4;
    const bf16* qb = (const bf16*)(ws + WS_Q); const bf16* Kb = (const bf16*)(ws + WS_KB); const bf16* Vt = (const bf16*)(ws + WS_VT); bf16* ob = (bf16*)(ws + WS_OB);
    unsigned char* L = F.lds;
    for (int item = F.bid; item < (T / 128) * 4; item += F.G) {
        const int tile = item >> 2, hd = item & 3, t = tile * 128 + 16 * wid + fr;
        __syncthreads();
#pragma unroll
        for (int i = 0; i < 16; ++i) { const int e = tid + 512 * i, row = e >> 5, c16 = e & 31; *(u32x4*)(L + row * 528 + c16 * 16) = *(const u32x4*)(Kb + (size_t)row * D + hd * 256 + c16 * 8); }
        bf16x8 qf[8];
#pragma unroll
        for (int ks = 0; ks < 8; ++ks) qf[ks] = *(const bf16x8*)(qb + (size_t)t * D + hd * 256 + 32 * ks + 8 * fq);
        __syncthreads();
        f32x4 sacc[16];
#pragma unroll
        for (int mt = 0; mt < 16; ++mt) { sacc[mt] = (f32x4){0.f, 0.f, 0.f, 0.f};
#pragma unroll
            for (int ks = 0; ks < 8; ++ks) sacc[mt] = MFMA16(*(const bf16x8*)(L + (16 * mt + fr) * 528 + (32 * ks + 8 * fq) * 2), qf[ks], sacc[mt]); }
        float mx = -1e30f;
#pragma unroll
        for (int mt = 0; mt < 16; ++mt) mx = fmaxf(mx, fmaxf(fmaxf(sacc[mt][0], sacc[mt][1]), fmaxf(sacc[mt][2], sacc[mt][3])));
        mx = fmaxf(mx, __shfl_xor(mx, 16)); mx = fmaxf(mx, __shfl_xor(mx, 32));
        float sum = 0.f; bf16x8 pf[8];
#pragma unroll
        for (int s2 = 0; s2 < 8; ++s2) { float e[8];
#pragma unroll
            for (int j = 0; j < 4; ++j) { e[j] = __expf((sacc[2 * s2][j] - mx) * 0.0625f); e[4 + j] = __expf((sacc[2 * s2 + 1][j] - mx) * 0.0625f); }
#pragma unroll
            for (int j = 0; j < 8; ++j) sum += e[j];
            u32x4 w; w.x = pk2(e[0], e[1]); w.y = pk2(e[2], e[3]); w.z = pk2(e[4], e[5]); w.w = pk2(e[6], e[7]); pf[s2] = __builtin_bit_cast(bf16x8, w); }
        sum += __shfl_xor(sum, 16); sum += __shfl_xor(sum, 32);
        const float inv = 1.0f / sum;
        __syncthreads();
#pragma unroll
        for (int i = 0; i < 16; ++i) { const int e = tid + 512 * i, row = e >> 5, c16 = e & 31; *(u32x4*)(L + row * 528 + c16 * 16) = *(const u32x4*)(Vt + (size_t)(hd * 256 + row) * MEM + c16 * 8); }
        __syncthreads();
#pragma unroll 4
        for (int dt = 0; dt < 16; ++dt) { f32x4 o = (f32x4){0.f, 0.f, 0.f, 0.f}; const unsigned char* vrow = L + (16 * dt + fr) * 528 + 8 * fq;
#pragma unroll
            for (int s2 = 0; s2 < 8; ++s2) { const u32x2 lo = *(const u32x2*)(vrow + 64 * s2), hi = *(const u32x2*)(vrow + 64 * s2 + 32);
                const u32x4 vv = (u32x4){lo.x, lo.y, hi.x, hi.y}; o = MFMA16(__builtin_bit_cast(bf16x8, vv), pf[s2], o); }
            u32x2 w; w.x = pk2(o[0] * inv, o[1] * inv); w.y = pk2(o[2] * inv, o[3] * inv);
            *(u32x2*)(ob + (size_t)t * D + hd * 256 + 16 * dt + 4 * fq) = w; }
    }
}

DI void final_norm(Frame& F) {
    const int gw = F.bid * NWAVES + F.wid, NGW = F.G * NWAVES, lane = F.lane; const float* ss3 = (const float*)(F.ws + WS_CTL) + 2 * T; const float* gf = F.in[30];
    for (int m = gw; m < T; m += NGW) { const float rs = rsqrtf(ss3[m] * (1.0f / D) + RMS_EPS); f32x4* xr = (f32x4*)(F.out + (size_t)m * D) + lane;
#pragma unroll
        for (int j = 0; j < 4; ++j) { const f32x4 g = ((const f32x4*)gf)[lane + 64 * j]; xr[64 * j] = xr[64 * j] * rs * g; } }
}

#ifndef MK_PER_PHASE
#define MK_PER_PHASE 0
#endif
constexpr int NPHASES = 13;
struct Args { const float* in[31]; float* out; unsigned char* ws; int ph_lo, ph_hi; };
static_assert(sizeof(Args) == 33 * 8 + 8, "no padding");

__global__ void __launch_bounds__(NTHR, 2) hybrid_fwd(Args args) {
    extern __shared__ __attribute__((aligned(16))) unsigned char lds[];
    cg::grid_group grid = cg::this_grid();
    Frame F;
    F.lds = lds; F.tid = threadIdx.x; F.lane = F.tid & 63; F.wid = __builtin_amdgcn_readfirstlane(F.tid >> 6); F.bid = blockIdx.x; F.G = gridDim.x;
#pragma unroll
    for (int i = 0; i < 31; ++i) F.in[i] = args.in[i];
    F.out = args.out; F.ws = args.ws;
    unsigned char* ws = args.ws;
    PG8_LAS unsigned char* glds = (PG8_LAS unsigned char*)lds;
    float* ctl = (float*)(ws + WS_CTL); float *ss1 = ctl, *ss2 = ctl + T, *ss3 = ctl + 2 * T, *sg1 = ctl + 3 * T, *sg2 = ctl + 4 * T;
    const int lo = args.ph_lo, hi = args.ph_hi;
#ifndef PHMASK
#define PHMASK 0x1fff
#endif
#define IN(k) (((PHMASK >> (k)) & 1) && lo <= (k) && (k) < hi)
#define SEAM(k) do { if ((k) + 1 < hi) grid.sync(); } while (0)

    if (IN(0)) { p0_prologue(F); SEAM(0); }
    if (IN(1)) {
        { pg8::Gemm g{(const bf16*)(ws + WS_XB), (const bf16*)(ws + WS_WIN), T, NIN, D}; pg8::StaticOrder S; S.init(T, NIN, F.G, F.bid);
          EpiZ E{(bf16*)(ws + WS_ZR), (bf16*)(ws + WS_SU), (const float*)(ws + WS_RS0), sg1, sg2};
          pg8::gemm_phase<EpiZ, pg8::StaticOrder>(glds, g, S, E, nullptr); }
        { const int b = F.bid - (F.G - 8); const bool isk = b >= 0 && b < 4, isv = b >= 4 && b < 8;
          if (isk) { pg8::Gemm g{(const bf16*)(ws + WS_MB), (const bf16*)(ws + WS_WK), MEM, D, D}; FewOrder S{0, b, true}; EpiBf E{(bf16*)(ws + WS_KB), D, nullptr};
              pg8::gemm_phase<EpiBf, FewOrder>(glds, g, S, E, nullptr); }
          if (isv) { pg8::Gemm g{(const bf16*)(ws + WS_WV), (const bf16*)(ws + WS_MB), D, MEM, D}; FewOrder S{b - 4, 0, true}; EpiBf E{(bf16*)(ws + WS_VT), MEM, nullptr};
              pg8::gemm_phase<EpiBf, FewOrder>(glds, g, S, E, nullptr); } }
        SEAM(1); }
    if (IN(2)) { prep_phase(F); SEAM(2); }
    if (IN(3)) { scan_pass<false>(F); SEAM(3); }
    if (IN(4)) {
        if (F.bid < 32) { if (F.wid == 0) scan_pass2(F, F.bid); }
        else sgu_items(F, (F.bid - 32) * NWAVES + F.wid, (F.G - 32) * NWAVES);
        SEAM(4); }
    if (IN(5)) { scan_pass<true>(F); SEAM(5); }
    if (IN(6)) {
        pg8::Gemm g{(const bf16*)(ws + WS_MIX), (const bf16*)(ws + WS_WOUT), T, D, D}; pg8::StaticOrder S; S.init(T, D, F.G, F.bid);
        EpiRes E{F.in[0], F.out, (bf16*)(ws + WS_XB), ss1};
        pg8::gemm_phase<EpiRes, pg8::StaticOrder>(glds, g, S, E, nullptr); SEAM(6); }
    if (IN(7)) {
        pg8::Gemm g{(const bf16*)(ws + WS_XB), (const bf16*)(ws + WS_WQ), T, D, D}; pg8::StaticOrder S; S.init(T, D, F.G, F.bid);
        EpiBf E{(bf16*)(ws + WS_Q), D, ss1};
        pg8::gemm_phase<EpiBf, pg8::StaticOrder>(glds, g, S, E, nullptr); SEAM(7); }
    if (IN(8)) { attn_phase(F); SEAM(8); }
    if (IN(9)) {
        pg8::Gemm g{(const bf16*)(ws + WS_OB), (const bf16*)(ws + WS_WO), T, D, D}; pg8::StaticOrder S; S.init(T, D, F.G, F.bid);
        EpiRes E{F.out, F.out, (bf16*)(ws + WS_XB), ss2};
        pg8::gemm_phase<EpiRes, pg8::StaticOrder>(glds, g, S, E, nullptr); SEAM(9); }
    if (IN(10)) {
        pg8::Gemm g{(const bf16*)(ws + WS_XB), (const bf16*)(ws + WS_WGU), T, 2 * FF, D}; pg8::StaticOrder S; S.init(T, 2 * FF, F.G, F.bid);
        EpiSwi E{(bf16*)(ws + WS_HFF), ss2};
        pg8::gemm_phase<EpiSwi, pg8::StaticOrder>(glds, g, S, E, nullptr); SEAM(10); }
    if (IN(11)) {
        pg8::Gemm g{(const bf16*)(ws + WS_HFF), (const bf16*)(ws + WS_WD), T, D, FF}; pg8::StaticOrder S; S.init(T, D, F.G, F.bid);
        EpiRes E{F.out, F.out, nullptr, ss3};
        pg8::gemm_phase<EpiRes, pg8::StaticOrder>(glds, g, S, E, nullptr); SEAM(11); }
    if (IN(12)) { final_norm(F); }
#undef IN
#undef SEAM
}

extern "C" void kernel_launch(void* const* d_in, const int* in_sizes, int n_in, void* d_out, int out_size, void* d_ws, size_t ws_size, hipStream_t stream) {
    static int grid = 0;
    if (grid == 0) {
        if (n_in != 31 || in_sizes[0] != T * D || out_size != T * D || ws_size < WS_END) { fprintf(stderr, "kernel_launch: unexpected shapes (n_in %d, in0 %d, out %d, ws %zu)\n", n_in, n_in > 0 ? in_sizes[0] : -1, out_size, ws_size); grid = -1; return; }
        int dev = 0, cus = 0, per_cu = 0;
        if (hipGetDevice(&dev) != hipSuccess || hipDeviceGetAttribute(&cus, hipDeviceAttributeMultiprocessorCount, dev) != hipSuccess) { grid = -1; return; }
        if (hipFuncSetAttribute((const void*)hybrid_fwd, hipFuncAttributeMaxDynamicSharedMemorySize, LDS_BYTES) != hipSuccess) { fprintf(stderr, "kernel_launch: hipFuncSetAttribute failed\n"); grid = -1; return; }
        if (hipOccupancyMaxActiveBlocksPerMultiprocessor(&per_cu, (const void*)hybrid_fwd, NTHR, LDS_BYTES) != hipSuccess || per_cu < 1) { fprintf(stderr, "kernel_launch: occupancy query says %d blocks per CU\n", per_cu); per_cu = 1; }
        (void)hipGetLastError();
        grid = cus * per_cu;
    }
    if (grid < 0) return;
    if (hipMemsetAsync((char*)d_ws + WS_CTL, 0, CTL_BYTES, stream) != hipSuccess) { fprintf(stderr, "kernel_launch: memset failed\n"); return; }
    Args a{};
    for (int i = 0; i < 31; ++i) a.in[i] = (const float*)d_in[i];
    a.out = (float*)d_out; a.ws = (unsigned char*)d_ws;
#if MK_PER_PHASE
    for (int p = 0; p < NPHASES; ++p) { a.ph_lo = p; a.ph_hi = p + 1; hipLaunchKernelGGL(hybrid_fwd, dim3(grid), dim3(NTHR), LDS_BYTES, stream, a); }
#else
    a.ph_lo = 0; a.ph_hi = NPHASES;
    void* kargs[] = {&a};
    hipError_t e = hipLaunchCooperativeKernel((const void*)hybrid_fwd, dim3(grid), dim3(NTHR), kargs, LDS_BYTES, stream);
    if (e != hipSuccess) fprintf(stderr, "kernel_launch: cooperative launch failed: %s (grid %d)\n", hipGetErrorString(e), grid);
#endif
}
```

```cpp
#include <hip/hip_runtime.h>
#include <hip/hip_cooperative_groups.h>
#include <cstdio>
namespace cg = cooperative_groups;

namespace pg8 {
#define PG8_LAS __attribute__((address_space(3)))
typedef unsigned short bf16_t;
typedef short bf16x8 __attribute__((ext_vector_type(8)));
typedef float f32x4 __attribute__((ext_vector_type(4)));
typedef unsigned u32x4 __attribute__((ext_vector_type(4)));
constexpr int BM = 256, BK = 64, HALF = 128, HTB = HALF * BK * 2  , STAGE_BYTES = 8 * HTB, NXCD = 8, WGM = 8;

__host__ __device__ __forceinline__ int lds_byte(int r, int c) { const int st = (r >> 4) * 2 + (c >> 5), rr = r & 15, cc = c & 31, ob = rr * 64 + cc * 2; return st * 1024 + (ob ^ (((ob >> 9) & 1) << 5)); }
__host__ __device__ __forceinline__ void stage_rc(int b, int& R, int& C) { const int st = b / 1024, sb = b % 1024, swz = sb ^ (((sb >> 9) & 1) << 5); R = (st >> 1) * 16 + swz / 64; C = (st & 1) * 32 + (swz % 64) / 2; }
__host__ __device__ __forceinline__ int perm32(int rho) { const int n = rho >> 4, i = rho & 15; return 8 * (i >> 2) + 4 * n + (i & 3); }

struct Unit { int pm, pn; };
struct Gemm { const bf16_t* A; const bf16_t* Bt; int M, N, K; };

struct StaticOrder {
    int nM, nN, nwg, G, c;
    __host__ __device__ void init(int M, int N, int G_, int c_) { nM = M / BM; nN = N / BM; nwg = nM * nN; G = G_; c = c_; }
    __host__ __device__ bool next(int i, Unit& u) const {
        const long L = (long)i * G + c; if (L >= nwg) return false;
        int wgid = (int)L; { const int q = nwg / NXCD, r = nwg % NXCD, xcd = wgid % NXCD, off = wgid / NXCD; wgid = (xcd < r ? xcd * (q + 1) : r * (q + 1) + (xcd - r) * q) + off; }
        const int nig = WGM * nN, gid = wgid / nig, fm = gid * WGM, gsz = (nM - fm) < WGM ? (nM - fm) : WGM;
        u.pm = fm + ((wgid % nig) % gsz); u.pn = (wgid % nig) / gsz; return true;
    }
    __device__ __forceinline__ void a_ready(const Unit&) const {}
    __device__ __forceinline__ void done(const Unit&) const {}
};
__device__ __forceinline__ unsigned cvt_pk_bf16(float lo, float hi) { unsigned r; asm volatile("v_cvt_pk_bf16_f32 %0, %1, %2" : "=v"(r) : "v"(lo), "v"(hi)); return r; }
typedef float f32x2 __attribute__((ext_vector_type(2)));
__device__ __forceinline__ f32x2 gelu_pk(f32x2 v) {
    const f32x2 av = __builtin_elementwise_abs(v), d = av * 0.2316418882f + 1.0f;
    f32x2 t; t.x = __builtin_amdgcn_rcpf(d.x); t.y = __builtin_amdgcn_rcpf(d.y);
    f32x2 q = t * 0.5307027145f + (-0.7265760135f); q = q * t + 0.7107068705f; q = q * t + (-0.142248368f); q = q * t + 0.127414796f; q = q * t;
    const f32x2 s = (v * v) * (-0.72134752044f);
    f32x2 e; e.x = __builtin_amdgcn_exp2f(s.x); e.y = __builtin_amdgcn_exp2f(s.y);
    const f32x2 m = v * (q * e), r = v - m;
    f32x2 o; o.x = v.x < 0.f ? m.x : r.x; o.y = v.y < 0.f ? m.y : r.y; return o;
}

template <class Epi, class Sched, bool STAMP = false>
__device__ __forceinline__ void gemm_phase(PG8_LAS unsigned char* lds, const Gemm g, const Sched& S, const Epi& E, unsigned long long* stamps) {
    const int tid = threadIdx.x, wid = __builtin_amdgcn_readfirstlane(tid >> 6), lane = tid & 63, wr = wid >> 2, wc = wid & 3, fr = lane & 15, fq = lane >> 4;
    const int K = g.K, nt = K / BK;
    int ts_lo = 0, ts_hi = 0, nts = 0; const unsigned long long rt_entry = STAMP ? (unsigned long long)wall_clock64() : 0ull;
#define PG8_STAMP() do { if (STAMP && wid == 0 && nts < 64) { const unsigned long long _c = (unsigned long long)clock64(); \
        ts_lo = (lane == nts) ? (int)(unsigned)_c : ts_lo; ts_hi = (lane == nts) ? (int)(unsigned)(_c >> 32) : ts_hi; ++nts; } } while (0)
    PG8_STAMP();
    unsigned voffA[2], voffB[2];
#pragma unroll
    for (int i = 0; i < 2; ++i) { int R, C; stage_rc(tid * 16 + i * 8192, R, C); const int Rb = Epi::PERM ? ((R & ~31) + perm32(R & 31)) : R;
        voffA[i] = (unsigned)(R * K + C) * 2u; voffB[i] = (unsigned)(Rb * K + C) * 2u; }
    const size_t kstep = (size_t)(BK * 2);
    const size_t hstep = (size_t)HALF * K * 2;
    const size_t tstep = 2 * hstep;
    const unsigned ldsw = (unsigned)wid * 1024u;
    const int aoff = lds_byte(wr * 64 + fr, fq * 8), boff = lds_byte(wc * 32 + fr, fq * 8);
#define PG8_SA(b, h) (((b) * 2 + (h)) * HTB)
#define PG8_SB(b, h) ((4 + (b) * 2 + (h)) * HTB)
#define PG8_STAGE(bufoff, gbase, voff) do { _Pragma("unroll") for (int _i = 0; _i < 2; ++_i) \
        __builtin_amdgcn_global_load_lds((const unsigned*)((const char*)(gbase) + (voff)[_i]), (PG8_LAS unsigned*)(lds + (bufoff) + ldsw + _i * 8192), 16, 0, 0); } while (0)
#define PG8_LDA(dst, b, h) do { _Pragma("unroll") for (int m = 0; m < 4; ++m) _Pragma("unroll") for (int k = 0; k < 2; ++k) dst[m][k] = *(const PG8_LAS bf16x8*)(lds + PG8_SA(b, h) + aoff + m * 2048 + k * 1024); } while (0)
#define PG8_LDB(dst, b, h) do { _Pragma("unroll") for (int n = 0; n < 2; ++n) _Pragma("unroll") for (int k = 0; k < 2; ++k) dst[n][k] = *(const PG8_LAS bf16x8*)(lds + PG8_SB(b, h) + boff + n * 2048 + k * 1024); } while (0)
#define PG8_MMA(ai, bj, At, Bt) do { __builtin_amdgcn_s_setprio(1); _Pragma("unroll") for (int m = 0; m < 4; ++m) _Pragma("unroll") for (int n = 0; n < 2; ++n) _Pragma("unroll") for (int k = 0; k < 2; ++k) \
        acc[ai][bj][m][n] = __builtin_amdgcn_mfma_f32_16x16x32_bf16(Bt[n][k], At[m][k], acc[ai][bj][m][n], 0, 0, 0); __builtin_amdgcn_s_setprio(0); } while (0)
#define PG8_WAIT_V(n) asm volatile("s_waitcnt vmcnt(" #n ")" ::: "memory")
#define PG8_WAIT_L(n) asm volatile("s_waitcnt lgkmcnt(" #n ")" ::: "memory")
#define PG8_BAR __builtin_amdgcn_s_barrier()
#define PG8_SCHED __builtin_amdgcn_sched_barrier(0)
    Unit cur, nxt; int ui = 0;
    if (!S.next(0, cur)) return;
    f32x4 acc[2][2][4][2];
#pragma unroll
    for (int a = 0; a < 2; ++a)
#pragma unroll
        for (int b = 0; b < 2; ++b)
#pragma unroll
            for (int m = 0; m < 4; ++m)
#pragma unroll
                for (int n = 0; n < 2; ++n) acc[a][b][m][n] = (f32x4){0.f, 0.f, 0.f, 0.f};
    bf16x8 At[4][2], B0[2][2], B1[2][2];
    const char* cA = (const char*)g.A + (size_t)cur.pm * tstep; const char* cB = (const char*)g.Bt + (size_t)cur.pn * tstep;
    S.a_ready(cur);
    PG8_STAGE(PG8_SB(0, 0), cB, voffB); PG8_STAGE(PG8_SA(0, 0), cA, voffA); PG8_STAGE(PG8_SB(0, 1), cB + hstep, voffB); PG8_STAGE(PG8_SA(0, 1), cA + hstep, voffA);
    if (wr == 1) PG8_BAR;
    PG8_WAIT_V(4); PG8_BAR;
    PG8_STAGE(PG8_SB(1, 0), cB + kstep, voffB); PG8_STAGE(PG8_SA(1, 0), cA + kstep, voffA); PG8_STAGE(PG8_SB(1, 1), cB + hstep + kstep, voffB);
    PG8_WAIT_V(6); PG8_BAR;
    PG8_STAMP();
    for (;;) {
        const bool has_next = S.next(ui + 1, nxt);
        const char* nA = has_next ? (const char*)g.A + (size_t)nxt.pm * tstep : cA; const char* nB = has_next ? (const char*)g.Bt + (size_t)nxt.pn * tstep : cB;
        for (int t = 0; t < nt; t += 2) {
            const bool last = (t == nt - 2);
            const char* a1 = cA + (size_t)(t + 1) * kstep;
            const char* a2 = last ? nA : cA + (size_t)(t + 2) * kstep; const char* b2 = last ? nB : cB + (size_t)(t + 2) * kstep;
            const char* a3 = a2 + kstep; const char* b3 = b2 + kstep;
            if (last && has_next) S.a_ready(nxt);
            PG8_LDB(B0, 0, 0); PG8_SCHED; PG8_LDA(At, 0, 0); PG8_STAGE(PG8_SA(1, 1), a1 + hstep, voffA);
            PG8_WAIT_L(8); PG8_BAR; PG8_WAIT_L(0); PG8_MMA(0, 0, At, B0); PG8_BAR; PG8_SCHED;
            PG8_LDB(B1, 0, 1); PG8_STAGE(PG8_SB(0, 0), b2, voffB);
            PG8_BAR; PG8_WAIT_L(0); PG8_MMA(0, 1, At, B1); PG8_BAR;
            PG8_LDA(At, 0, 1); PG8_STAGE(PG8_SA(0, 0), a2, voffA);
            PG8_BAR; PG8_WAIT_L(0); PG8_MMA(1, 0, At, B0); PG8_BAR; PG8_SCHED;
            PG8_STAGE(PG8_SB(0, 1), b2 + hstep, voffB);
            PG8_WAIT_V(6); PG8_BAR; PG8_MMA(1, 1, At, B1); PG8_BAR;
            PG8_LDB(B0, 1, 0); PG8_SCHED; PG8_LDA(At, 1, 0); PG8_STAGE(PG8_SA(0, 1), a2 + hstep, voffA);
            PG8_WAIT_L(8); PG8_BAR; PG8_WAIT_L(0); PG8_MMA(0, 0, At, B0); PG8_BAR; PG8_SCHED;
            PG8_LDB(B1, 1, 1); PG8_STAGE(PG8_SB(1, 0), b3, voffB);
            PG8_BAR; PG8_WAIT_L(0); PG8_MMA(0, 1, At, B1); PG8_BAR;
            PG8_LDA(At, 1, 1); PG8_STAGE(PG8_SA(1, 0), a3, voffA);
            PG8_BAR; PG8_WAIT_L(0); PG8_MMA(1, 0, At, B0); PG8_BAR; PG8_SCHED;
            PG8_STAGE(PG8_SB(1, 1), b3 + hstep, voffB);
            PG8_WAIT_V(6); PG8_BAR; PG8_MMA(1, 1, At, B1); PG8_BAR;
        }
        PG8_STAMP();
        if constexpr (!Epi::AFTER_DRAIN) { E(acc, cur, wr, wc, fr, fq); S.done(cur); }
        PG8_STAMP();
        if (!has_next) break;
#pragma unroll
        for (int a = 0; a < 2; ++a)
#pragma unroll
            for (int b = 0; b < 2; ++b)
#pragma unroll
                for (int m = 0; m < 4; ++m)
#pragma unroll
                    for (int n = 0; n < 2; ++n) acc[a][b][m][n] = (f32x4){0.f, 0.f, 0.f, 0.f};
        cur = nxt; cA = nA; cB = nB; ++ui;
    }
    PG8_WAIT_V(0);
    if (wr == 0) PG8_BAR;
    PG8_BAR;
    if constexpr (Epi::AFTER_DRAIN) { E.fused(acc, cur, wr, wc, fr, fq, lds, wid, lane); S.done(cur); }
    PG8_STAMP();
    if (STAMP && wid == 0) { stamps[lane] = lane < nts ? (((unsigned long long)(unsigned)ts_hi << 32) | (unsigned)ts_lo) : 0ull;
        if (lane == 62) stamps[62] = rt_entry; if (lane == 63) stamps[63] = (unsigned long long)wall_clock64(); }
#undef PG8_STAMP
#undef PG8_SA
#undef PG8_SB
#undef PG8_STAGE
#undef PG8_LDA
#undef PG8_LDB
#undef PG8_MMA
#undef PG8_WAIT_V
#undef PG8_WAIT_L
#undef PG8_BAR
#undef PG8_SCHED
}
}

using pg8::bf16x8; using pg8::f32x4; using pg8::u32x4; using pg8::Unit;
typedef unsigned short bf16;
typedef unsigned u32x2 __attribute__((ext_vector_type(2)));
typedef float f32x2 __attribute__((ext_vector_type(2)));
#define LAS __attribute__((address_space(3)))
#define DI __device__ __forceinline__
constexpr int T = 16384, D = 1024, NIN = 2816, RIN = 1792, RW = 512, FF = 2816, MEM = 256;
constexpr int NWAVES = 8, NTHR = 512;
constexpr int LCH = 256, NC = T / LCH;
constexpr float RMS_EPS = 1e-6f;
constexpr size_t MiB = (size_t)1 << 20, KiB = 1024;
constexpr size_t WS_CTL = 0, CTL_BYTES = 1 * MiB;
constexpr size_t WS_WIN = 2 * MiB, WS_WOUT = WS_WIN + (size_t)NIN * D * 2, WS_WQ = WS_WOUT + 2 * MiB, WS_WK = WS_WQ + 2 * MiB, WS_WV = WS_WK + 2 * MiB,
                 WS_WO = WS_WV + 2 * MiB, WS_WGU = WS_WO + 2 * MiB, WS_WD = WS_WGU + (size_t)2 * FF * D * 2;
constexpr size_t WS_XB = 34 * MiB;
constexpr size_t WS_R = WS_XB, WS_V = WS_XB + 16 * MiB;
constexpr size_t WS_G16 = WS_WIN;
constexpr size_t WS_ZR = 66 * MiB;
constexpr size_t WS_PT = WS_ZR, WS_SLOC = WS_ZR + 8 * MiB, WS_SST = WS_ZR + 16 * MiB;
constexpr size_t WS_Q = WS_ZR, WS_HFF = WS_ZR;
constexpr size_t WS_SU = 122 * MiB;
constexpr size_t WS_OB = WS_SU;
constexpr size_t WS_MIX = 154 * MiB;
constexpr size_t WS_B = 186 * MiB;
constexpr size_t WS_KP = 218 * MiB;
constexpr size_t WS_G = 234 * MiB;
constexpr size_t WS_MB = 251 * MiB, WS_KB = WS_MB + 512 * KiB, WS_VT = WS_KB + 512 * KiB, WS_WSB = WS_VT + 512 * KiB, WS_WLT = WS_WSB + 256 * KiB,
                 WS_ALT = WS_WLT + 64 * KiB, WS_GLT = WS_ALT + 64 * KiB, WS_RS0 = WS_GLT + 128 * KiB, WS_BON = WS_RS0 + 256 * KiB, WS_END = WS_BON + 512 * KiB;
constexpr size_t WS_WOTH = 254 * MiB;
static_assert(WS_WD + (size_t)D * FF * 2 <= WS_XB && WS_END <= WS_WOTH && WS_WOTH + 2 * MiB <= 256 * MiB, "ws map");
constexpr int LDS_BYTES = 147456;

DI float bf2f(unsigned b) { return __uint_as_float(b << 16); }
DI float bflo(unsigned w) { return __uint_as_float(w << 16); }
DI float bfhi(unsigned w) { return __uint_as_float(w & 0xffff0000u); }
DI unsigned pk2(float lo, float hi) { return pg8::cvt_pk_bf16(lo, hi); }
DI float wave_sum(float v) {
#pragma unroll
    for (int o = 1; o < 64; o <<= 1) v += __shfl_xor(v, o);
    return v; }
DI float sigmoidf_(float x) { return __builtin_amdgcn_rcpf(1.0f + __expf(-x)); }
DI float gelu_tanh(float v) { const float u2 = 1.5957691216f * (v + 0.044715f * v * v * v); return v * __builtin_amdgcn_rcpf(1.0f + __expf(-u2)); }
#define LDS_FENCE() asm volatile("s_waitcnt lgkmcnt(0)" ::: "memory")
#define MFMA16(a, b, c) __builtin_amdgcn_mfma_f32_16x16x32_bf16((a), (b), (c), 0, 0, 0)

struct KArgs { const float* in[31]; float* out; unsigned char* ws; int ph_lo, ph_hi; };
struct InTab { const __attribute__((address_space(4))) KArgs* ka; DI const float* operator[](int i) const { return ka->in[i]; } };
struct Frame {
    unsigned char* lds; int tid, lane, wid, bid, G;
    InTab in; float* out; unsigned char* ws;
};

#define XB_TMO      128
#define XB_XCNT(j)  (256  + 64 * (j))
#define XB_XSUB(j)  (1280 + 64 * (j))
#define XB_XGEN(j)  (2304 + 64 * (j))
#define XB_TOP      3328
#define XB_TOPGEN   3392
#define XCD_BAR_WORDS 3456
#define XB_SPIN_CAP (1u << 18)

__device__ __forceinline__ unsigned xb_ld(unsigned* p)              { return __hip_atomic_load(p, __ATOMIC_RELAXED, __HIP_MEMORY_SCOPE_AGENT); }
__device__ __forceinline__ unsigned xb_add(unsigned* p, unsigned v) { return __hip_atomic_fetch_add(p, v, __ATOMIC_RELAXED, __HIP_MEMORY_SCOPE_AGENT); }
__device__ __forceinline__ unsigned xb_xcc_id() { return (unsigned)__builtin_amdgcn_s_getreg((3 << 11) | 20) & 0xFu; }
#define XB_SPIN(cond, bar) do { unsigned _sp = 0; while (cond) { __builtin_amdgcn_s_sleep(1); \
    if ((++_sp & 255u) == 0u) { if (xb_ld(&(bar)[XB_TMO])) break; if (_sp > XB_SPIN_CAP) { atomicAdd(&(bar)[XB_TMO], 1u); break; } } } } while (0)

struct XcdBarrier {
    unsigned* bar; unsigned x;
    volatile LAS unsigned* st;
};

__device__ __forceinline__ XcdBarrier xcd_barrier_post(unsigned* bar, volatile LAS unsigned* st) {
    XcdBarrier b; b.bar = bar; b.x = xb_xcc_id(); b.st = st;
    if (threadIdx.x == 0) (void)xb_add(&bar[XB_XCNT(b.x)], 1u);
    return b;
}
__device__ __forceinline__ void xcd_barrier_complete(unsigned* bar, unsigned x, unsigned& nloc, unsigned& nx) {
    const unsigned G = gridDim.x * gridDim.y * gridDim.z;
    unsigned sum, cnt, mine, sp = 0u;
    for (;;) {
        sum = 0u; cnt = 0u; mine = 0u;
#pragma unroll
        for (unsigned j = 0; j < 16; ++j) { const unsigned c = xb_ld(&bar[XB_XCNT(j)]); sum += c; cnt += (c > 0u) ? 1u : 0u; mine = (j == x) ? c : mine; }
        if (sum == G) break;
        __builtin_amdgcn_s_sleep(1);
        if ((++sp & 255u) == 0u) { if (xb_ld(&bar[XB_TMO])) break; if (sp > XB_SPIN_CAP) { atomicAdd(&bar[XB_TMO], 1u); break; } }
    }
    nloc = mine > 0u ? mine : 1u; nx = cnt > 0u ? cnt : 1u;
}

__device__ __forceinline__ void xcd_barrier(const XcdBarrier& b) {
    asm volatile("s_waitcnt vmcnt(0)" ::: "memory");
    __syncthreads();
    if (threadIdx.x == 0) {
        unsigned* bar = b.bar;
        __builtin_amdgcn_s_waitcnt(0);
        unsigned nloc = b.st[0], nx = b.st[1];
        if (nloc == 0u) { xcd_barrier_complete(bar, b.x, nloc, nx); b.st[0] = nloc; b.st[1] = nx; }
        const unsigned old = xb_add(&bar[XB_XSUB(b.x)], 1u);
        const unsigned gen = old / nloc;
        if (old + 1u == (gen + 1u) * nloc) {
            __builtin_amdgcn_fence(__ATOMIC_RELEASE, "agent");
            asm volatile("s_waitcnt vmcnt(0)" ::: "memory");
            const unsigned og = xb_add(&bar[XB_TOP], 1u);
            const unsigned tg = og / nx;
            if (og + 1u == (tg + 1u) * nx) xb_add(&bar[XB_TOPGEN], 1u);
            else XB_SPIN(xb_ld(&bar[XB_TOPGEN]) == tg, bar);
            __builtin_amdgcn_fence(__ATOMIC_ACQUIRE, "agent");
            xb_add(&bar[XB_XGEN(b.x)], 1u);
            asm volatile("s_waitcnt vmcnt(0)" ::: "memory");
        } else {
            XB_SPIN(xb_ld(&bar[XB_XGEN(b.x)]) == gen, bar);
            __builtin_amdgcn_fence(__ATOMIC_ACQUIRE, "agent");
            asm volatile("s_waitcnt vmcnt(0)" ::: "memory");
        }
    }
    __syncthreads();
}

DI bool static_unit(int i, int G, int cid, int nM, int nN, int& pm, int& pn) {
    const int nwg = nM * nN; const long L = (long)i * G + cid; if (L >= nwg) return false;
    int wgid = (int)L; { const int q = nwg / pg8::NXCD, r = nwg % pg8::NXCD, xcd = wgid % pg8::NXCD, off = wgid / pg8::NXCD; wgid = (xcd < r ? xcd * (q + 1) : r * (q + 1) + (xcd - r) * q) + off; }
    const int nig = pg8::WGM * nN, gid = wgid / nig, fm = gid * pg8::WGM, gsz = (nM - fm) < pg8::WGM ? (nM - fm) : pg8::WGM;
    pm = fm + ((wgid % nig) % gsz); pn = (wgid % nig) / gsz; return true; }
constexpr int RS_TAB_OFF = 131072, RS_TAB_UNITS = 8;
DI void fill_rs_table(Frame& F, int nM, int nN, const float* src, bool is_ss) {
    float* tab = (float*)(F.lds + RS_TAB_OFF);
    for (int i = 0; i < RS_TAB_UNITS; ++i) { int pm, pn; if (!static_unit(i, F.G, F.bid, nM, nN, pm, pn)) break;
        if (F.tid < 256) { const float v = src[pm * 256 + F.tid]; tab[i * 256 + F.tid] = is_ss ? rsqrtf(v * (1.0f / D) + RMS_EPS) : v; } }
    __syncthreads();
}
struct EpiZ {
    static constexpr bool PERM = true, AFTER_DRAIN = false;
    bf16* zr; bf16* su; const float* rstab; float* sg1; float* sg2; mutable int ui = 0;
    DI void operator()(const f32x4 (&acc)[2][2][4][2], const Unit& u, int wr, int wc, int fr, int fq) const {
        const int row0 = u.pm * 256 + wr * 64 + fr; const bool isr = u.pn < 7, st = u.pn >= 9;
        bf16* base = isr ? zr : su; const int ldc = isr ? RIN : 1024; const int col0 = (isr ? u.pn : u.pn - 7) * 256 + wc * 32 + 8 * fq;
        float rsv[8];
#pragma unroll
        for (int i = 0; i < 8; ++i) rsv[i] = rstab[ui * 256 + wr * 64 + fr + (i >> 2) * 128 + (i & 3) * 16];
        ++ui;
#pragma unroll
        for (int ai = 0; ai < 2; ++ai)
#pragma unroll
            for (int m = 0; m < 4; ++m) { const int r = row0 + ai * 128 + m * 16; const float rs = rsv[ai * 4 + m]; bf16* rowp = base + (size_t)r * ldc + col0; float s1 = 0.f, s2 = 0.f;
#pragma unroll
                for (int bj = 0; bj < 2; ++bj) { f32x4 v0 = acc[ai][bj][m][0] * rs, v1 = acc[ai][bj][m][1] * rs;
                    if (!isr) {
#pragma unroll
                        for (int j = 0; j < 4; ++j) { v0[j] = gelu_tanh(v0[j]); v1[j] = gelu_tanh(v1[j]); }
#pragma unroll
                        for (int j = 0; j < 4; ++j) { s1 += v0[j] + v1[j]; s2 += v0[j] * v0[j] + v1[j] * v1[j]; } }
                    u32x4 w; w.x = pk2(v0[0], v0[1]); w.y = pk2(v0[2], v0[3]); w.z = pk2(v1[0], v1[1]); w.w = pk2(v1[2], v1[3]);
                    *(u32x4*)(rowp + bj * 128) = w; }
                if (st) { s1 += __shfl_xor(s1, 16); s1 += __shfl_xor(s1, 32); s2 += __shfl_xor(s2, 16); s2 += __shfl_xor(s2, 32);
                    if (fq == 0) { atomicAdd(sg1 + r, s1); atomicAdd(sg2 + r, s2); } } }
    }
};
struct EpiBf {
    static constexpr bool PERM = true, AFTER_DRAIN = false;
    bf16* O; int ldc; const float* ss; float one; int head_stride = 0;
    DI void operator()(const f32x4 (&acc)[2][2][4][2], const Unit& u, int wr, int wc, int fr, int fq) const {
        const int row0 = u.pm * 256 + wr * 64 + fr, col0 = (head_stride ? 0 : u.pn * 256) + wc * 32 + 8 * fq; bf16* Ob = O + (size_t)(head_stride ? u.pn : 0) * head_stride;
        float rsv[8];
#pragma unroll
        for (int i = 0; i < 8; ++i) rsv[i] = ss ? rsqrtf(ss[row0 + (i >> 2) * 128 + (i & 3) * 16] * (1.0f / D) + RMS_EPS) : one;
#pragma unroll
        for (int ai = 0; ai < 2; ++ai)
#pragma unroll
            for (int m = 0; m < 4; ++m) { const int r = row0 + ai * 128 + m * 16; const float rs = rsv[ai * 4 + m]; bf16* rowp = Ob + (size_t)r * ldc + col0;
#pragma unroll
                for (int bj = 0; bj < 2; ++bj) { const f32x4 v0 = acc[ai][bj][m][0] * rs, v1 = acc[ai][bj][m][1] * rs;
                    u32x4 w; w.x = pk2(v0[0], v0[1]); w.y = pk2(v0[2], v0[3]); w.z = pk2(v1[0], v1[1]); w.w = pk2(v1[2], v1[3]);
                    *(u32x4*)(rowp + bj * 128) = w; } }
    }
};
struct EpiRes {
    static constexpr bool PERM = false, AFTER_DRAIN = false;
    const float* basef; const bf16* baseb; bf16* xb; float* ss;
    DI void ld(f32x4 (&d)[4], size_t off) const {
        if (basef) {
#pragma unroll
            for (int q = 0; q < 4; ++q) d[q] = *(const f32x4*)(basef + off + (q >> 1) * 128 + (q & 1) * 16);
        } else {
#pragma unroll
            for (int q = 0; q < 4; ++q) { const u32x2 w = *(const u32x2*)(baseb + off + (q >> 1) * 128 + (q & 1) * 16); d[q] = (f32x4){bflo(w.x), bfhi(w.x), bflo(w.y), bfhi(w.y)}; }
        } }
    DI void operator()(const f32x4 (&acc)[2][2][4][2], const Unit& u, int wr, int wc, int fr, int fq) const {
        const int row0 = u.pm * 256 + wr * 64 + fr, col0 = u.pn * 256 + wc * 32 + 4 * fq;
        f32x4 bc[4], bn[4];
        ld(bc, (size_t)row0 * D + col0);
#pragma unroll
        for (int idx = 0; idx < 8; ++idx) { const int ai = idx >> 2, m = idx & 3; const int r = row0 + ai * 128 + m * 16; const size_t off = (size_t)r * D + col0; float s2 = 0.f;
            if (idx + 1 < 8) ld(bn, (size_t)(row0 + ((idx + 1) >> 2) * 128 + ((idx + 1) & 3) * 16) * D + col0);
#pragma unroll
            for (int bj = 0; bj < 2; ++bj)
#pragma unroll
                for (int n = 0; n < 2; ++n) { const f32x4 o = bc[bj * 2 + n] + acc[ai][bj][m][n];
                    s2 += (o[0] * o[0] + o[1] * o[1]) + (o[2] * o[2] + o[3] * o[3]);
                    u32x2 w; w.x = pk2(o[0], o[1]); w.y = pk2(o[2], o[3]); *(u32x2*)(xb + off + bj * 128 + n * 16) = w; }
            s2 += __shfl_xor(s2, 16); s2 += __shfl_xor(s2, 32);
            if (fq == 0) atomicAdd(ss + r, s2);
#pragma unroll
            for (int q = 0; q < 4; ++q) bc[q] = bn[q];
            asm volatile("" ::: "memory"); }
    }
};
struct EpiFinal {
    static constexpr bool PERM = false, AFTER_DRAIN = true;
    const bf16* base; float* out; float* ss; unsigned* cnt; const float* gf;
    DI void ld(f32x4 (&d)[4], size_t off) const {
#pragma unroll
        for (int q = 0; q < 4; ++q) { const u32x2 w = *(const u32x2*)(base + off + (q >> 1) * 128 + (q & 1) * 16); d[q] = (f32x4){bflo(w.x), bfhi(w.x), bflo(w.y), bfhi(w.y)}; } }
    DI void fused(f32x4 (&acc)[2][2][4][2], const Unit& u, int wr, int wc, int fr, int fq, PG8_LAS unsigned char* lds, int wid, int lane) const {
        const int row0 = u.pm * 256 + wr * 64 + fr, col0 = u.pn * 256 + wc * 32 + 4 * fq;
        f32x4 bc[4], bn[4];
        ld(bc, (size_t)row0 * D + col0);
#pragma unroll
        for (int idx = 0; idx < 8; ++idx) { const int ai = idx >> 2, m = idx & 3; const int r = row0 + ai * 128 + m * 16; float s2 = 0.f;
            if (idx + 1 < 8) ld(bn, (size_t)(row0 + ((idx + 1) >> 2) * 128 + ((idx + 1) & 3) * 16) * D + col0);
#pragma unroll
            for (int bj = 0; bj < 2; ++bj)
#pragma unroll
                for (int n = 0; n < 2; ++n) { const f32x4 o = bc[bj * 2 + n] + acc[ai][bj][m][n]; acc[ai][bj][m][n] = o; s2 += (o[0] * o[0] + o[1] * o[1]) + (o[2] * o[2] + o[3] * o[3]); }
            s2 += __shfl_xor(s2, 16); s2 += __shfl_xor(s2, 32);
            if (fq == 0) atomicAdd(ss + r, s2);
#pragma unroll
            for (int q = 0; q < 4; ++q) bc[q] = bn[q];
            asm volatile("" ::: "memory"); }
        asm volatile("s_waitcnt vmcnt(0)" ::: "memory");
        __syncthreads();
        if (threadIdx.x == 0) { unsigned* c = cnt + 64 * u.pm; __hip_atomic_fetch_add(c, 1u, __ATOMIC_RELAXED, __HIP_MEMORY_SCOPE_AGENT);
            unsigned sp = 0; while (__hip_atomic_load(c, __ATOMIC_RELAXED, __HIP_MEMORY_SCOPE_AGENT) < (unsigned)(D / 256) && ++sp < (1u << 22)) __builtin_amdgcn_s_sleep(1); }
        __syncthreads();
        f32x4 g4[4];
#pragma unroll
        for (int q = 0; q < 4; ++q) g4[q] = *(const f32x4*)(gf + col0 + (q >> 1) * 128 + (q & 1) * 16);
#pragma unroll
        for (int idx = 0; idx < 8; ++idx) { const int ai = idx >> 2, m = idx & 3; const int r = row0 + ai * 128 + m * 16; const size_t off = (size_t)r * D + col0;
            const float rs = rsqrtf(__hip_atomic_load(ss + r, __ATOMIC_RELAXED, __HIP_MEMORY_SCOPE_AGENT) * (1.0f / D) + RMS_EPS);
#pragma unroll
            for (int bj = 0; bj < 2; ++bj)
#pragma unroll
                for (int n = 0; n < 2; ++n) *(f32x4*)(out + off + bj * 128 + n * 16) = acc[ai][bj][m][n] * rs * g4[bj * 2 + n]; }
    }
};
struct EpiSoftmax {
    static constexpr bool PERM = true, AFTER_DRAIN = true;
    bf16* P; const float* ss;
    DI void fused(f32x4 (&acc)[2][2][4][2], const Unit& u, int wr, int wc, int fr, int fq, PG8_LAS unsigned char* lds, int wid, int lane) const {
        PG8_LAS float* red = (PG8_LAS float*)lds;
        const int lrow0 = wr * 64 + fr, grow0 = u.pm * 256 + lrow0;
#pragma unroll
        for (int idx = 0; idx < 8; ++idx) { const int ai = idx >> 2, m = idx & 3, lr = lrow0 + ai * 128 + m * 16; const float rs = rsqrtf(ss[grow0 + ai * 128 + m * 16] * (1.0f / D) + RMS_EPS) * 0.0625f; float mx = -1e30f;
#pragma unroll
            for (int bj = 0; bj < 2; ++bj)
#pragma unroll
                for (int n = 0; n < 2; ++n) { const f32x4 v = acc[ai][bj][m][n] * rs; acc[ai][bj][m][n] = v; mx = fmaxf(mx, fmaxf(fmaxf(v[0], v[1]), fmaxf(v[2], v[3]))); }
            mx = fmaxf(mx, __shfl_xor(mx, 16)); mx = fmaxf(mx, __shfl_xor(mx, 32));
            if (fq == 0) red[lr * 4 + wc] = mx; }
        asm volatile("s_waitcnt lgkmcnt(0)" ::: "memory"); __builtin_amdgcn_s_barrier(); asm volatile("" ::: "memory");
#pragma unroll
        for (int idx = 0; idx < 8; ++idx) { const int ai = idx >> 2, m = idx & 3, lr = lrow0 + ai * 128 + m * 16; const f32x4 m4 = *(const PG8_LAS f32x4*)(red + lr * 4);
            const float mx = fmaxf(fmaxf(m4[0], m4[1]), fmaxf(m4[2], m4[3])); float sm = 0.f;
#pragma unroll
            for (int bj = 0; bj < 2; ++bj)
#pragma unroll
                for (int n = 0; n < 2; ++n) { f32x4 v = acc[ai][bj][m][n];
#pragma unroll
                    for (int e = 0; e < 4; ++e) { v[e] = __expf(v[e] - mx); sm += v[e]; }
                    acc[ai][bj][m][n] = v; }
            sm += __shfl_xor(sm, 16); sm += __shfl_xor(sm, 32);
            if (fq == 0) red[1024 + lr * 4 + wc] = sm; }
        asm volatile("s_waitcnt lgkmcnt(0)" ::: "memory"); __builtin_amdgcn_s_barrier(); asm volatile("" ::: "memory");
#pragma unroll
        for (int idx = 0; idx < 8; ++idx) { const int ai = idx >> 2, m = idx & 3, lr = lrow0 + ai * 128 + m * 16; const f32x4 s4 = *(const PG8_LAS f32x4*)(red + 1024 + lr * 4);
            const float inv = 1.0f / ((s4[0] + s4[1]) + (s4[2] + s4[3])); bf16* rowp = P + (size_t)(grow0 + ai * 128 + m * 16) * D + u.pn * 256 + wc * 32 + 8 * fq;
#pragma unroll
            for (int bj = 0; bj < 2; ++bj) { const f32x4 v0 = acc[ai][bj][m][0] * inv, v1 = acc[ai][bj][m][1] * inv;
                u32x4 w; w.x = pk2(v0[0], v0[1]); w.y = pk2(v0[2], v0[3]); w.z = pk2(v1[0], v1[1]); w.w = pk2(v1[2], v1[3]);
                *(u32x4*)(rowp + bj * 128) = w; } }
    }
};
struct EpiSwi {
    static constexpr bool PERM = true, AFTER_DRAIN = false;
    bf16* H; const float* rstab; mutable int ui = 0;
    DI void operator()(const f32x4 (&acc)[2][2][4][2], const Unit& u, int wr, int wc, int fr, int fq) const {
        const int row0 = u.pm * 256 + wr * 64 + fr, col0 = u.pn * 128 + wc * 32 + 8 * fq;
        float rsv[8];
#pragma unroll
        for (int i = 0; i < 8; ++i) rsv[i] = rstab[ui * 256 + wr * 64 + fr + (i >> 2) * 128 + (i & 3) * 16];
        ++ui;
#pragma unroll
        for (int ai = 0; ai < 2; ++ai)
#pragma unroll
            for (int m = 0; m < 4; ++m) { const int r = row0 + ai * 128 + m * 16; const float rs = rsv[ai * 4 + m]; float h[8];
#pragma unroll
                for (int n = 0; n < 2; ++n)
#pragma unroll
                    for (int j = 0; j < 4; ++j) { const float g = acc[ai][0][m][n][j] * rs, up = acc[ai][1][m][n][j] * rs; h[4 * n + j] = g * up * sigmoidf_(g); }
                u32x4 w; w.x = pk2(h[0], h[1]); w.y = pk2(h[2], h[3]); w.z = pk2(h[4], h[5]); w.w = pk2(h[6], h[7]);
                *(u32x4*)(H + (size_t)r * FF + col0) = w; }
    }
};
struct FewOrder {
    int pm, pn; bool has;
    DI bool next(int i, Unit& u) const { if (i != 0 || !has) return false; u.pm = pm; u.pn = pn; return true; }
    DI void a_ready(const Unit&) const {}
    DI void done(const Unit&) const {}
};

struct TrItem { const float* W; const float* ks; bf16* WT; int K, N, drow0, kb, nb; bool valid; };
DI void tr_load(const TrItem& I, f32x4 (&v)[8], int lane) {
    if (!I.valid) return;
    const int k0 = 64 * I.kb, n0 = 32 * I.nb;
#pragma unroll
    for (int i = 0; i < 8; ++i) { const int kk = (lane >> 3) + 8 * i; v[i] = *(const f32x4*)(I.W + (size_t)(k0 + kk) * I.N + n0 + 4 * (lane & 7)); }
}
DI void tr_finish(const TrItem& I, const f32x4 (&v)[8], float* scr, int lane) {
    if (!I.valid) return;
    const int k0 = 64 * I.kb;
#pragma unroll
    for (int i = 0; i < 8; ++i) { const int kk = (lane >> 3) + 8 * i; const float sc = I.ks ? I.ks[k0 + kk] : 1.0f; float* d = scr + kk * 33 + 4 * (lane & 7);
        d[0] = v[i][0] * sc; d[1] = v[i][1] * sc; d[2] = v[i][2] * sc; d[3] = v[i][3] * sc; }
    LDS_FENCE();
    const int c = lane & 7;
#pragma unroll
    for (int j = 0; j < 4; ++j) { const int n = (lane >> 3) + 8 * j; const float* s = scr + (8 * c) * 33 + n;
        u32x4 o; o.x = pk2(s[0 * 33], s[1 * 33]); o.y = pk2(s[2 * 33], s[3 * 33]); o.z = pk2(s[4 * 33], s[5 * 33]); o.w = pk2(s[6 * 33], s[7 * 33]);
        *(u32x4*)(I.WT + (size_t)(I.drow0 + n) * I.K + k0 + 8 * c) = o; }
    LDS_FENCE();
}
DI TrItem tr_decode(Frame& F, int it, int nitems) {
    TrItem I; I.valid = it < nitems; I.W = nullptr; I.ks = nullptr; I.WT = nullptr; I.K = 0; I.N = 0; I.drow0 = 0; I.kb = 0; I.nb = 0;
    if (!I.valid) return I;
    unsigned char* ws = F.ws; int r = it;
#define TR(Wp, K_, N_, SC, DST, DROW) { constexpr int ni_ = ((K_) / 64) * ((N_) / 32); if (r >= 0 && r < ni_) { I.kb = r / ((N_) / 32); I.nb = r % ((N_) / 32); const int n0 = I.nb * 32; (void)n0; \
            I.W = (Wp); I.K = (K_); I.N = (N_); I.ks = (SC); I.WT = (bf16*)(ws + (DST)); I.drow0 = (DROW); } r -= ni_; }
    TR(F.in[3], D, NIN, F.in[2], WS_WIN, n0)
    TR(F.in[23], D, D, (const float*)nullptr, WS_WK, n0)
    TR(F.in[24], D, D, (const float*)nullptr, WS_WV, n0)
    TR(F.in[6], 64, RW, (const float*)nullptr, WS_WLT, n0)
    TR(F.in[8], 64, RW, (const float*)nullptr, WS_ALT, n0)
    TR(F.in[9], 128, RW, (const float*)nullptr, WS_GLT, n0)
    TR(F.in[27], D, FF, F.in[26], WS_WGU, (n0 / 128) * 256 + (n0 % 128))
    TR(F.in[28], D, FF, F.in[26], WS_WGU, (n0 / 128) * 256 + 128 + (n0 % 128))
    TR(F.in[19], D, D, (const float*)nullptr, WS_WOUT, n0)
    TR(F.in[25] + 0 * 256 * D, 256, D, (const float*)nullptr, WS_WOTH + 0 * (size_t)D * 256 * 2, n0)
    TR(F.in[25] + 1 * 256 * D, 256, D, (const float*)nullptr, WS_WOTH + 1 * (size_t)D * 256 * 2, n0)
    TR(F.in[25] + 2 * 256 * D, 256, D, (const float*)nullptr, WS_WOTH + 2 * (size_t)D * 256 * 2, n0)
    TR(F.in[25] + 3 * 256 * D, 256, D, (const float*)nullptr, WS_WOTH + 3 * (size_t)D * 256 * 2, n0)
    TR(F.in[29], FF, D, (const float*)nullptr, WS_WD, n0)
#undef TR
    return I;
}
constexpr int TR_I_IN = (D / 64) * (NIN / 32), TR_I_SQ = (D / 64) * (D / 32), TR_I_FF = (D / 64) * (FF / 32), TR_I_DN = (FF / 64) * (D / 32), TR_I_L64 = 1 * (RW / 32), TR_I_L128 = 2 * (RW / 32);
constexpr int TR_NITEMS = TR_I_IN + 4 * TR_I_SQ + 2 * TR_I_FF + TR_I_DN + 2 * TR_I_L64 + TR_I_L128, TR_LATE0 = TR_I_IN + 2 * TR_I_SQ + 2 * TR_I_L64 + TR_I_L128 + 0 * TR_I_FF, TR_DN0 = TR_NITEMS - TR_I_DN;
DI void tr_run(Frame& F, int gw, int NGW, int base, int count, int skip_at, int skip_len) {
    float* scr = (float*)(F.lds + F.wid * 16384); const int lane = F.lane;
#define TR_REAL(v_) ((v_) < count ? ((base + (v_)) >= skip_at ? base + (v_) + skip_len : base + (v_)) : TR_NITEMS)
    f32x4 va[8], vb[8];
    TrItem Ia = tr_decode(F, TR_REAL(gw), TR_NITEMS); tr_load(Ia, va, lane);
    for (int it = gw; it < count; it += 2 * NGW) {
        TrItem Ib = tr_decode(F, TR_REAL(it + NGW), TR_NITEMS); tr_load(Ib, vb, lane);
        tr_finish(Ia, va, scr, lane);
        Ia = tr_decode(F, TR_REAL(it + 2 * NGW), TR_NITEMS); tr_load(Ia, va, lane);
        tr_finish(Ib, vb, scr, lane);
    }
#undef TR_REAL
}
DI void p0_prologue(Frame& F) {
    const int gw = F.bid * NWAVES + F.wid, NGW = F.G * NWAVES, lane = F.lane;
    unsigned char* ws = F.ws;
    tr_run(F, gw, NGW, 0, TR_LATE0, 1 << 30, 0);
    const float* x = F.in[0]; bf16* xb = (bf16*)(ws + WS_XB); float* rs0 = (float*)(ws + WS_RS0);
    { f32x4 vn[4];
#pragma unroll
      for (int j = 0; j < 4; ++j) vn[j] = ((const f32x4*)(x + (size_t)gw * D) + lane)[64 * j];
      for (int m = gw; m < T; m += NGW) {
        f32x4 v[4]; float s = 0.f;
#pragma unroll
        for (int j = 0; j < 4; ++j) { v[j] = vn[j]; s += (v[j][0] * v[j][0] + v[j][1] * v[j][1]) + (v[j][2] * v[j][2] + v[j][3] * v[j][3]); }
        if (m + NGW < T) {
#pragma unroll
            for (int j = 0; j < 4; ++j) vn[j] = ((const f32x4*)(x + (size_t)(m + NGW) * D) + lane)[64 * j]; }
        s = wave_sum(s);
        if (lane == 0) rs0[m] = rsqrtf(s * (1.0f / D) + RMS_EPS);
        u32x2* o8 = (u32x2*)(xb + (size_t)m * D) + lane;
#pragma unroll
        for (int j = 0; j < 4; ++j) { u32x2 w; w.x = pk2(v[j][0], v[j][1]); w.y = pk2(v[j][2], v[j][3]); o8[64 * j] = w; }
      } }
    { const float* wq = F.in[22]; const float* g2 = F.in[20]; bf16* wqu = (bf16*)(ws + WS_WQ);
      for (int k = gw; k < D; k += NGW) { const float gk = g2[k];
#pragma unroll
          for (int j = 0; j < 4; ++j) { const f32x4 v = ((const f32x4*)(wq + (size_t)k * D) + lane)[64 * j]; u32x2 w; w.x = pk2(v[0] * gk, v[1] * gk); w.y = pk2(v[2] * gk, v[3] * gk);
              *(u32x2*)(wqu + (size_t)j * D * 256 + (size_t)k * 256 + 4 * lane) = w; } } }
    const float* mem = F.in[1]; const float* mg = F.in[21]; bf16* mb = (bf16*)(ws + WS_MB);
    for (int m = gw; m < MEM; m += NGW) {
        const f32x4* xr = (const f32x4*)(mem + (size_t)m * D) + lane; f32x4 v[4]; float s = 0.f;
#pragma unroll
        for (int j = 0; j < 4; ++j) { v[j] = xr[64 * j]; s += (v[j][0] * v[j][0] + v[j][1] * v[j][1]) + (v[j][2] * v[j][2] + v[j][3] * v[j][3]); }
        s = wave_sum(s); const float rs = rsqrtf(s * (1.0f / D) + RMS_EPS);
        u32x2* o8 = (u32x2*)(mb + (size_t)m * D) + lane;
#pragma unroll
        for (int j = 0; j < 4; ++j) { const f32x4 g = ((const f32x4*)mg)[lane + 64 * j]; u32x2 w; w.x = pk2(v[j][0] * rs * g[0], v[j][1] * rs * g[1]); w.y = pk2(v[j][2] * rs * g[2], v[j][3] * rs * g[3]); o8[64 * j] = w; }
    }
    const float* wsp = F.in[17]; bf16* wsb = (bf16*)(ws + WS_WSB);
    for (int e = F.bid * NTHR + F.tid; e < 8 * 128 * 128; e += F.G * NTHR) { const int i = (e >> 7) & 127, j = e & 127; wsb[e] = (bf16)(pk2(j <= i ? wsp[e] : 0.f, 0.f) & 0xffffu); }
}

DI f32x4 load_shift4(const bf16* zrow, int col, int t, const float* mu) {
    const u32x2 a = *(const u32x2*)(zrow + col); u32x2 p = (u32x2){0u, 0u}; if (t > 0) p = *(const u32x2*)(zrow - RIN + col);
    const f32x4 m4 = *(const f32x4*)(mu + col); const f32x4 z = (f32x4){bflo(a.x), bfhi(a.x), bflo(a.y), bfhi(a.y)}, pz = (f32x4){bflo(p.x), bfhi(p.x), bflo(p.y), bfhi(p.y)};
    return z + (pz - z) * m4; }
template <int N> DI float dpp_shr(float v, float old) { return __builtin_bit_cast(float, __builtin_amdgcn_update_dpp(__builtin_bit_cast(int, old), __builtin_bit_cast(int, v), 0x110 + N, 0xF, 0xF, false)); }
DI float scan16_mul(float x) { x *= dpp_shr<1>(x, 1.0f); x *= dpp_shr<2>(x, 1.0f); x *= dpp_shr<4>(x, 1.0f); x *= dpp_shr<8>(x, 1.0f); return x; }
DI void prep_phase(Frame& F) {
    unsigned char* ws = F.ws; const int tid = F.tid, lane = F.lane, h = F.wid, fr = lane & 15, fq = lane >> 4;
    const bf16* zr = (const bf16*)(ws + WS_ZR); const float* mu = F.in[4];
    const bf16* WlT = (const bf16*)(ws + WS_WLT); const bf16* AlT = (const bf16*)(ws + WS_ALT); const bf16* GlT = (const bf16*)(ws + WS_GLT);
    const float *w0 = F.in[5], *a0 = F.in[7], *k_k = F.in[10], *k_a = F.in[11], *r_k = F.in[12];
    float* G16 = (float*)(ws + WS_G16); float* KK = F.out + (size_t)T * RW; float* Bb = (float*)(ws + WS_B);
    bf16* Rb = (bf16*)(ws + WS_R); bf16* Vb = (bf16*)(ws + WS_V); bf16* KPb = (bf16*)(ws + WS_KP); bf16* Gb = (bf16*)(ws + WS_G); float* bonus = (float*)(ws + WS_BON);
    unsigned char* AL = F.lds;
    const float gone = F.G > (1 << 20) ? 2.0f : 1.0f;
    for (int tile = F.bid; tile < T / 64; tile += F.G) {
        const int t0 = tile * 64;
        __syncthreads();
        { const int tk = tid >> 3, cs = (tid & 7) * 32, t = t0 + tk, kind = cs < 64 ? 0 : (cs < 128 ? 1 : 2);
          const bf16* zrow = zr + (size_t)t * RIN + 1536 + cs;
#pragma unroll
          for (int q = 0; q < 4; ++q) { const u32x4 a = *(const u32x4*)(zrow + 8 * q); u32x4 p = (u32x4){0u, 0u, 0u, 0u}; if (t > 0) p = *(const u32x4*)(zrow - RIN + 8 * q);
              float o[8];
#pragma unroll
              for (int e2 = 0; e2 < 4; ++e2) { const float z0 = bflo(a[e2]), z1 = bfhi(a[e2]), p0 = bflo(p[e2]), p1 = bfhi(p[e2]);
                  const float m0 = mu[1536 + cs + 8 * q + 2 * e2], m1 = mu[1536 + cs + 8 * q + 2 * e2 + 1];
                  float h0 = z0 + (p0 - z0) * m0, h1 = z1 + (p1 - z1) * m1;
                  if (kind == 0) { h0 = 1.0f - 2.0f * __builtin_amdgcn_rcpf(1.0f + __expf(2.0f * h0)); h1 = 1.0f - 2.0f * __builtin_amdgcn_rcpf(1.0f + __expf(2.0f * h1)); }
                  if (kind == 2) { h0 = sigmoidf_(h0); h1 = sigmoidf_(h1); }
                  o[2 * e2] = h0; o[2 * e2 + 1] = h1; }
              u32x4 w; w.x = pk2(o[0], o[1]); w.y = pk2(o[2], o[3]); w.z = pk2(o[4], o[5]); w.w = pk2(o[6], o[7]);
              *(u32x4*)(AL + tk * 528 + (cs + 8 * q) * 2) = w; } }
        __syncthreads();
        float inv[4], bon[4];
#pragma unroll
        for (int mt = 0; mt < 4; ++mt) { const int t = t0 + 16 * mt + fr; const bf16* zrow = zr + (size_t)t * RIN; float ssq = 0.f;
#pragma unroll
            for (int nt = 0; nt < 4; ++nt) { const int c = 64 * h + 16 * nt + 4 * fq; const f32x4 k4 = load_shift4(zrow, 512 + c, t, mu); const f32x4 kk4 = *(const f32x4*)(k_k + c);
#pragma unroll
                for (int e = 0; e < 4; ++e) { const float q = k4[e] * kk4[e]; ssq += q * q; } }
            ssq += __shfl_xor(ssq, 16); ssq += __shfl_xor(ssq, 32);
            inv[mt] = 1.0f / fmaxf(sqrtf(ssq), 1e-12f); bon[mt] = 0.f; }
#pragma unroll 1
        for (int nt = 0; nt < 4; ++nt) {
            const int n = 64 * h + 16 * nt + fr, c = 64 * h + 16 * nt + 4 * fq;
            bf16x8 bw[2], ba[2], bg[4];
#pragma unroll
            for (int ks = 0; ks < 2; ++ks) { bw[ks] = *(const bf16x8*)(WlT + n * 64 + 32 * ks + 8 * fq); ba[ks] = *(const bf16x8*)(AlT + n * 64 + 32 * ks + 8 * fq); }
#pragma unroll
            for (int ks = 0; ks < 4; ++ks) bg[ks] = *(const bf16x8*)(GlT + n * 128 + 32 * ks + 8 * fq);
            const f32x4 w04 = *(const f32x4*)(w0 + c), a04 = *(const f32x4*)(a0 + c), kk4 = *(const f32x4*)(k_k + c), ka4 = *(const f32x4*)(k_a + c), rk4 = *(const f32x4*)(r_k + c);
#pragma unroll
            for (int mt = 0; mt < 4; ++mt) {
                const int t = t0 + 16 * mt + fr; const bf16* zrow = zr + (size_t)t * RIN; const size_t o = (size_t)t * RW + c;
                const f32x4 r4 = load_shift4(zrow, c, t, mu), k4 = load_shift4(zrow, 512 + c, t, mu), v4 = load_shift4(zrow, 1024 + c, t, mu);
                f32x4 aw = (f32x4){0.f, 0.f, 0.f, 0.f}, aa = aw, ag = aw;
                const unsigned char* arow = AL + (16 * mt + fr) * 528 + 16 * fq;
#pragma unroll
                for (int ks = 0; ks < 2; ++ks) { aw = MFMA16(bw[ks], *(const bf16x8*)(arow + 64 * ks), aw); aa = MFMA16(ba[ks], *(const bf16x8*)(arow + 128 + 64 * ks), aa); }
#pragma unroll
                for (int ks = 0; ks < 4; ++ks) ag = MFMA16(bg[ks], *(const bf16x8*)(arow + 256 + 64 * ks), ag);
                f32x4 dw, dk, db; float kp[4];
#pragma unroll
                for (int e = 0; e < 4; ++e) { const float wl = w04[e] + aw[e];
                    dw[e] = __expf(-0.6065306597f * sigmoidf_(wl));
                    const float a = sigmoidf_(a04[e] + aa[e]);
                    const float kkv = k4[e] * kk4[e] * inv[mt]; dk[e] = kkv; db[e] = kkv * a;
                    kp[e] = k4[e] * (1.0f + (a - 1.0f) * ka4[e]); bon[mt] += r4[e] * kp[e] * rk4[e]; }
                f32x4 gi, ge, gr;
#pragma unroll
                for (int e = 0; e < 4; ++e) { gi[e] = scan16_mul(dw[e]); ge[e] = dpp_shr<1>(gi[e], 1.0f); gr[e] = __builtin_amdgcn_rcpf(gi[e]); }
                if (fr == 15) *(f32x4*)(G16 + (size_t)(t >> 4) * RW + c) = gi;
                *(f32x4*)(KK + o) = dk * ge; *(f32x4*)(Bb + o) = db * gr;
                u32x2 w; w.x = pk2(r4[0] * gi[0], r4[1] * gi[1]); w.y = pk2(r4[2] * gi[2], r4[3] * gi[3]); *(u32x2*)(Rb + o) = w;
                w.x = pk2(v4[0], v4[1]); w.y = pk2(v4[2], v4[3]); *(u32x2*)(Vb + o) = w;
                w.x = pk2(kp[0] * gr[0], kp[1] * gr[1]); w.y = pk2(kp[2] * gr[2], kp[3] * gr[3]); *(u32x2*)(KPb + o) = w;
                { const f32x4 gv = ag * gone;
                  w.x = pk2(gv[0], gv[1]); w.y = pk2(gv[2], gv[3]); *(u32x2*)(Gb + o) = w; }
                asm volatile("" ::: "memory");
            }
        }
#pragma unroll
        for (int mt = 0; mt < 4; ++mt) { float bsum = bon[mt]; bsum += __shfl_xor(bsum, 16); bsum += __shfl_xor(bsum, 32); if (fq == 0) bonus[(size_t)(t0 + 16 * mt + fr) * 8 + h] = bsum; }
    }
}

DI void sgu_items(Frame& F, int first, int stride) {
    unsigned char* ws = F.ws; const int lane = F.lane, fr = lane & 15, fq = lane >> 4;
    const bf16* su = (const bf16*)(ws + WS_SU); bf16* mix = (bf16*)(ws + WS_MIX); const bf16* wsb = (const bf16*)(ws + WS_WSB);
    const float* sg1 = (const float*)(ws + WS_CTL) + 3 * T; const float* sg2 = sg1 + T; const float *lnw = F.in[15], *lnb = F.in[16], *bsp = F.in[18];
    unsigned char* vnT = F.lds + F.wid * 17408;
    for (int item = first; item < 1024; item += stride) {
        const int nb = item >> 3, g = item & 7; constexpr int KJ = 128;
        LDS_FENCE();
        { const int chunk = lane & 7, jp = lane >> 3;
          const f32x4 lw0 = *(const f32x4*)(lnw + 64 * g + 8 * chunk), lw1 = *(const f32x4*)(lnw + 64 * g + 8 * chunk + 4), lb0 = *(const f32x4*)(lnb + 64 * g + 8 * chunk), lb1 = *(const f32x4*)(lnb + 64 * g + 8 * chunk + 4);
          const float lwv[8] = {lw0[0], lw0[1], lw0[2], lw0[3], lw1[0], lw1[1], lw1[2], lw1[3]}, lbv[8] = {lb0[0], lb0[1], lb0[2], lb0[3], lb1[0], lb1[1], lb1[2], lb1[3]};
          u32x4 a0[8], a1[8]; float m0[8], m1[8], q0[8], q1[8];
#pragma unroll
          for (int it = 0; it < 8; ++it) if (it < KJ / 16) { const int tok = 128 * nb + 2 * (jp + 8 * it);
              a0[it] = *(const u32x4*)(su + (size_t)tok * 1024 + 512 + 64 * g + 8 * chunk); a1[it] = *(const u32x4*)(su + (size_t)(tok + 1) * 1024 + 512 + 64 * g + 8 * chunk);
              m0[it] = sg1[tok]; m1[it] = sg1[tok + 1]; q0[it] = sg2[tok]; q1[it] = sg2[tok + 1]; }
#pragma unroll
          for (int it = 0; it < 8; ++it) if (it < KJ / 16) { const int j = 2 * (jp + 8 * it);
              const float mm0 = m0[it] * (1.0f / 512), mm1 = m1[it] * (1.0f / 512);
              const float r0 = rsqrtf(fmaxf(q0[it] * (1.0f / 512) - mm0 * mm0, 0.f) + 1e-5f), r1 = rsqrtf(fmaxf(q1[it] * (1.0f / 512) - mm1 * mm1, 0.f) + 1e-5f);
#pragma unroll
              for (int e2 = 0; e2 < 4; ++e2) {
                  const float x0a = (bflo(a0[it][e2]) - mm0) * r0 * lwv[2 * e2] + lbv[2 * e2], x0b = (bfhi(a0[it][e2]) - mm0) * r0 * lwv[2 * e2 + 1] + lbv[2 * e2 + 1];
                  const float x1a = (bflo(a1[it][e2]) - mm1) * r1 * lwv[2 * e2] + lbv[2 * e2], x1b = (bfhi(a1[it][e2]) - mm1) * r1 * lwv[2 * e2 + 1] + lbv[2 * e2 + 1];
                  *(unsigned*)(vnT + (8 * chunk + 2 * e2) * 272 + j * 2) = pk2(x0a, x1a);
                  *(unsigned*)(vnT + (8 * chunk + 2 * e2 + 1) * 272 + j * 2) = pk2(x0b, x1b); } } }
        LDS_FENCE();
#pragma unroll 1
        for (int hf = 0; hf < 2; ++hf) {
        f32x4 acc[4][4];
#pragma unroll
        for (int a = 0; a < 4; ++a)
#pragma unroll
            for (int b = 0; b < 4; ++b) acc[a][b] = (f32x4){0.f, 0.f, 0.f, 0.f};
#pragma unroll
        for (int ks = 0; ks < 4; ++ks) if (ks < 2 * (hf + 1)) {
            bf16x8 bfv[4];
#pragma unroll
            for (int ct = 0; ct < 4; ++ct) bfv[ct] = *(const bf16x8*)(vnT + (16 * ct + fr) * 272 + (32 * ks + 8 * fq) * 2);
#pragma unroll
            for (int it = 0; it < 4; ++it) { const int i = 64 * hf + 16 * it + fr; const bf16x8 af = *(const bf16x8*)(wsb + (size_t)(g * 128 + i) * 128 + 32 * ks + 8 * fq);
#pragma unroll
                for (int ct = 0; ct < 4; ++ct) acc[it][ct] = MFMA16(bfv[ct], af, acc[it][ct]); } }
        u32x2 uu[4][4]; float bias[4];
#pragma unroll
        for (int it = 0; it < 4; ++it) { const int i = 64 * hf + 16 * it + fr, tok = 128 * nb + i; bias[it] = bsp[g * 128 + i];
#pragma unroll
            for (int ct = 0; ct < 4; ++ct) uu[it][ct] = *(const u32x2*)(su + (size_t)tok * 1024 + 64 * g + 16 * ct + 4 * fq); }
#pragma unroll
        for (int it = 0; it < 4; ++it) { const int i = 64 * hf + 16 * it + fr, tok = 128 * nb + i;
#pragma unroll
            for (int ct = 0; ct < 4; ++ct) { const int c = 64 * g + 16 * ct + 4 * fq; const u32x2 u2 = uu[it][ct];
                u32x2 w; w.x = pk2(bflo(u2.x) * (acc[it][ct][0] + bias[it]), bfhi(u2.x) * (acc[it][ct][1] + bias[it])); w.y = pk2(bflo(u2.y) * (acc[it][ct][2] + bias[it]), bfhi(u2.y) * (acc[it][ct][3] + bias[it]));
                *(u32x2*)(mix + (size_t)tok * 1024 + 512 + c) = w; } }
        }
    }
}

DI float dpp_x1(float v) { return __builtin_bit_cast(float, __builtin_amdgcn_update_dpp(0, __builtin_bit_cast(int, v), 0xB1, 0xF, 0xF, true)); }
DI float dpp_x2(float v) { return __builtin_bit_cast(float, __builtin_amdgcn_update_dpp(0, __builtin_bit_cast(int, v), 0x4E, 0xF, 0xF, true)); }
DI float dpp_hm(float v) { return __builtin_bit_cast(float, __builtin_amdgcn_update_dpp(0, __builtin_bit_cast(int, v), 0x141, 0xF, 0xF, true)); }
DI float red8(float p) { p += dpp_x1(p); p += dpp_x2(p); p += dpp_hm(p); return p; }
#define RED8X4(a, b, c, d) asm volatile("s_nop 1\n\t" \
    "v_add_f32_dpp %0, %0, %0 quad_perm:[1,0,3,2] row_mask:0xf bank_mask:0xf\n\tv_add_f32_dpp %1, %1, %1 quad_perm:[1,0,3,2] row_mask:0xf bank_mask:0xf\n\t" \
    "v_add_f32_dpp %2, %2, %2 quad_perm:[1,0,3,2] row_mask:0xf bank_mask:0xf\n\tv_add_f32_dpp %3, %3, %3 quad_perm:[1,0,3,2] row_mask:0xf bank_mask:0xf\n\t" \
    "v_add_f32_dpp %0, %0, %0 quad_perm:[2,3,0,1] row_mask:0xf bank_mask:0xf\n\tv_add_f32_dpp %1, %1, %1 quad_perm:[2,3,0,1] row_mask:0xf bank_mask:0xf\n\t" \
    "v_add_f32_dpp %2, %2, %2 quad_perm:[2,3,0,1] row_mask:0xf bank_mask:0xf\n\tv_add_f32_dpp %3, %3, %3 quad_perm:[2,3,0,1] row_mask:0xf bank_mask:0xf\n\t" \
    "v_add_f32_dpp %0, %0, %0 row_half_mirror row_mask:0xf bank_mask:0xf\n\tv_add_f32_dpp %1, %1, %1 row_half_mirror row_mask:0xf bank_mask:0xf\n\t" \
    "v_add_f32_dpp %2, %2, %2 row_half_mirror row_mask:0xf bank_mask:0xf\n\tv_add_f32_dpp %3, %3, %3 row_half_mirror row_mask:0xf bank_mask:0xf\n\ts_nop 1" \
    : "+v"(a), "+v"(b), "+v"(c), "+v"(d))
constexpr int SC = 16, NSC = LCH / SC, SARR = SC * 64, SBUF = 6 * SARR, SGRP = 2 * SBUF;
DI void split8(const f32x4& x0, const f32x4& x1, bf16x8& hi, bf16x8& lo) {
    unsigned hb[8], lb[8];
#pragma unroll
    for (int e = 0; e < 8; ++e) { const float x = e < 4 ? x0[e & 3] : x1[e & 3]; hb[e] = __float_as_uint(x) & 0xffff0000u; lb[e] = __float_as_uint(x - __uint_as_float(hb[e])); }
    u32x4 h, l;
#pragma unroll
    for (int p = 0; p < 4; ++p) { h[p] = (hb[2 * p] >> 16) | hb[2 * p + 1]; l[p] = (lb[2 * p] >> 16) | (lb[2 * p + 1] & 0xffff0000u); }
    hi = __builtin_bit_cast(bf16x8, h); lo = __builtin_bit_cast(bf16x8, l);
}
DI void unpack8(const u32x4& wa, const u32x4& wb, bf16x8& hi, bf16x8& lo) {
    u32x4 h, l;
    h[0] = (wa[0] >> 16) | (wa[1] & 0xffff0000u); h[1] = (wa[2] >> 16) | (wa[3] & 0xffff0000u); h[2] = (wb[0] >> 16) | (wb[1] & 0xffff0000u); h[3] = (wb[2] >> 16) | (wb[3] & 0xffff0000u);
    l[0] = (wa[0] & 0xffffu) | (wa[1] << 16); l[1] = (wa[2] & 0xffffu) | (wa[3] << 16); l[2] = (wb[0] & 0xffffu) | (wb[1] << 16); l[3] = (wb[2] & 0xffffu) | (wb[3] << 16);
    hi = __builtin_bit_cast(bf16x8, h); lo = __builtin_bit_cast(bf16x8, l);
}
DI unsigned presplit(float x) { const unsigned hb = __float_as_uint(x) & 0xffff0000u; return hb | (__float_as_uint(x - __uint_as_float(hb)) >> 16); }
template <bool ISP> DI void scan1_chunk(const float* gl, float* gst, int NSCc, const float* G16, const float* KK, const float* Bb, const bf16* KPb, const bf16* Vb, const bf16* Rb,
                                         float* OUTY, int tb, int h, int gt, int srow0, int kg, f32x2 (&s)[4][4]) {
    const int lstep = gt >> 4, lc4 = (gt & 15) * 4;
    f32x4 lkk, lb; u32x2 lkp, lv, lr;
#define SCAN_LOAD(sc_) do { const size_t o_ = (size_t)(tb + (sc_) * SC + lstep) * RW + h * 64 + lc4; lkk = *(const f32x4*)(KK + o_); lb = *(const f32x4*)(Bb + o_); \
        lkp = *(const u32x2*)(KPb + o_); lv = *(const u32x2*)(Vb + o_); lr = *(const u32x2*)(Rb + o_); } while (0)
#define SCAN_STORE(b_) do { float* d_ = gst + (b_) * SBUF + lstep * 64 + lc4; *(f32x4*)(d_ + SARR) = lkk; *(f32x4*)(d_ + 2 * SARR) = lb; \
        *(f32x4*)(d_ + 3 * SARR) = (f32x4){bflo(lkp.x), bfhi(lkp.x), bflo(lkp.y), bfhi(lkp.y)}; *(f32x4*)(d_ + 4 * SARR) = (f32x4){bflo(lv.x), bfhi(lv.x), bflo(lv.y), bfhi(lv.y)}; \
        *(f32x4*)(d_ + 5 * SARR) = (f32x4){bflo(lr.x), bfhi(lr.x), bflo(lr.y), bfhi(lr.y)}; } while (0)
    __syncthreads();
    SCAN_LOAD(0); SCAN_STORE(0);
    __syncthreads();
    for (int sc = 0; sc < NSCc; ++sc) {
        const float* bf = gl + (sc & 1) * SBUF;
        if (sc + 1 < NSCc) SCAN_LOAD(sc + 1);
        const float* gp_ = G16 + (size_t)((tb >> 4) + sc) * RW + h * 64 + 8 * kg; const f32x4 gq0 = *(const f32x4*)gp_, gq1 = *(const f32x4*)(gp_ + 4);
#pragma unroll 2
        for (int st = 0; st < SC; ++st) {
            const float* p = bf + st * 64 + 8 * kg;
            const f32x4 k0 = *(const f32x4*)(p + SARR), k1 = *(const f32x4*)(p + SARR + 4), b0 = *(const f32x4*)(p + 2 * SARR), b1 = *(const f32x4*)(p + 2 * SARR + 4),
                        r0 = *(const f32x4*)(p + 5 * SARR), r1 = *(const f32x4*)(p + 5 * SARR + 4);
            const f32x2 k2[4] = {k0.xy, k0.zw, k1.xy, k1.zw}, b2[4] = {b0.xy, b0.zw, b1.xy, b1.zw}, r2[4] = {r0.xy, r0.zw, r1.xy, r1.zw};
            f32x2 q2[4]; f32x4 v4 = (f32x4){0.f, 0.f, 0.f, 0.f};
            if (!ISP) { const f32x4 q0 = *(const f32x4*)(p + 3 * SARR), q1 = *(const f32x4*)(p + 3 * SARR + 4); v4 = *(const f32x4*)(bf + 4 * SARR + st * 64 + srow0);
                q2[0] = q0.xy; q2[1] = q0.zw; q2[2] = q1.xy; q2[3] = q1.zw; }
            float pd[4], yd[4];
#pragma unroll
            for (int i = 0; i < 4; ++i) { f32x2 a = s[i][0] * k2[0]; a = s[i][1] * k2[1] + a; a = s[i][2] * k2[2] + a; a = s[i][3] * k2[3] + a; pd[i] = a.x + a.y; }
            RED8X4(pd[0], pd[1], pd[2], pd[3]);
#pragma unroll
            for (int i = 0; i < 4; ++i) { const f32x2 n2 = (f32x2){-pd[i], -pd[i]};
                if (ISP) {
#pragma unroll
                    for (int j = 0; j < 4; ++j) s[i][j] = s[i][j] + n2 * b2[j];
                } else { const f32x2 vv2 = (f32x2){v4[i], v4[i]};
#pragma unroll
                    for (int j = 0; j < 4; ++j) s[i][j] = vv2 * q2[j] + (n2 * b2[j] + s[i][j]);
                }
                f32x2 y = s[i][0] * r2[0]; y = s[i][1] * r2[1] + y; y = s[i][2] * r2[2] + y; y = s[i][3] * r2[3] + y; yd[i] = y.x + y.y; }
            RED8X4(yd[0], yd[1], yd[2], yd[3]);
            const f32x4 yv = (f32x4){yd[0], yd[1], yd[2], yd[3]};
            if (kg == 0) *(f32x4*)(OUTY + (size_t)(tb + sc * SC + st) * RW + h * 64 + srow0) = yv;
        }
        { const f32x2 g2[4] = {gq0.xy, gq0.zw, gq1.xy, gq1.zw};
#pragma unroll
          for (int i = 0; i < 4; ++i)
#pragma unroll
              for (int j = 0; j < 4; ++j) s[i][j] = s[i][j] * g2[j]; }
        if (sc + 1 < NSCc) SCAN_STORE((sc + 1) & 1);
        asm volatile("s_waitcnt lgkmcnt(0)" ::: "memory"); __builtin_amdgcn_s_barrier(); asm volatile("" ::: "memory");
    }
#undef SCAN_LOAD
#undef SCAN_STORE
}
DI void scan_pass1(Frame& F) {
    unsigned char* ws = F.ws; const int lane = F.lane, grp = F.wid >> 2, w4 = F.wid & 3, gt = F.tid & 255, rs = lane >> 3, kg = lane & 7;
    float* Wd = F.out; float* KK = F.out + (size_t)T * RW; const float* Bb = (const float*)(ws + WS_B); const float* G16 = (const float*)(ws + WS_G16);
    const bf16* Rb = (const bf16*)(ws + WS_R); const bf16* Vb = (const bf16*)(ws + WS_V); const bf16* KPb = (const bf16*)(ws + WS_KP);
    float* PT = (float*)(ws + WS_PT); float* SL = (float*)(ws + WS_SLOC);
    float* gl = (float*)F.lds + grp * SGRP;
    for (int pair0 = F.bid * 2; pair0 < NC * 8; pair0 += F.G * 2) {
        const int pair = pair0 + grp, c = pair >> 3, h = pair & 7, tb = c * LCH;
        const int vrow0 = 32 * ((w4 + 2 * grp) & 3) + 4 * rs;
        const bool isP = vrow0 < 64; const int srow0 = vrow0 & 63;
        f32x2 s[4][4];
#pragma unroll
        for (int i = 0; i < 4; ++i)
#pragma unroll
            for (int j = 0; j < 4; ++j) s[i][j] = (f32x2){(isP && (srow0 + i == 8 * kg + 2 * j)) ? 1.f : 0.f, (isP && (srow0 + i == 8 * kg + 2 * j + 1)) ? 1.f : 0.f};
        if (isP) {
            scan1_chunk<true>(gl, gl, NSC, G16, KK, Bb, KPb, Vb, Rb, Wd, tb, h, gt, srow0, kg, s);
#pragma unroll
            for (int j = 0; j < 8; ++j) *(u32x4*)(PT + ((size_t)(c * 8 + h) * 64 + 8 * kg + j) * 64 + srow0) = (u32x4){presplit(s[0][j >> 1][j & 1]), presplit(s[1][j >> 1][j & 1]), presplit(s[2][j >> 1][j & 1]), presplit(s[3][j >> 1][j & 1])};
        } else {
            scan1_chunk<false>(gl, gl, NSC, G16, KK, Bb, KPb, Vb, Rb, KK, tb, h, gt, srow0, kg, s);
#pragma unroll
            for (int i = 0; i < 4; ++i) { float* sp = SL + ((size_t)(c * 8 + h) * 64 + srow0 + i) * 64 + 8 * kg;
                *(f32x4*)sp = (f32x4){s[i][0].x, s[i][0].y, s[i][1].x, s[i][1].y}; *(f32x4*)(sp + 4) = (f32x4){s[i][2].x, s[i][2].y, s[i][3].x, s[i][3].y}; }
        }
    }
}
DI void scan_pass3(Frame& F) {
    unsigned char* ws = F.ws; const int lane = F.lane, grp = F.wid >> 2, w4 = F.wid & 3, fr = lane & 15, fq = lane >> 4;
    const float* QT = F.out; const float* YL = F.out + (size_t)T * RW; const float* SST = (const float*)(ws + WS_SST);
    const bf16* Vb = (const bf16*)(ws + WS_V); const bf16* Gb = (const bf16*)(ws + WS_G); const float* bonus = (const float*)(ws + WS_BON); bf16* mix = (bf16*)(ws + WS_MIX);
    const float *lnxw = F.in[13], *lnxb = F.in[14];
    for (int pair0 = F.bid * 2; pair0 < NC * 8; pair0 += F.G * 2) {
        const int pair = pair0 + grp, c = pair >> 3, h = pair & 7, tb = c * LCH;
        f32x4 sst[4][4];
#pragma unroll
        for (int vt = 0; vt < 4; ++vt)
#pragma unroll
            for (int g4 = 0; g4 < 4; ++g4) sst[vt][g4] = *(const f32x4*)(SST + ((size_t)(c * 8 + h) * 64 + 16 * vt + fr) * 64 + 16 * g4 + 4 * fq);
        bf16x8 ah[4][2], al[4][2];
#pragma unroll
        for (int vt = 0; vt < 4; ++vt)
#pragma unroll
            for (int s2 = 0; s2 < 2; ++s2) split8(sst[vt][2 * s2], sst[vt][2 * s2 + 1], ah[vt][s2], al[vt][s2]);
#pragma unroll 1
        for (int tt = 0; tt < LCH / 64; ++tt) {
            const int t = tb + 16 * (w4 * (LCH / 64) + tt) + fr; const size_t o = (size_t)t * RW + h * 64;
            f32x4 q[4], acc[4]; u32x2 v2a[4], g2a[4];
#pragma unroll
            for (int g4 = 0; g4 < 4; ++g4) { q[g4] = *(const f32x4*)(QT + o + 16 * g4 + 4 * fq); acc[g4] = *(const f32x4*)(YL + o + 16 * g4 + 4 * fq); }
#pragma unroll
            for (int g4 = 0; g4 < 4; ++g4) { v2a[g4] = *(const u32x2*)(Vb + o + 16 * g4 + 4 * fq); g2a[g4] = *(const u32x2*)(Gb + o + 16 * g4 + 4 * fq); }
            const float bo = bonus[(size_t)t * 8 + h];
            bf16x8 bh[2], bl[2];
#pragma unroll
            for (int s2 = 0; s2 < 2; ++s2) split8(q[2 * s2], q[2 * s2 + 1], bh[s2], bl[s2]);
#pragma unroll
            for (int vt = 0; vt < 4; ++vt)
#pragma unroll
                for (int s2 = 0; s2 < 2; ++s2) { acc[vt] = MFMA16(ah[vt][s2], bh[s2], acc[vt]); acc[vt] = MFMA16(ah[vt][s2], bl[s2], acc[vt]); acc[vt] = MFMA16(al[vt][s2], bh[s2], acc[vt]); }
            float sm = 0.f;
#pragma unroll
            for (int vt = 0; vt < 4; ++vt) sm += (acc[vt][0] + acc[vt][1]) + (acc[vt][2] + acc[vt][3]);
            sm += __shfl_xor(sm, 16); sm += __shfl_xor(sm, 32);
            const float mean = sm * (1.0f / 64); float qq = 0.f;
#pragma unroll
            for (int vt = 0; vt < 4; ++vt) { acc[vt] = acc[vt] - mean; qq += (acc[vt][0] * acc[vt][0] + acc[vt][1] * acc[vt][1]) + (acc[vt][2] * acc[vt][2] + acc[vt][3] * acc[vt][3]); }
            qq += __shfl_xor(qq, 16); qq += __shfl_xor(qq, 32);
            const float rstd = rsqrtf(qq * (1.0f / 64) + 64e-5f);
#pragma unroll
            for (int vt = 0; vt < 4; ++vt) { const int c4 = 16 * vt + 4 * fq; const f32x4 lw4 = *(const f32x4*)(lnxw + h * 64 + c4), lb4 = *(const f32x4*)(lnxb + h * 64 + c4);
                const u32x2 v2 = v2a[vt], g2 = g2a[vt];
                const float vv[4] = {bflo(v2.x), bfhi(v2.x), bflo(v2.y), bfhi(v2.y)}, gg[4] = {bflo(g2.x), bfhi(g2.x), bflo(g2.y), bfhi(g2.y)}; float o4[4];
#pragma unroll
                for (int e = 0; e < 4; ++e) o4[e] = (acc[vt][e] * rstd * lw4[e] + lb4[e] + bo * vv[e]) * gg[e];
                u32x2 w; w.x = pk2(o4[0], o4[1]); w.y = pk2(o4[2], o4[3]); *(u32x2*)(mix + (size_t)t * 1024 + h * 64 + c4) = w; }
        }
    }
}
DI void scan_pass2(Frame& F, int task, int jt, float* xch, bool active) {
    unsigned char* ws = F.ws; const int lane = F.lane, fr = lane & 15, fq = lane >> 4, h = task >> 2, ib = task & 3;
    const float* PT = (const float*)(ws + WS_PT); const float* SL = (const float*)(ws + WS_SLOC); float* SST = (float*)(ws + WS_SST);
    f32x4 S[4];
#pragma unroll
    for (int j = 0; j < 4; ++j) S[j] = (f32x4){0.f, 0.f, 0.f, 0.f};
    f32x4 pv0[4], pv1[4], pv2[4], nl0, nl1, nl2, own = (f32x4){0.f, 0.f, 0.f, 0.f};
#define P2_LOAD(c_, PV, NL) do { const int cc_ = (c_) < NC - 1 ? (c_) : NC - 2; const size_t m_ = (size_t)(cc_ * 8 + h) * 4096; NL = *(const f32x4*)(SL + m_ + (16 * ib + fr) * 64 + 16 * jt + 4 * fq); \
        _Pragma("unroll") for (int t4 = 0; t4 < 4; ++t4) PV[t4] = *(const f32x4*)(PT + m_ + (16 * jt + fr) * 64 + 16 * t4 + 4 * fq); } while (0)
#define P2_STEP(c_, PV, NL) do { *(f32x4*)(SST + (size_t)((c_) * 8 + h) * 4096 + (16 * ib + fr) * 64 + 16 * jt + 4 * fq) = own; \
        { bf16x8 ah0_, al0_, ah1_, al1_, bh0_, bl0_, bh1_, bl1_; unpack8(__builtin_bit_cast(u32x4, PV[0]), __builtin_bit_cast(u32x4, PV[1]), ah0_, al0_); unpack8(__builtin_bit_cast(u32x4, PV[2]), __builtin_bit_cast(u32x4, PV[3]), ah1_, al1_); \
          split8(S[0], S[1], bh0_, bl0_); split8(S[2], S[3], bh1_, bl1_); \
          NL = MFMA16(ah0_, bh0_, NL); NL = MFMA16(ah1_, bh1_, NL); NL = MFMA16(ah0_, bl0_, NL); NL = MFMA16(ah1_, bl1_, NL); NL = MFMA16(al0_, bh0_, NL); NL = MFMA16(al1_, bh1_, NL); }     \
        float* xb_ = xch + ((c_) & 1) * 1024; own = NL; *(f32x4*)(xb_ + jt * 256 + lane * 4) = NL; \
        P2_LOAD((c_) + 3, PV, NL); \
        asm volatile("s_waitcnt lgkmcnt(0)" ::: "memory"); __builtin_amdgcn_s_barrier(); asm volatile("" ::: "memory"); \
        _Pragma("unroll") for (int j = 0; j < 4; ++j) S[j] = *(const f32x4*)(xb_ + j * 256 + lane * 4); } while (0)
    static_assert((NC - 1) % 3 == 0, "pass 2 is unrolled by 3");
    if (!active) { for (int c = 0; c < NC - 1; ++c) { asm volatile("s_waitcnt lgkmcnt(0)" ::: "memory"); __builtin_amdgcn_s_barrier(); asm volatile("" ::: "memory"); } return; }
    P2_LOAD(0, pv0, nl0); P2_LOAD(1, pv1, nl1); P2_LOAD(2, pv2, nl2);
    for (int c = 0; c < NC - 1; c += 3) { P2_STEP(c, pv0, nl0); P2_STEP(c + 1, pv1, nl1); P2_STEP(c + 2, pv2, nl2); }
    *(f32x4*)(SST + (size_t)((NC - 1) * 8 + h) * 4096 + (16 * ib + fr) * 64 + 16 * jt + 4 * fq) = own;
#undef P2_STEP
#undef P2_LOAD
}


#ifndef MK_PER_PHASE
#define MK_PER_PHASE 0
#endif
constexpr int NPHASES = 12;
typedef KArgs Args;
static_assert(sizeof(Args) == 33 * 8 + 8, "no padding");

__global__ void __launch_bounds__(NTHR, 2) hybrid_fwd(Args args) {
    extern __shared__ __attribute__((aligned(16))) unsigned char lds[];
    cg::grid_group grid = cg::this_grid();
    Frame F;
    F.lds = lds; F.tid = threadIdx.x; F.lane = F.tid & 63; F.wid = __builtin_amdgcn_readfirstlane(F.tid >> 6); F.bid = blockIdx.x; F.G = gridDim.x;
    F.in.ka = (const __attribute__((address_space(4))) KArgs*)__builtin_amdgcn_kernarg_segment_ptr();
    F.out = args.out; F.ws = args.ws;
    unsigned char* ws = args.ws;
    PG8_LAS unsigned char* glds = (PG8_LAS unsigned char*)lds;
    float* ctl = (float*)(ws + WS_CTL); float *ss1 = ctl, *ss2 = ctl + T, *ss3 = ctl + 2 * T, *sg1 = ctl + 3 * T, *sg2 = ctl + 4 * T;
    const int lo = args.ph_lo, hi = args.ph_hi;
    const float rone = F.G > (1 << 20) ? 2.0f : 1.0f;
    volatile LAS unsigned* MISC = (volatile LAS unsigned*)(glds + LDS_BYTES - 64);
    if (F.tid < 16) MISC[F.tid] = 0u;
    __syncthreads();
    XcdBarrier bar = xcd_barrier_post((unsigned*)(ws + WS_CTL + 768 * KiB), MISC);
#ifndef PHMASK
#define PHMASK 0xfff
#endif
#define IN(k) (((PHMASK >> (k)) & 1) && lo <= (k) && (k) < hi)
#define SEAM(k) do { if ((k) + 1 < hi) { if (hi > NPHASES) grid.sync(); else xcd_barrier(bar); } } while (0)
#ifndef DBLMASK
#define DBLMASK 0
#endif
#define REPS(k) for (int rep = 0; rep < (((DBLMASK >> (k)) & 1) ? 2 : 1); ++rep)
    float* dummy = ctl + 8 * T;

    if (IN(0)) { REPS(0) p0_prologue(F); SEAM(0); }
    if (IN(1)) {
        REPS(1) { pg8::Gemm g{(const bf16*)(ws + WS_XB), (const bf16*)(ws + WS_WIN), T, NIN, D}; pg8::StaticOrder S; S.init(T, NIN, F.G, F.bid);
          fill_rs_table(F, T / 256, NIN / 256, (const float*)(ws + WS_RS0), false);
          EpiZ E{(bf16*)(ws + WS_ZR), (bf16*)(ws + WS_SU), (const float*)(F.lds + RS_TAB_OFF), rep ? dummy : sg1, rep ? dummy + T : sg2};
          pg8::gemm_phase<EpiZ, pg8::StaticOrder>(glds, g, S, E, nullptr); }
        { const int lb = F.bid - 192;
          if (lb >= 0 && lb < 56) tr_run(F, lb * NWAVES + F.wid, 56 * NWAVES, TR_LATE0, TR_DN0 - TR_LATE0, 1 << 30, 0); }
        { const int b = F.bid - (F.G - 8); const bool isk = b >= 0 && b < 4, isv = b >= 4 && b < 8;
          if (isk) { pg8::Gemm g{(const bf16*)(ws + WS_MB), (const bf16*)(ws + WS_WK), MEM, D, D}; FewOrder S{0, b, true}; EpiBf E{(bf16*)(ws + WS_KB), 256, nullptr, rone, 256 * 256};
              pg8::gemm_phase<EpiBf, FewOrder>(glds, g, S, E, nullptr); }
          if (isv) { pg8::Gemm g{(const bf16*)(ws + WS_MB), (const bf16*)(ws + WS_WV), MEM, D, D}; FewOrder S{0, b - 4, true}; EpiBf E{(bf16*)(ws + WS_VT), 256, nullptr, rone, 256 * 256};
              pg8::gemm_phase<EpiBf, FewOrder>(glds, g, S, E, nullptr); } }
        SEAM(1); }
    if (IN(2)) { REPS(2) prep_phase(F); SEAM(2); }
    if (IN(3)) { REPS(3) scan_pass1(F); SEAM(3); }
    if (IN(4)) {
        REPS(4) { if (F.bid < 32) scan_pass2(F, F.bid, F.wid & 3, (float*)F.lds, F.wid < 4);
        else if (F.bid < 48) {
            const int fu = F.bid - 32, fh = fu >> 2, fpm = fu & 3;
            pg8::Gemm g{(const bf16*)(ws + WS_WOTH) + (size_t)fh * D * 256, (const bf16*)(ws + WS_VT) + (size_t)fh * 256 * 256, D, 256, 256}; FewOrder S{fpm, 0, true};
            EpiBf E{(bf16*)(ws + WS_WO) + fh * 256, D, nullptr, rone};
            pg8::gemm_phase<EpiBf, FewOrder>(glds, g, S, E, nullptr); }
        else if (F.bid < 64) {
            const int fu = F.bid - 48, fh = fu >> 2, fpn = fu & 3;
            pg8::Gemm g{(const bf16*)(ws + WS_KB) + (size_t)fh * 256 * 256, (const bf16*)(ws + WS_WQ) + (size_t)fh * D * 256, 256, D, 256}; FewOrder S{0, fpn, true};
            EpiBf E{(bf16*)(ws + WS_WK) + (size_t)fh * 256 * D, D, nullptr, rone};
            pg8::gemm_phase<EpiBf, FewOrder>(glds, g, S, E, nullptr); }
        else sgu_items(F, (F.bid - 64) * NWAVES + F.wid, (F.G - 64) * NWAVES); }
        SEAM(4); }
    if (IN(5)) { REPS(5) scan_pass3(F); SEAM(5); }
    if (IN(6)) {
        REPS(6) { pg8::Gemm g{(const bf16*)(ws + WS_MIX), (const bf16*)(ws + WS_WOUT), T, D, D}; pg8::StaticOrder S; S.init(T, D, F.G, F.bid);
        EpiRes E{F.in[0], nullptr, (bf16*)(ws + WS_XB), rep ? dummy : ss1};
        pg8::gemm_phase<EpiRes, pg8::StaticOrder>(glds, g, S, E, nullptr); } SEAM(6); }
    if (IN(7)) {
        pg8::Gemm g{(const bf16*)(ws + WS_XB), (const bf16*)(ws + WS_WK), T, D, D}; pg8::StaticOrder S; S.init(T, D, F.G, F.bid);
        EpiSoftmax E{(bf16*)(ws + WS_OB), ss1};
        pg8::gemm_phase<EpiSoftmax, pg8::StaticOrder>(glds, g, S, E, nullptr); SEAM(7); }
    if (IN(9)) {
        pg8::Gemm g{(const bf16*)(ws + WS_OB), (const bf16*)(ws + WS_WO), T, D, D}; pg8::StaticOrder S; S.init(T, D, F.G, F.bid);
        EpiRes E{nullptr, (const bf16*)(ws + WS_XB), (bf16*)(ws + WS_XB), ss2};
        pg8::gemm_phase<EpiRes, pg8::StaticOrder>(glds, g, S, E, nullptr); SEAM(9); }
    if (IN(10)) {
        pg8::Gemm g{(const bf16*)(ws + WS_XB), (const bf16*)(ws + WS_WGU), T, 2 * FF, D}; pg8::StaticOrder S; S.init(T, 2 * FF, F.G, F.bid);
        fill_rs_table(F, T / 256, 2 * FF / 256, ss2, true);
        EpiSwi E{(bf16*)(ws + WS_HFF), (const float*)(F.lds + RS_TAB_OFF)};
        REPS(10) pg8::gemm_phase<EpiSwi, pg8::StaticOrder>(glds, g, S, E, nullptr);
        if (F.bid >= 128) tr_run(F, (F.bid - 128) * NWAVES + F.wid, (F.G - 128) * NWAVES, TR_DN0, TR_I_DN, 1 << 30, 0);
        SEAM(10); }
    if (IN(11)) {
        pg8::Gemm g{(const bf16*)(ws + WS_HFF), (const bf16*)(ws + WS_WD), T, D, FF}; pg8::StaticOrder S; S.init(T, D, F.G, F.bid);
        EpiFinal E{(const bf16*)(ws + WS_XB), F.out, ss3, (unsigned*)(ctl + 10 * T), F.in[30]};
        pg8::gemm_phase<EpiFinal, pg8::StaticOrder>(glds, g, S, E, nullptr); }
#ifdef SYNCX
    for (int i = 0; i < SYNCX; ++i) xcd_barrier(bar);
#endif
#undef IN
#undef SEAM
}

extern "C" void kernel_launch(void* const* d_in, const int* in_sizes, int n_in, void* d_out, int out_size, void* d_ws, size_t ws_size, hipStream_t stream) {
    static int grid = 0;
    if (grid == 0) {
        if (n_in != 31 || in_sizes[0] != T * D || out_size != T * D || ws_size < WS_END) { fprintf(stderr, "kernel_launch: unexpected shapes (n_in %d, in0 %d, out %d, ws %zu)\n", n_in, n_in > 0 ? in_sizes[0] : -1, out_size, ws_size); grid = -1; return; }
        int dev = 0, cus = 0, per_cu = 0;
        if (hipGetDevice(&dev) != hipSuccess || hipDeviceGetAttribute(&cus, hipDeviceAttributeMultiprocessorCount, dev) != hipSuccess) { grid = -1; return; }
        if (hipFuncSetAttribute((const void*)hybrid_fwd, hipFuncAttributeMaxDynamicSharedMemorySize, LDS_BYTES) != hipSuccess) { fprintf(stderr, "kernel_launch: hipFuncSetAttribute failed\n"); grid = -1; return; }
        if (hipOccupancyMaxActiveBlocksPerMultiprocessor(&per_cu, (const void*)hybrid_fwd, NTHR, LDS_BYTES) != hipSuccess || per_cu < 1) { fprintf(stderr, "kernel_launch: occupancy query says %d blocks per CU\n", per_cu); per_cu = 1; }
        (void)hipGetLastError();
        grid = cus * per_cu;
    }
    if (grid < 0) return;
    if (hipMemsetAsync((char*)d_ws + WS_CTL, 0, CTL_BYTES, stream) != hipSuccess) { fprintf(stderr, "kernel_launch: memset failed\n"); return; }
    Args a{};
    for (int i = 0; i < 31; ++i) a.in[i] = (const float*)d_in[i];
    a.out = (float*)d_out; a.ws = (unsigned char*)d_ws;
#if MK_PER_PHASE
    for (int p = 0; p < NPHASES; ++p) { a.ph_lo = p; a.ph_hi = p + 1; hipLaunchKernelGGL(hybrid_fwd, dim3(grid), dim3(NTHR), LDS_BYTES, stream, a); }
#else
    a.ph_lo = 0; a.ph_hi = NPHASES;
    void* kargs[] = {&a};
    hipError_t e = hipLaunchCooperativeKernel((const void*)hybrid_fwd, dim3(grid), dim3(NTHR), kargs, LDS_BYTES, stream);
    if (e != hipSuccess) fprintf(stderr, "kernel_launch: cooperative launch failed: %s (grid %d)\n", hipGetErrorString(e), grid);
#endif
}
```

```cpp
#include <hip/hip_runtime.h>
#include <hip/hip_cooperative_groups.h>
#include <cstdio>
namespace cg = cooperative_groups;

namespace pg8 {
#define PG8_LAS __attribute__((address_space(3)))
typedef unsigned short bf16_t;
typedef short bf16x8 __attribute__((ext_vector_type(8)));
typedef float f32x4 __attribute__((ext_vector_type(4)));
typedef unsigned u32x4 __attribute__((ext_vector_type(4)));
constexpr int BM = 256, BK = 64, HALF = 128, HTB = HALF * BK * 2  , STAGE_BYTES = 8 * HTB, NXCD = 8, WGM = 8;

__host__ __device__ __forceinline__ int lds_byte(int r, int c) { const int st = (r >> 4) * 2 + (c >> 5), rr = r & 15, cc = c & 31, ob = rr * 64 + cc * 2; return st * 1024 + (ob ^ (((ob >> 9) & 1) << 5)); }
__host__ __device__ __forceinline__ void stage_rc(int b, int& R, int& C) { const int st = b / 1024, sb = b % 1024, swz = sb ^ (((sb >> 9) & 1) << 5); R = (st >> 1) * 16 + swz / 64; C = (st & 1) * 32 + (swz % 64) / 2; }
__host__ __device__ __forceinline__ int perm32(int rho) { const int n = rho >> 4, i = rho & 15; return 8 * (i >> 2) + 4 * n + (i & 3); }

struct Unit { int pm, pn; };
struct Gemm { const bf16_t* A; const bf16_t* Bt; int M, N, K; };

struct StaticOrder {
    int nM, nN, nwg, G, c;
    __host__ __device__ void init(int M, int N, int G_, int c_) { nM = M / BM; nN = N / BM; nwg = nM * nN; G = G_; c = c_; }
    __host__ __device__ bool next(int i, Unit& u) const {
        const long L = (long)i * G + c; if (L >= nwg) return false;
        int wgid = (int)L; { const int q = nwg / NXCD, r = nwg % NXCD, xcd = wgid % NXCD, off = wgid / NXCD; wgid = (xcd < r ? xcd * (q + 1) : r * (q + 1) + (xcd - r) * q) + off; }
        const int nig = WGM * nN, gid = wgid / nig, fm = gid * WGM, gsz = (nM - fm) < WGM ? (nM - fm) : WGM;
        u.pm = fm + ((wgid % nig) % gsz); u.pn = (wgid % nig) / gsz; return true;
    }
    __device__ __forceinline__ void a_ready(const Unit&) const {}
    __device__ __forceinline__ void done(const Unit&) const {}
};
__device__ __forceinline__ unsigned cvt_pk_bf16(float lo, float hi) { unsigned r; asm volatile("v_cvt_pk_bf16_f32 %0, %1, %2" : "=v"(r) : "v"(lo), "v"(hi)); return r; }
typedef float f32x2 __attribute__((ext_vector_type(2)));
__device__ __forceinline__ f32x2 gelu_pk(f32x2 v) {
    const f32x2 av = __builtin_elementwise_abs(v), d = av * 0.2316418882f + 1.0f;
    f32x2 t; t.x = __builtin_amdgcn_rcpf(d.x); t.y = __builtin_amdgcn_rcpf(d.y);
    f32x2 q = t * 0.5307027145f + (-0.7265760135f); q = q * t + 0.7107068705f; q = q * t + (-0.142248368f); q = q * t + 0.127414796f; q = q * t;
    const f32x2 s = (v * v) * (-0.72134752044f);
    f32x2 e; e.x = __builtin_amdgcn_exp2f(s.x); e.y = __builtin_amdgcn_exp2f(s.y);
    const f32x2 m = v * (q * e), r = v - m;
    f32x2 o; o.x = v.x < 0.f ? m.x : r.x; o.y = v.y < 0.f ? m.y : r.y; return o;
}

template <class Epi, class Sched, bool STAMP = false>
__device__ __forceinline__ void gemm_phase(PG8_LAS unsigned char* lds, const Gemm g, const Sched& S, const Epi& E, unsigned long long* stamps) {
    const int tid = threadIdx.x, wid = __builtin_amdgcn_readfirstlane(tid >> 6), lane = tid & 63, wr = wid >> 2, wc = wid & 3, fr = lane & 15, fq = lane >> 4;
    const int K = g.K, nt = K / BK;
    int ts_lo = 0, ts_hi = 0, nts = 0; const unsigned long long rt_entry = STAMP ? (unsigned long long)wall_clock64() : 0ull;
#define PG8_STAMP() do { if (STAMP && wid == 0 && nts < 64) { const unsigned long long _c = (unsigned long long)clock64(); \
        ts_lo = (lane == nts) ? (int)(unsigned)_c : ts_lo; ts_hi = (lane == nts) ? (int)(unsigned)(_c >> 32) : ts_hi; ++nts; } } while (0)
    PG8_STAMP();
    unsigned voffA[2], voffB[2];
#pragma unroll
    for (int i = 0; i < 2; ++i) { int R, C; stage_rc(tid * 16 + i * 8192, R, C); const int Rb = Epi::PERM ? ((R & ~31) + perm32(R & 31)) : R;
        voffA[i] = (unsigned)(R * K + C) * 2u; voffB[i] = (unsigned)(Rb * K + C) * 2u; }
    const size_t kstep = (size_t)(BK * 2);
    const size_t hstep = (size_t)HALF * K * 2;
    const size_t tstep = 2 * hstep;
    const unsigned ldsw = (unsigned)wid * 1024u;
    const int aoff = lds_byte(wr * 64 + fr, fq * 8), boff = lds_byte(wc * 32 + fr, fq * 8);
#define PG8_SA(b, h) (((b) * 2 + (h)) * HTB)
#define PG8_SB(b, h) ((4 + (b) * 2 + (h)) * HTB)
#define PG8_STAGE(bufoff, gbase, voff) do { _Pragma("unroll") for (int _i = 0; _i < 2; ++_i) \
        __builtin_amdgcn_global_load_lds((const unsigned*)((const char*)(gbase) + (voff)[_i]), (PG8_LAS unsigned*)(lds + (bufoff) + ldsw + _i * 8192), 16, 0, 0); } while (0)
#define PG8_LDA(dst, b, h) do { _Pragma("unroll") for (int m = 0; m < 4; ++m) _Pragma("unroll") for (int k = 0; k < 2; ++k) dst[m][k] = *(const PG8_LAS bf16x8*)(lds + PG8_SA(b, h) + aoff + m * 2048 + k * 1024); } while (0)
#define PG8_LDB(dst, b, h) do { _Pragma("unroll") for (int n = 0; n < 2; ++n) _Pragma("unroll") for (int k = 0; k < 2; ++k) dst[n][k] = *(const PG8_LAS bf16x8*)(lds + PG8_SB(b, h) + boff + n * 2048 + k * 1024); } while (0)
#define PG8_MMA(ai, bj, At, Bt) do { __builtin_amdgcn_s_setprio(1); _Pragma("unroll") for (int m = 0; m < 4; ++m) _Pragma("unroll") for (int n = 0; n < 2; ++n) _Pragma("unroll") for (int k = 0; k < 2; ++k) \
        acc[ai][bj][m][n] = __builtin_amdgcn_mfma_f32_16x16x32_bf16(Bt[n][k], At[m][k], acc[ai][bj][m][n], 0, 0, 0); __builtin_amdgcn_s_setprio(0); } while (0)
#define PG8_WAIT_V(n) asm volatile("s_waitcnt vmcnt(" #n ")" ::: "memory")
#define PG8_WAIT_L(n) asm volatile("s_waitcnt lgkmcnt(" #n ")" ::: "memory")
#define PG8_BAR __builtin_amdgcn_s_barrier()
#define PG8_SCHED __builtin_amdgcn_sched_barrier(0)
    Unit cur, nxt; int ui = 0;
    if (!S.next(0, cur)) return;
    f32x4 acc[2][2][4][2];
#pragma unroll
    for (int a = 0; a < 2; ++a)
#pragma unroll
        for (int b = 0; b < 2; ++b)
#pragma unroll
            for (int m = 0; m < 4; ++m)
#pragma unroll
                for (int n = 0; n < 2; ++n) acc[a][b][m][n] = (f32x4){0.f, 0.f, 0.f, 0.f};
    bf16x8 At[4][2], B0[2][2], B1[2][2];
    const char* cA = (const char*)g.A + (size_t)cur.pm * tstep; const char* cB = (const char*)g.Bt + (size_t)cur.pn * tstep;
    S.a_ready(cur);
    PG8_STAGE(PG8_SB(0, 0), cB, voffB); PG8_STAGE(PG8_SA(0, 0), cA, voffA); PG8_STAGE(PG8_SB(0, 1), cB + hstep, voffB); PG8_STAGE(PG8_SA(0, 1), cA + hstep, voffA);
    if (wr == 1) PG8_BAR;
    PG8_WAIT_V(4); PG8_BAR;
    PG8_STAGE(PG8_SB(1, 0), cB + kstep, voffB); PG8_STAGE(PG8_SA(1, 0), cA + kstep, voffA); PG8_STAGE(PG8_SB(1, 1), cB + hstep + kstep, voffB);
    PG8_WAIT_V(6); PG8_BAR;
    PG8_STAMP();
    for (;;) {
        const bool has_next = S.next(ui + 1, nxt);
        const char* nA = has_next ? (const char*)g.A + (size_t)nxt.pm * tstep : cA; const char* nB = has_next ? (const char*)g.Bt + (size_t)nxt.pn * tstep : cB;
        for (int t = 0; t < nt; t += 2) {
            const bool last = (t == nt - 2);
            const char* a1 = cA + (size_t)(t + 1) * kstep;
            const char* a2 = last ? nA : cA + (size_t)(t + 2) * kstep; const char* b2 = last ? nB : cB + (size_t)(t + 2) * kstep;
            const char* a3 = a2 + kstep; const char* b3 = b2 + kstep;
            if (last && has_next) S.a_ready(nxt);
            PG8_LDB(B0, 0, 0); PG8_SCHED; PG8_LDA(At, 0, 0); PG8_STAGE(PG8_SA(1, 1), a1 + hstep, voffA);
            PG8_WAIT_L(8); PG8_BAR; PG8_WAIT_L(0); PG8_MMA(0, 0, At, B0); PG8_BAR; PG8_SCHED;
            PG8_LDB(B1, 0, 1); PG8_STAGE(PG8_SB(0, 0), b2, voffB);
            PG8_BAR; PG8_WAIT_L(0); PG8_MMA(0, 1, At, B1); PG8_BAR;
            PG8_LDA(At, 0, 1); PG8_STAGE(PG8_SA(0, 0), a2, voffA);
            PG8_BAR; PG8_WAIT_L(0); PG8_MMA(1, 0, At, B0); PG8_BAR; PG8_SCHED;
            PG8_STAGE(PG8_SB(0, 1), b2 + hstep, voffB);
            PG8_WAIT_V(6); PG8_BAR; PG8_MMA(1, 1, At, B1); PG8_BAR;
            PG8_LDB(B0, 1, 0); PG8_SCHED; PG8_LDA(At, 1, 0); PG8_STAGE(PG8_SA(0, 1), a2 + hstep, voffA);
            PG8_WAIT_L(8); PG8_BAR; PG8_WAIT_L(0); PG8_MMA(0, 0, At, B0); PG8_BAR; PG8_SCHED;
            PG8_LDB(B1, 1, 1); PG8_STAGE(PG8_SB(1, 0), b3, voffB);
            PG8_BAR; PG8_WAIT_L(0); PG8_MMA(0, 1, At, B1); PG8_BAR;
            PG8_LDA(At, 1, 1); PG8_STAGE(PG8_SA(1, 0), a3, voffA);
            PG8_BAR; PG8_WAIT_L(0); PG8_MMA(1, 0, At, B0); PG8_BAR; PG8_SCHED;
            PG8_STAGE(PG8_SB(1, 1), b3 + hstep, voffB);
            PG8_WAIT_V(6); PG8_BAR; PG8_MMA(1, 1, At, B1); PG8_BAR;
        }
        PG8_STAMP();
        if constexpr (!Epi::AFTER_DRAIN) { E(acc, cur, wr, wc, fr, fq); S.done(cur); }
        PG8_STAMP();
        if (!has_next) break;
#pragma unroll
        for (int a = 0; a < 2; ++a)
#pragma unroll
            for (int b = 0; b < 2; ++b)
#pragma unroll
                for (int m = 0; m < 4; ++m)
#pragma unroll
                    for (int n = 0; n < 2; ++n) acc[a][b][m][n] = (f32x4){0.f, 0.f, 0.f, 0.f};
        cur = nxt; cA = nA; cB = nB; ++ui;
    }
    PG8_WAIT_V(0);
    if (wr == 0) PG8_BAR;
    PG8_BAR;
    if constexpr (Epi::AFTER_DRAIN) { E.fused(acc, cur, wr, wc, fr, fq, lds, wid, lane); S.done(cur); }
    PG8_STAMP();
    if (STAMP && wid == 0) { stamps[lane] = lane < nts ? (((unsigned long long)(unsigned)ts_hi << 32) | (unsigned)ts_lo) : 0ull;
        if (lane == 62) stamps[62] = rt_entry; if (lane == 63) stamps[63] = (unsigned long long)wall_clock64(); }
#undef PG8_STAMP
#undef PG8_SA
#undef PG8_SB
#undef PG8_STAGE
#undef PG8_LDA
#undef PG8_LDB
#undef PG8_MMA
#undef PG8_WAIT_V
#undef PG8_WAIT_L
#undef PG8_BAR
#undef PG8_SCHED
}
}

using pg8::bf16x8; using pg8::f32x4; using pg8::u32x4; using pg8::Unit;
typedef unsigned short bf16;
typedef unsigned u32x2 __attribute__((ext_vector_type(2)));
typedef float f32x2 __attribute__((ext_vector_type(2)));
#define LAS __attribute__((address_space(3)))
#define DI __device__ __forceinline__
constexpr int T = 16384, D = 1024, NIN = 2816, RIN = 1792, RW = 512, FF = 2816, MEM = 256;
constexpr int NWAVES = 8, NTHR = 512;
constexpr int LCH = 256, NC = T / LCH;
constexpr float RMS_EPS = 1e-6f;
constexpr size_t MiB = (size_t)1 << 20, KiB = 1024;
constexpr size_t WS_CTL = 0, CTL_BYTES = 1 * MiB;
constexpr size_t WS_WIN = 2 * MiB, WS_WOUT = WS_WIN + (size_t)NIN * D * 2, WS_WQ = WS_WOUT + 2 * MiB, WS_WK = WS_WQ + 2 * MiB, WS_WV = WS_WK + 2 * MiB,
                 WS_WO = WS_WV + 2 * MiB, WS_WGU = WS_WO + 2 * MiB, WS_WD = WS_WGU + (size_t)2 * FF * D * 2;
constexpr size_t WS_XB = 34 * MiB;
constexpr size_t WS_R = WS_XB, WS_V = WS_XB + 16 * MiB;
constexpr size_t WS_G16 = WS_WIN;
constexpr size_t WS_ZR = 66 * MiB;
constexpr size_t WS_PT = WS_ZR, WS_SLOC = WS_ZR + 8 * MiB, WS_SST = WS_ZR + 16 * MiB;
constexpr size_t WS_Q = WS_ZR, WS_HFF = WS_ZR;
constexpr size_t WS_SU = 122 * MiB;
constexpr size_t WS_OB = WS_SU;
constexpr size_t WS_MIX = 154 * MiB;
constexpr size_t WS_B = 186 * MiB;
constexpr size_t WS_KP = 218 * MiB;
constexpr size_t WS_G = 234 * MiB;
constexpr size_t WS_MB = 251 * MiB, WS_KB = WS_MB + 512 * KiB, WS_VT = WS_KB + 512 * KiB, WS_WSB = WS_VT + 512 * KiB, WS_WLT = WS_WSB + 256 * KiB,
                 WS_ALT = WS_WLT + 64 * KiB, WS_GLT = WS_ALT + 64 * KiB, WS_RS0 = WS_GLT + 128 * KiB, WS_BON = WS_RS0 + 256 * KiB, WS_END = WS_BON + 512 * KiB;
constexpr size_t WS_WOTH = 254 * MiB;
static_assert(WS_WD + (size_t)D * FF * 2 <= WS_XB && WS_END <= WS_WOTH && WS_WOTH + 2 * MiB <= 256 * MiB, "ws map");
constexpr int LDS_BYTES = 147456;

DI float bf2f(unsigned b) { return __uint_as_float(b << 16); }
DI float bflo(unsigned w) { return __uint_as_float(w << 16); }
DI float bfhi(unsigned w) { return __uint_as_float(w & 0xffff0000u); }
DI unsigned pk2(float lo, float hi) { return pg8::cvt_pk_bf16(lo, hi); }
DI float wave_sum(float v) {
#pragma unroll
    for (int o = 1; o < 64; o <<= 1) v += __shfl_xor(v, o);
    return v; }
DI float sigmoidf_(float x) { return __builtin_amdgcn_rcpf(1.0f + __expf(-x)); }
DI float gelu_tanh(float v) { const float u2 = 1.5957691216f * (v + 0.044715f * v * v * v); return v * __builtin_amdgcn_rcpf(1.0f + __expf(-u2)); }
#define LDS_FENCE() asm volatile("s_waitcnt lgkmcnt(0)" ::: "memory")
#define MFMA16(a, b, c) __builtin_amdgcn_mfma_f32_16x16x32_bf16((a), (b), (c), 0, 0, 0)

struct KArgs { const float* in[31]; float* out; unsigned char* ws; int ph_lo, ph_hi; };
struct InTab { const __attribute__((address_space(4))) KArgs* ka; DI const float* operator[](int i) const { return ka->in[i]; } };
struct Frame {
    unsigned char* lds; int tid, lane, wid, bid, G;
    InTab in; float* out; unsigned char* ws;
};

#define XB_TMO      128
#define XB_XCNT(j)  (256  + 64 * (j))
#define XB_XSUB(j)  (1280 + 64 * (j))
#define XB_XGEN(j)  (2304 + 64 * (j))
#define XB_TOP      3328
#define XB_TOPGEN   3392
#define XCD_BAR_WORDS 3456
#define XB_SPIN_CAP (1u << 18)

__device__ __forceinline__ unsigned xb_ld(unsigned* p)              { return __hip_atomic_load(p, __ATOMIC_RELAXED, __HIP_MEMORY_SCOPE_AGENT); }
__device__ __forceinline__ unsigned xb_add(unsigned* p, unsigned v) { return __hip_atomic_fetch_add(p, v, __ATOMIC_RELAXED, __HIP_MEMORY_SCOPE_AGENT); }
__device__ __forceinline__ unsigned xb_xcc_id() { return (unsigned)__builtin_amdgcn_s_getreg((3 << 11) | 20) & 0xFu; }
#define XB_SPIN(cond, bar) do { unsigned _sp = 0; while (cond) { __builtin_amdgcn_s_sleep(1); \
    if ((++_sp & 255u) == 0u) { if (xb_ld(&(bar)[XB_TMO])) break; if (_sp > XB_SPIN_CAP) { atomicAdd(&(bar)[XB_TMO], 1u); break; } } } } while (0)

struct XcdBarrier {
    unsigned* bar; unsigned x;
    volatile LAS unsigned* st;
};

__device__ __forceinline__ XcdBarrier xcd_barrier_post(unsigned* bar, volatile LAS unsigned* st) {
    XcdBarrier b; b.bar = bar; b.x = xb_xcc_id(); b.st = st;
    if (threadIdx.x == 0) (void)xb_add(&bar[XB_XCNT(b.x)], 1u);
    return b;
}
__device__ __forceinline__ void xcd_barrier_complete(unsigned* bar, unsigned x, unsigned& nloc, unsigned& nx) {
    const unsigned G = gridDim.x * gridDim.y * gridDim.z;
    unsigned sum, cnt, mine, sp = 0u;
    for (;;) {
        sum = 0u; cnt = 0u; mine = 0u;
#pragma unroll
        for (unsigned j = 0; j < 16; ++j) { const unsigned c = xb_ld(&bar[XB_XCNT(j)]); sum += c; cnt += (c > 0u) ? 1u : 0u; mine = (j == x) ? c : mine; }
        if (sum == G) break;
        __builtin_amdgcn_s_sleep(1);
        if ((++sp & 255u) == 0u) { if (xb_ld(&bar[XB_TMO])) break; if (sp > XB_SPIN_CAP) { atomicAdd(&bar[XB_TMO], 1u); break; } }
    }
    nloc = mine > 0u ? mine : 1u; nx = cnt > 0u ? cnt : 1u;
}

__device__ __forceinline__ void xcd_barrier(const XcdBarrier& b) {
    asm volatile("s_waitcnt vmcnt(0)" ::: "memory");
    __syncthreads();
    if (threadIdx.x == 0) {
        unsigned* bar = b.bar;
        __builtin_amdgcn_s_waitcnt(0);
        unsigned nloc = b.st[0], nx = b.st[1];
        if (nloc == 0u) { xcd_barrier_complete(bar, b.x, nloc, nx); b.st[0] = nloc; b.st[1] = nx; }
        const unsigned old = xb_add(&bar[XB_XSUB(b.x)], 1u);
        const unsigned gen = old / nloc;
        if (old + 1u == (gen + 1u) * nloc) {
            __builtin_amdgcn_fence(__ATOMIC_RELEASE, "agent");
            asm volatile("s_waitcnt vmcnt(0)" ::: "memory");
            const unsigned og = xb_add(&bar[XB_TOP], 1u);
            const unsigned tg = og / nx;
            if (og + 1u == (tg + 1u) * nx) xb_add(&bar[XB_TOPGEN], 1u);
            else XB_SPIN(xb_ld(&bar[XB_TOPGEN]) == tg, bar);
            __builtin_amdgcn_fence(__ATOMIC_ACQUIRE, "agent");
            xb_add(&bar[XB_XGEN(b.x)], 1u);
            asm volatile("s_waitcnt vmcnt(0)" ::: "memory");
        } else {
            XB_SPIN(xb_ld(&bar[XB_XGEN(b.x)]) == gen, bar);
            __builtin_amdgcn_fence(__ATOMIC_ACQUIRE, "agent");
            asm volatile("s_waitcnt vmcnt(0)" ::: "memory");
        }
    }
    __syncthreads();
}

DI bool static_unit(int i, int G, int cid, int nM, int nN, int& pm, int& pn) {
    const int nwg = nM * nN; const long L = (long)i * G + cid; if (L >= nwg) return false;
    int wgid = (int)L; { const int q = nwg / pg8::NXCD, r = nwg % pg8::NXCD, xcd = wgid % pg8::NXCD, off = wgid / pg8::NXCD; wgid = (xcd < r ? xcd * (q + 1) : r * (q + 1) + (xcd - r) * q) + off; }
    const int nig = pg8::WGM * nN, gid = wgid / nig, fm = gid * pg8::WGM, gsz = (nM - fm) < pg8::WGM ? (nM - fm) : pg8::WGM;
    pm = fm + ((wgid % nig) % gsz); pn = (wgid % nig) / gsz; return true; }
constexpr int RS_TAB_OFF = 131072, RS_TAB_UNITS = 8;
DI void fill_rs_table(Frame& F, int nM, int nN, const float* src, bool is_ss) {
    float* tab = (float*)(F.lds + RS_TAB_OFF);
    for (int i = 0; i < RS_TAB_UNITS; ++i) { int pm, pn; if (!static_unit(i, F.G, F.bid, nM, nN, pm, pn)) break;
        if (F.tid < 256) { const float v = src[pm * 256 + F.tid]; tab[i * 256 + F.tid] = is_ss ? rsqrtf(v * (1.0f / D) + RMS_EPS) : v; } }
    __syncthreads();
}
struct EpiZ {
    static constexpr bool PERM = true, AFTER_DRAIN = false;
    bf16* zr; bf16* su; const float* rstab; float* sg1; float* sg2; mutable int ui = 0;
    DI void operator()(const f32x4 (&acc)[2][2][4][2], const Unit& u, int wr, int wc, int fr, int fq) const {
        const int row0 = u.pm * 256 + wr * 64 + fr; const bool isr = u.pn < 7, st = u.pn >= 9;
        bf16* base = isr ? zr : su; const int ldc = isr ? RIN : 1024; const int col0 = (isr ? u.pn : u.pn - 7) * 256 + wc * 32 + 8 * fq;
        float rsv[8];
#pragma unroll
        for (int i = 0; i < 8; ++i) rsv[i] = rstab[ui * 256 + wr * 64 + fr + (i >> 2) * 128 + (i & 3) * 16];
        ++ui;
#pragma unroll
        for (int ai = 0; ai < 2; ++ai)
#pragma unroll
            for (int m = 0; m < 4; ++m) { const int r = row0 + ai * 128 + m * 16; const float rs = rsv[ai * 4 + m]; bf16* rowp = base + (size_t)r * ldc + col0; float s1 = 0.f, s2 = 0.f;
#pragma unroll
                for (int bj = 0; bj < 2; ++bj) { f32x4 v0 = acc[ai][bj][m][0] * rs, v1 = acc[ai][bj][m][1] * rs;
                    if (!isr) {
#pragma unroll
                        for (int j = 0; j < 4; ++j) { v0[j] = gelu_tanh(v0[j]); v1[j] = gelu_tanh(v1[j]); }
#pragma unroll
                        for (int j = 0; j < 4; ++j) { s1 += v0[j] + v1[j]; s2 += v0[j] * v0[j] + v1[j] * v1[j]; } }
                    u32x4 w; w.x = pk2(v0[0], v0[1]); w.y = pk2(v0[2], v0[3]); w.z = pk2(v1[0], v1[1]); w.w = pk2(v1[2], v1[3]);
                    *(u32x4*)(rowp + bj * 128) = w; }
                if (st) { s1 += __shfl_xor(s1, 16); s1 += __shfl_xor(s1, 32); s2 += __shfl_xor(s2, 16); s2 += __shfl_xor(s2, 32);
                    if (fq == 0) { atomicAdd(sg1 + r, s1); atomicAdd(sg2 + r, s2); } } }
    }
};
struct EpiBf {
    static constexpr bool PERM = true, AFTER_DRAIN = false;
    bf16* O; int ldc; const float* ss; float one; int head_stride = 0;
    DI void operator()(const f32x4 (&acc)[2][2][4][2], const Unit& u, int wr, int wc, int fr, int fq) const {
        const int row0 = u.pm * 256 + wr * 64 + fr, col0 = (head_stride ? 0 : u.pn * 256) + wc * 32 + 8 * fq; bf16* Ob = O + (size_t)(head_stride ? u.pn : 0) * head_stride;
        float rsv[8];
#pragma unroll
        for (int i = 0; i < 8; ++i) rsv[i] = ss ? rsqrtf(ss[row0 + (i >> 2) * 128 + (i & 3) * 16] * (1.0f / D) + RMS_EPS) : one;
#pragma unroll
        for (int ai = 0; ai < 2; ++ai)
#pragma unroll
            for (int m = 0; m < 4; ++m) { const int r = row0 + ai * 128 + m * 16; const float rs = rsv[ai * 4 + m]; bf16* rowp = Ob + (size_t)r * ldc + col0;
#pragma unroll
                for (int bj = 0; bj < 2; ++bj) { const f32x4 v0 = acc[ai][bj][m][0] * rs, v1 = acc[ai][bj][m][1] * rs;
                    u32x4 w; w.x = pk2(v0[0], v0[1]); w.y = pk2(v0[2], v0[3]); w.z = pk2(v1[0], v1[1]); w.w = pk2(v1[2], v1[3]);
                    *(u32x4*)(rowp + bj * 128) = w; } }
    }
};
struct EpiRes {
    static constexpr bool PERM = false, AFTER_DRAIN = false;
    const float* basef; const bf16* baseb; bf16* xb; float* ss;
    DI void ld(f32x4 (&d)[4], size_t off) const {
        if (basef) {
#pragma unroll
            for (int q = 0; q < 4; ++q) d[q] = *(const f32x4*)(basef + off + (q >> 1) * 128 + (q & 1) * 16);
        } else {
#pragma unroll
            for (int q = 0; q < 4; ++q) { const u32x2 w = *(const u32x2*)(baseb + off + (q >> 1) * 128 + (q & 1) * 16); d[q] = (f32x4){bflo(w.x), bfhi(w.x), bflo(w.y), bfhi(w.y)}; }
        } }
    DI void operator()(const f32x4 (&acc)[2][2][4][2], const Unit& u, int wr, int wc, int fr, int fq) const {
        const int row0 = u.pm * 256 + wr * 64 + fr, col0 = u.pn * 256 + wc * 32 + 4 * fq;
        f32x4 bc[4], bn[4];
        ld(bc, (size_t)row0 * D + col0);
#pragma unroll
        for (int idx = 0; idx < 8; ++idx) { const int ai = idx >> 2, m = idx & 3; const int r = row0 + ai * 128 + m * 16; const size_t off = (size_t)r * D + col0; float s2 = 0.f;
            if (idx + 1 < 8) ld(bn, (size_t)(row0 + ((idx + 1) >> 2) * 128 + ((idx + 1) & 3) * 16) * D + col0);
#pragma unroll
            for (int bj = 0; bj < 2; ++bj)
#pragma unroll
                for (int n = 0; n < 2; ++n) { const f32x4 o = bc[bj * 2 + n] + acc[ai][bj][m][n];
                    s2 += (o[0] * o[0] + o[1] * o[1]) + (o[2] * o[2] + o[3] * o[3]);
                    u32x2 w; w.x = pk2(o[0], o[1]); w.y = pk2(o[2], o[3]); *(u32x2*)(xb + off + bj * 128 + n * 16) = w; }
            s2 += __shfl_xor(s2, 16); s2 += __shfl_xor(s2, 32);
            if (fq == 0) atomicAdd(ss + r, s2);
#pragma unroll
            for (int q = 0; q < 4; ++q) bc[q] = bn[q];
            asm volatile("" ::: "memory"); }
    }
};
struct EpiFinal {
    static constexpr bool PERM = false, AFTER_DRAIN = true;
    const bf16* base; float* out; float* ss; unsigned* cnt; const float* gf;
    DI void ld(f32x4 (&d)[4], size_t off) const {
#pragma unroll
        for (int q = 0; q < 4; ++q) { const u32x2 w = *(const u32x2*)(base + off + (q >> 1) * 128 + (q & 1) * 16); d[q] = (f32x4){bflo(w.x), bfhi(w.x), bflo(w.y), bfhi(w.y)}; } }
    DI void fused(f32x4 (&acc)[2][2][4][2], const Unit& u, int wr, int wc, int fr, int fq, PG8_LAS unsigned char* lds, int wid, int lane) const {
        const int row0 = u.pm * 256 + wr * 64 + fr, col0 = u.pn * 256 + wc * 32 + 4 * fq;
        f32x4 bc[4], bn[4];
        ld(bc, (size_t)row0 * D + col0);
#pragma unroll
        for (int idx = 0; idx < 8; ++idx) { const int ai = idx >> 2, m = idx & 3; const int r = row0 + ai * 128 + m * 16; float s2 = 0.f;
            if (idx + 1 < 8) ld(bn, (size_t)(row0 + ((idx + 1) >> 2) * 128 + ((idx + 1) & 3) * 16) * D + col0);
#pragma unroll
            for (int bj = 0; bj < 2; ++bj)
#pragma unroll
                for (int n = 0; n < 2; ++n) { const f32x4 o = bc[bj * 2 + n] + acc[ai][bj][m][n]; acc[ai][bj][m][n] = o; s2 += (o[0] * o[0] + o[1] * o[1]) + (o[2] * o[2] + o[3] * o[3]); }
            s2 += __shfl_xor(s2, 16); s2 += __shfl_xor(s2, 32);
            if (fq == 0) atomicAdd(ss + r, s2);
#pragma unroll
            for (int q = 0; q < 4; ++q) bc[q] = bn[q];
            asm volatile("" ::: "memory"); }
        asm volatile("s_waitcnt vmcnt(0)" ::: "memory");
        __syncthreads();
        if (threadIdx.x == 0) { unsigned* c = cnt + 64 * u.pm; __hip_atomic_fetch_add(c, 1u, __ATOMIC_RELAXED, __HIP_MEMORY_SCOPE_AGENT);
            unsigned sp = 0; while (__hip_atomic_load(c, __ATOMIC_RELAXED, __HIP_MEMORY_SCOPE_AGENT) < (unsigned)(D / 256) && ++sp < (1u << 22)) __builtin_amdgcn_s_sleep(1); }
        __syncthreads();
        f32x4 g4[4];
#pragma unroll
        for (int q = 0; q < 4; ++q) g4[q] = *(const f32x4*)(gf + col0 + (q >> 1) * 128 + (q & 1) * 16);
#pragma unroll
        for (int idx = 0; idx < 8; ++idx) { const int ai = idx >> 2, m = idx & 3; const int r = row0 + ai * 128 + m * 16; const size_t off = (size_t)r * D + col0;
            const float rs = rsqrtf(__hip_atomic_load(ss + r, __ATOMIC_RELAXED, __HIP_MEMORY_SCOPE_AGENT) * (1.0f / D) + RMS_EPS);
#pragma unroll
            for (int bj = 0; bj < 2; ++bj)
#pragma unroll
                for (int n = 0; n < 2; ++n) *(f32x4*)(out + off + bj * 128 + n * 16) = acc[ai][bj][m][n] * rs * g4[bj * 2 + n]; }
    }
};
struct EpiSoftmax {
    static constexpr bool PERM = true, AFTER_DRAIN = true;
    bf16* P; const float* ss;
    DI void fused(f32x4 (&acc)[2][2][4][2], const Unit& u, int wr, int wc, int fr, int fq, PG8_LAS unsigned char* lds, int wid, int lane) const {
        PG8_LAS float* red = (PG8_LAS float*)lds;
        const int lrow0 = wr * 64 + fr, grow0 = u.pm * 256 + lrow0;
#pragma unroll
        for (int idx = 0; idx < 8; ++idx) { const int ai = idx >> 2, m = idx & 3, lr = lrow0 + ai * 128 + m * 16; const float rs = rsqrtf(ss[grow0 + ai * 128 + m * 16] * (1.0f / D) + RMS_EPS) * 0.0625f; float mx = -1e30f;
#pragma unroll
            for (int bj = 0; bj < 2; ++bj)
#pragma unroll
                for (int n = 0; n < 2; ++n) { const f32x4 v = acc[ai][bj][m][n] * rs; acc[ai][bj][m][n] = v; mx = fmaxf(mx, fmaxf(fmaxf(v[0], v[1]), fmaxf(v[2], v[3]))); }
            mx = fmaxf(mx, __shfl_xor(mx, 16)); mx = fmaxf(mx, __shfl_xor(mx, 32));
            if (fq == 0) red[lr * 4 + wc] = mx; }
        asm volatile("s_waitcnt lgkmcnt(0)" ::: "memory"); __builtin_amdgcn_s_barrier(); asm volatile("" ::: "memory");
#pragma unroll
        for (int idx = 0; idx < 8; ++idx) { const int ai = idx >> 2, m = idx & 3, lr = lrow0 + ai * 128 + m * 16; const f32x4 m4 = *(const PG8_LAS f32x4*)(red + lr * 4);
            const float mx = fmaxf(fmaxf(m4[0], m4[1]), fmaxf(m4[2], m4[3])); float sm = 0.f;
#pragma unroll
            for (int bj = 0; bj < 2; ++bj)
#pragma unroll
                for (int n = 0; n < 2; ++n) { f32x4 v = acc[ai][bj][m][n];
#pragma unroll
                    for (int e = 0; e < 4; ++e) { v[e] = __expf(v[e] - mx); sm += v[e]; }
                    acc[ai][bj][m][n] = v; }
            sm += __shfl_xor(sm, 16); sm += __shfl_xor(sm, 32);
            if (fq == 0) red[1024 + lr * 4 + wc] = sm; }
        asm volatile("s_waitcnt lgkmcnt(0)" ::: "memory"); __builtin_amdgcn_s_barrier(); asm volatile("" ::: "memory");
#pragma unroll
        for (int idx = 0; idx < 8; ++idx) { const int ai = idx >> 2, m = idx & 3, lr = lrow0 + ai * 128 + m * 16; const f32x4 s4 = *(const PG8_LAS f32x4*)(red + 1024 + lr * 4);
            const float inv = 1.0f / ((s4[0] + s4[1]) + (s4[2] + s4[3])); bf16* rowp = P + (size_t)(grow0 + ai * 128 + m * 16) * D + u.pn * 256 + wc * 32 + 8 * fq;
#pragma unroll
            for (int bj = 0; bj < 2; ++bj) { const f32x4 v0 = acc[ai][bj][m][0] * inv, v1 = acc[ai][bj][m][1] * inv;
                u32x4 w; w.x = pk2(v0[0], v0[1]); w.y = pk2(v0[2], v0[3]); w.z = pk2(v1[0], v1[1]); w.w = pk2(v1[2], v1[3]);
                *(u32x4*)(rowp + bj * 128) = w; } }
    }
};
struct EpiSwi {
    static constexpr bool PERM = true, AFTER_DRAIN = false;
    bf16* H; const float* rstab; mutable int ui = 0;
    DI void operator()(const f32x4 (&acc)[2][2][4][2], const Unit& u, int wr, int wc, int fr, int fq) const {
        const int row0 = u.pm * 256 + wr * 64 + fr, col0 = u.pn * 128 + wc * 32 + 8 * fq;
        float rsv[8];
#pragma unroll
        for (int i = 0; i < 8; ++i) rsv[i] = rstab[ui * 256 + wr * 64 + fr + (i >> 2) * 128 + (i & 3) * 16];
        ++ui;
#pragma unroll
        for (int ai = 0; ai < 2; ++ai)
#pragma unroll
            for (int m = 0; m < 4; ++m) { const int r = row0 + ai * 128 + m * 16; const float rs = rsv[ai * 4 + m]; float h[8];
#pragma unroll
                for (int n = 0; n < 2; ++n)
#pragma unroll
                    for (int j = 0; j < 4; ++j) { const float g = acc[ai][0][m][n][j] * rs, up = acc[ai][1][m][n][j] * rs; h[4 * n + j] = g * up * sigmoidf_(g); }
                u32x4 w; w.x = pk2(h[0], h[1]); w.y = pk2(h[2], h[3]); w.z = pk2(h[4], h[5]); w.w = pk2(h[6], h[7]);
                *(u32x4*)(H + (size_t)r * FF + col0) = w; }
    }
};
struct FewOrder {
    int pm, pn; bool has;
    DI bool next(int i, Unit& u) const { if (i != 0 || !has) return false; u.pm = pm; u.pn = pn; return true; }
    DI void a_ready(const Unit&) const {}
    DI void done(const Unit&) const {}
};

struct TrItem { const float* W; const float* ks; bf16* WT; int K, N, drow0, kb, nb; bool valid; };
DI void tr_load(const TrItem& I, f32x4 (&v)[8], int lane) {
    if (!I.valid) return;
    const int k0 = 64 * I.kb, n0 = 32 * I.nb;
#pragma unroll
    for (int i = 0; i < 8; ++i) { const int kk = (lane >> 3) + 8 * i; v[i] = *(const f32x4*)(I.W + (size_t)(k0 + kk) * I.N + n0 + 4 * (lane & 7)); }
}
DI void tr_finish(const TrItem& I, const f32x4 (&v)[8], float* scr, int lane) {
    if (!I.valid) return;
    const int k0 = 64 * I.kb;
#pragma unroll
    for (int i = 0; i < 8; ++i) { const int kk = (lane >> 3) + 8 * i; const float sc = I.ks ? I.ks[k0 + kk] : 1.0f; float* d = scr + kk * 33 + 4 * (lane & 7);
        d[0] = v[i][0] * sc; d[1] = v[i][1] * sc; d[2] = v[i][2] * sc; d[3] = v[i][3] * sc; }
    LDS_FENCE();
    const int c = lane & 7;
#pragma unroll
    for (int j = 0; j < 4; ++j) { const int n = (lane >> 3) + 8 * j; const float* s = scr + (8 * c) * 33 + n;
        u32x4 o; o.x = pk2(s[0 * 33], s[1 * 33]); o.y = pk2(s[2 * 33], s[3 * 33]); o.z = pk2(s[4 * 33], s[5 * 33]); o.w = pk2(s[6 * 33], s[7 * 33]);
        *(u32x4*)(I.WT + (size_t)(I.drow0 + n) * I.K + k0 + 8 * c) = o; }
    LDS_FENCE();
}
DI TrItem tr_decode(Frame& F, int it, int nitems) {
    TrItem I; I.valid = it < nitems; I.W = nullptr; I.ks = nullptr; I.WT = nullptr; I.K = 0; I.N = 0; I.drow0 = 0; I.kb = 0; I.nb = 0;
    if (!I.valid) return I;
    unsigned char* ws = F.ws; int r = it;
#define TR(Wp, K_, N_, SC, DST, DROW) { constexpr int ni_ = ((K_) / 64) * ((N_) / 32); if (r >= 0 && r < ni_) { I.kb = r / ((N_) / 32); I.nb = r % ((N_) / 32); const int n0 = I.nb * 32; (void)n0; \
            I.W = (Wp); I.K = (K_); I.N = (N_); I.ks = (SC); I.WT = (bf16*)(ws + (DST)); I.drow0 = (DROW); } r -= ni_; }
    TR(F.in[3], D, NIN, F.in[2], WS_WIN, n0)
    TR(F.in[23], D, D, (const float*)nullptr, WS_WK, n0)
    TR(F.in[24], D, D, (const float*)nullptr, WS_WV, n0)
    TR(F.in[6], 64, RW, (const float*)nullptr, WS_WLT, n0)
    TR(F.in[8], 64, RW, (const float*)nullptr, WS_ALT, n0)
    TR(F.in[9], 128, RW, (const float*)nullptr, WS_GLT, n0)
    TR(F.in[27], D, FF, F.in[26], WS_WGU, (n0 / 128) * 256 + (n0 % 128))
    TR(F.in[28], D, FF, F.in[26], WS_WGU, (n0 / 128) * 256 + 128 + (n0 % 128))
    TR(F.in[19], D, D, (const float*)nullptr, WS_WOUT, n0)
    TR(F.in[25] + 0 * 256 * D, 256, D, (const float*)nullptr, WS_WOTH + 0 * (size_t)D * 256 * 2, n0)
    TR(F.in[25] + 1 * 256 * D, 256, D, (const float*)nullptr, WS_WOTH + 1 * (size_t)D * 256 * 2, n0)
    TR(F.in[25] + 2 * 256 * D, 256, D, (const float*)nullptr, WS_WOTH + 2 * (size_t)D * 256 * 2, n0)
    TR(F.in[25] + 3 * 256 * D, 256, D, (const float*)nullptr, WS_WOTH + 3 * (size_t)D * 256 * 2, n0)
    TR(F.in[29], FF, D, (const float*)nullptr, WS_WD, n0)
#undef TR
    return I;
}
constexpr int TR_I_IN = (D / 64) * (NIN / 32), TR_I_SQ = (D / 64) * (D / 32), TR_I_FF = (D / 64) * (FF / 32), TR_I_DN = (FF / 64) * (D / 32), TR_I_L64 = 1 * (RW / 32), TR_I_L128 = 2 * (RW / 32);
constexpr int TR_NITEMS = TR_I_IN + 4 * TR_I_SQ + 2 * TR_I_FF + TR_I_DN + 2 * TR_I_L64 + TR_I_L128, TR_LATE0 = TR_I_IN + 2 * TR_I_SQ + 2 * TR_I_L64 + TR_I_L128 + 0 * TR_I_FF, TR_DN0 = TR_NITEMS - TR_I_DN;
DI void tr_run(Frame& F, int gw, int NGW, int base, int count, int skip_at, int skip_len) {
    float* scr = (float*)(F.lds + F.wid * 16384); const int lane = F.lane;
#define TR_REAL(v_) ((v_) < count ? ((base + (v_)) >= skip_at ? base + (v_) + skip_len : base + (v_)) : TR_NITEMS)
    f32x4 va[8], vb[8];
    TrItem Ia = tr_decode(F, TR_REAL(gw), TR_NITEMS); tr_load(Ia, va, lane);
    for (int it = gw; it < count; it += 2 * NGW) {
        TrItem Ib = tr_decode(F, TR_REAL(it + NGW), TR_NITEMS); tr_load(Ib, vb, lane);
        tr_finish(Ia, va, scr, lane);
        Ia = tr_decode(F, TR_REAL(it + 2 * NGW), TR_NITEMS); tr_load(Ia, va, lane);
        tr_finish(Ib, vb, scr, lane);
    }
#undef TR_REAL
}
DI void p0_prologue(Frame& F) {
    const int gw = F.bid * NWAVES + F.wid, NGW = F.G * NWAVES, lane = F.lane;
    unsigned char* ws = F.ws;
    tr_run(F, gw, NGW, 0, TR_LATE0, 1 << 30, 0);
    const float* x = F.in[0]; bf16* xb = (bf16*)(ws + WS_XB); float* rs0 = (float*)(ws + WS_RS0);
    { f32x4 vn[4];
#pragma unroll
      for (int j = 0; j < 4; ++j) vn[j] = ((const f32x4*)(x + (size_t)gw * D) + lane)[64 * j];
      for (int m = gw; m < T; m += NGW) {
        f32x4 v[4]; float s = 0.f;
#pragma unroll
        for (int j = 0; j < 4; ++j) { v[j] = vn[j]; s += (v[j][0] * v[j][0] + v[j][1] * v[j][1]) + (v[j][2] * v[j][2] + v[j][3] * v[j][3]); }
        if (m + NGW < T) {
#pragma unroll
            for (int j = 0; j < 4; ++j) vn[j] = ((const f32x4*)(x + (size_t)(m + NGW) * D) + lane)[64 * j]; }
        s = wave_sum(s);
        if (lane == 0) rs0[m] = rsqrtf(s * (1.0f / D) + RMS_EPS);
        u32x2* o8 = (u32x2*)(xb + (size_t)m * D) + lane;
#pragma unroll
        for (int j = 0; j < 4; ++j) { u32x2 w; w.x = pk2(v[j][0], v[j][1]); w.y = pk2(v[j][2], v[j][3]); o8[64 * j] = w; }
      } }
    { const float* wq = F.in[22]; const float* g2 = F.in[20]; bf16* wqu = (bf16*)(ws + WS_WQ);
      for (int k = gw; k < D; k += NGW) { const float gk = g2[k];
#pragma unroll
          for (int j = 0; j < 4; ++j) { const f32x4 v = ((const f32x4*)(wq + (size_t)k * D) + lane)[64 * j]; u32x2 w; w.x = pk2(v[0] * gk, v[1] * gk); w.y = pk2(v[2] * gk, v[3] * gk);
              *(u32x2*)(wqu + (size_t)j * D * 256 + (size_t)k * 256 + 4 * lane) = w; } } }
    const float* mem = F.in[1]; const float* mg = F.in[21]; bf16* mb = (bf16*)(ws + WS_MB);
    for (int m = gw; m < MEM; m += NGW) {
        const f32x4* xr = (const f32x4*)(mem + (size_t)m * D) + lane; f32x4 v[4]; float s = 0.f;
#pragma unroll
        for (int j = 0; j < 4; ++j) { v[j] = xr[64 * j]; s += (v[j][0] * v[j][0] + v[j][1] * v[j][1]) + (v[j][2] * v[j][2] + v[j][3] * v[j][3]); }
        s = wave_sum(s); const float rs = rsqrtf(s * (1.0f / D) + RMS_EPS);
        u32x2* o8 = (u32x2*)(mb + (size_t)m * D) + lane;
#pragma unroll
        for (int j = 0; j < 4; ++j) { const f32x4 g = ((const f32x4*)mg)[lane + 64 * j]; u32x2 w; w.x = pk2(v[j][0] * rs * g[0], v[j][1] * rs * g[1]); w.y = pk2(v[j][2] * rs * g[2], v[j][3] * rs * g[3]); o8[64 * j] = w; }
    }
    const float* wsp = F.in[17]; bf16* wsb = (bf16*)(ws + WS_WSB);
    for (int e = F.bid * NTHR + F.tid; e < 8 * 128 * 128; e += F.G * NTHR) { const int i = (e >> 7) & 127, j = e & 127; wsb[e] = (bf16)(pk2(j <= i ? wsp[e] : 0.f, 0.f) & 0xffffu); }
}

DI f32x4 load_shift4(const bf16* zrow, int col, int t, const float* mu) {
    const u32x2 a = *(const u32x2*)(zrow + col); u32x2 p = (u32x2){0u, 0u}; if (t > 0) p = *(const u32x2*)(zrow - RIN + col);
    const f32x4 m4 = *(const f32x4*)(mu + col); const f32x4 z = (f32x4){bflo(a.x), bfhi(a.x), bflo(a.y), bfhi(a.y)}, pz = (f32x4){bflo(p.x), bfhi(p.x), bflo(p.y), bfhi(p.y)};
    return z + (pz - z) * m4; }
template <int N> DI float dpp_shr(float v, float old) { return __builtin_bit_cast(float, __builtin_amdgcn_update_dpp(__builtin_bit_cast(int, old), __builtin_bit_cast(int, v), 0x110 + N, 0xF, 0xF, false)); }
DI float scan16_mul(float x) { x *= dpp_shr<1>(x, 1.0f); x *= dpp_shr<2>(x, 1.0f); x *= dpp_shr<4>(x, 1.0f); x *= dpp_shr<8>(x, 1.0f); return x; }
DI void prep_phase(Frame& F) {
    unsigned char* ws = F.ws; const int tid = F.tid, lane = F.lane, h = F.wid, fr = lane & 15, fq = lane >> 4;
    const bf16* zr = (const bf16*)(ws + WS_ZR); const float* mu = F.in[4];
    const bf16* WlT = (const bf16*)(ws + WS_WLT); const bf16* AlT = (const bf16*)(ws + WS_ALT); const bf16* GlT = (const bf16*)(ws + WS_GLT);
    const float *w0 = F.in[5], *a0 = F.in[7], *k_k = F.in[10], *k_a = F.in[11], *r_k = F.in[12];
    float* G16 = (float*)(ws + WS_G16); float* KK = F.out + (size_t)T * RW; float* Bb = (float*)(ws + WS_B);
    bf16* Rb = (bf16*)(ws + WS_R); bf16* Vb = (bf16*)(ws + WS_V); bf16* KPb = (bf16*)(ws + WS_KP); bf16* Gb = (bf16*)(ws + WS_G); float* bonus = (float*)(ws + WS_BON);
    unsigned char* AL = F.lds;
    const float gone = F.G > (1 << 20) ? 2.0f : 1.0f;
    for (int tile = F.bid; tile < T / 64; tile += F.G) {
        const int t0 = tile * 64;
        __syncthreads();
        { const int tk = tid >> 3, cs = (tid & 7) * 32, t = t0 + tk, kind = cs < 64 ? 0 : (cs < 128 ? 1 : 2);
          const bf16* zrow = zr + (size_t)t * RIN + 1536 + cs;
#pragma unroll
          for (int q = 0; q < 4; ++q) { const u32x4 a = *(const u32x4*)(zrow + 8 * q); u32x4 p = (u32x4){0u, 0u, 0u, 0u}; if (t > 0) p = *(const u32x4*)(zrow - RIN + 8 * q);
              float o[8];
#pragma unroll
              for (int e2 = 0; e2 < 4; ++e2) { const float z0 = bflo(a[e2]), z1 = bfhi(a[e2]), p0 = bflo(p[e2]), p1 = bfhi(p[e2]);
                  const float m0 = mu[1536 + cs + 8 * q + 2 * e2], m1 = mu[1536 + cs + 8 * q + 2 * e2 + 1];
                  float h0 = z0 + (p0 - z0) * m0, h1 = z1 + (p1 - z1) * m1;
                  if (kind == 0) { h0 = 1.0f - 2.0f * __builtin_amdgcn_rcpf(1.0f + __expf(2.0f * h0)); h1 = 1.0f - 2.0f * __builtin_amdgcn_rcpf(1.0f + __expf(2.0f * h1)); }
                  if (kind == 2) { h0 = sigmoidf_(h0); h1 = sigmoidf_(h1); }
                  o[2 * e2] = h0; o[2 * e2 + 1] = h1; }
              u32x4 w; w.x = pk2(o[0], o[1]); w.y = pk2(o[2], o[3]); w.z = pk2(o[4], o[5]); w.w = pk2(o[6], o[7]);
              *(u32x4*)(AL + tk * 528 + (cs + 8 * q) * 2) = w; } }
        __syncthreads();
        float inv[4], bon[4];
#pragma unroll
        for (int mt = 0; mt < 4; ++mt) { const int t = t0 + 16 * mt + fr; const bf16* zrow = zr + (size_t)t * RIN; float ssq = 0.f;
#pragma unroll
            for (int nt = 0; nt < 4; ++nt) { const int c = 64 * h + 16 * nt + 4 * fq; const f32x4 k4 = load_shift4(zrow, 512 + c, t, mu); const f32x4 kk4 = *(const f32x4*)(k_k + c);
#pragma unroll
                for (int e = 0; e < 4; ++e) { const float q = k4[e] * kk4[e]; ssq += q * q; } }
            ssq += __shfl_xor(ssq, 16); ssq += __shfl_xor(ssq, 32);
            inv[mt] = 1.0f / fmaxf(sqrtf(ssq), 1e-12f); bon[mt] = 0.f; }
#pragma unroll 1
        for (int nt = 0; nt < 4; ++nt) {
            const int n = 64 * h + 16 * nt + fr, c = 64 * h + 16 * nt + 4 * fq;
            bf16x8 bw[2], ba[2], bg[4];
#pragma unroll
            for (int ks = 0; ks < 2; ++ks) { bw[ks] = *(const bf16x8*)(WlT + n * 64 + 32 * ks + 8 * fq); ba[ks] = *(const bf16x8*)(AlT + n * 64 + 32 * ks + 8 * fq); }
#pragma unroll
            for (int ks = 0; ks < 4; ++ks) bg[ks] = *(const bf16x8*)(GlT + n * 128 + 32 * ks + 8 * fq);
            const f32x4 w04 = *(const f32x4*)(w0 + c), a04 = *(const f32x4*)(a0 + c), kk4 = *(const f32x4*)(k_k + c), ka4 = *(const f32x4*)(k_a + c), rk4 = *(const f32x4*)(r_k + c);
#pragma unroll
            for (int mt = 0; mt < 4; ++mt) {
                const int t = t0 + 16 * mt + fr; const bf16* zrow = zr + (size_t)t * RIN; const size_t o = (size_t)t * RW + c;
                const f32x4 r4 = load_shift4(zrow, c, t, mu), k4 = load_shift4(zrow, 512 + c, t, mu), v4 = load_shift4(zrow, 1024 + c, t, mu);
                f32x4 aw = (f32x4){0.f, 0.f, 0.f, 0.f}, aa = aw, ag = aw;
                const unsigned char* arow = AL + (16 * mt + fr) * 528 + 16 * fq;
#pragma unroll
                for (int ks = 0; ks < 2; ++ks) { aw = MFMA16(bw[ks], *(const bf16x8*)(arow + 64 * ks), aw); aa = MFMA16(ba[ks], *(const bf16x8*)(arow + 128 + 64 * ks), aa); }
#pragma unroll
                for (int ks = 0; ks < 4; ++ks) ag = MFMA16(bg[ks], *(const bf16x8*)(arow + 256 + 64 * ks), ag);
                f32x4 dw, dk, db; float kp[4];
#pragma unroll
                for (int e = 0; e < 4; ++e) { const float wl = w04[e] + aw[e];
                    dw[e] = __expf(-0.6065306597f * sigmoidf_(wl));
                    const float a = sigmoidf_(a04[e] + aa[e]);
                    const float kkv = k4[e] * kk4[e] * inv[mt]; dk[e] = kkv; db[e] = kkv * a;
                    kp[e] = k4[e] * (1.0f + (a - 1.0f) * ka4[e]); bon[mt] += r4[e] * kp[e] * rk4[e]; }
                f32x4 gi, ge, gr;
#pragma unroll
                for (int e = 0; e < 4; ++e) { gi[e] = scan16_mul(dw[e]); ge[e] = dpp_shr<1>(gi[e], 1.0f); gr[e] = __builtin_amdgcn_rcpf(gi[e]); }
                if (fr == 15) *(f32x4*)(G16 + (size_t)(t >> 4) * RW + c) = gi;
                *(f32x4*)(KK + o) = dk * ge; *(f32x4*)(Bb + o) = db * gr;
                u32x2 w; w.x = pk2(r4[0] * gi[0], r4[1] * gi[1]); w.y = pk2(r4[2] * gi[2], r4[3] * gi[3]); *(u32x2*)(Rb + o) = w;
                w.x = pk2(v4[0], v4[1]); w.y = pk2(v4[2], v4[3]); *(u32x2*)(Vb + o) = w;
                w.x = pk2(kp[0] * gr[0], kp[1] * gr[1]); w.y = pk2(kp[2] * gr[2], kp[3] * gr[3]); *(u32x2*)(KPb + o) = w;
                { const f32x4 gv = ag * gone;
                  w.x = pk2(gv[0], gv[1]); w.y = pk2(gv[2], gv[3]); *(u32x2*)(Gb + o) = w; }
                asm volatile("" ::: "memory");
            }
        }
#pragma unroll
        for (int mt = 0; mt < 4; ++mt) { float bsum = bon[mt]; bsum += __shfl_xor(bsum, 16); bsum += __shfl_xor(bsum, 32); if (fq == 0) bonus[(size_t)(t0 + 16 * mt + fr) * 8 + h] = bsum; }
    }
}

DI void sgu_items(Frame& F, int first, int stride) {
    unsigned char* ws = F.ws; const int lane = F.lane, fr = lane & 15, fq = lane >> 4;
    const bf16* su = (const bf16*)(ws + WS_SU); bf16* mix = (bf16*)(ws + WS_MIX); const bf16* wsb = (const bf16*)(ws + WS_WSB);
    const float* sg1 = (const float*)(ws + WS_CTL) + 3 * T; const float* sg2 = sg1 + T; const float *lnw = F.in[15], *lnb = F.in[16], *bsp = F.in[18];
    unsigned char* vnT = F.lds + F.wid * 17408;
    for (int item = first; item < 1024; item += stride) {
        const int nb = item >> 3, g = item & 7; constexpr int KJ = 128;
        LDS_FENCE();
        { const int chunk = lane & 7, jp = lane >> 3;
          const f32x4 lw0 = *(const f32x4*)(lnw + 64 * g + 8 * chunk), lw1 = *(const f32x4*)(lnw + 64 * g + 8 * chunk + 4), lb0 = *(const f32x4*)(lnb + 64 * g + 8 * chunk), lb1 = *(const f32x4*)(lnb + 64 * g + 8 * chunk + 4);
          const float lwv[8] = {lw0[0], lw0[1], lw0[2], lw0[3], lw1[0], lw1[1], lw1[2], lw1[3]}, lbv[8] = {lb0[0], lb0[1], lb0[2], lb0[3], lb1[0], lb1[1], lb1[2], lb1[3]};
          u32x4 a0[8], a1[8]; float m0[8], m1[8], q0[8], q1[8];
#pragma unroll
          for (int it = 0; it < 8; ++it) if (it < KJ / 16) { const int tok = 128 * nb + 2 * (jp + 8 * it);
              a0[it] = *(const u32x4*)(su + (size_t)tok * 1024 + 512 + 64 * g + 8 * chunk); a1[it] = *(const u32x4*)(su + (size_t)(tok + 1) * 1024 + 512 + 64 * g + 8 * chunk);
              m0[it] = sg1[tok]; m1[it] = sg1[tok + 1]; q0[it] = sg2[tok]; q1[it] = sg2[tok + 1]; }
#pragma unroll
          for (int it = 0; it < 8; ++it) if (it < KJ / 16) { const int j = 2 * (jp + 8 * it);
              const float mm0 = m0[it] * (1.0f / 512), mm1 = m1[it] * (1.0f / 512);
              const float r0 = rsqrtf(fmaxf(q0[it] * (1.0f / 512) - mm0 * mm0, 0.f) + 1e-5f), r1 = rsqrtf(fmaxf(q1[it] * (1.0f / 512) - mm1 * mm1, 0.f) + 1e-5f);
#pragma unroll
              for (int e2 = 0; e2 < 4; ++e2) {
                  const float x0a = (bflo(a0[it][e2]) - mm0) * r0 * lwv[2 * e2] + lbv[2 * e2], x0b = (bfhi(a0[it][e2]) - mm0) * r0 * lwv[2 * e2 + 1] + lbv[2 * e2 + 1];
                  const float x1a = (bflo(a1[it][e2]) - mm1) * r1 * lwv[2 * e2] + lbv[2 * e2], x1b = (bfhi(a1[it][e2]) - mm1) * r1 * lwv[2 * e2 + 1] + lbv[2 * e2 + 1];
                  *(unsigned*)(vnT + (8 * chunk + 2 * e2) * 272 + j * 2) = pk2(x0a, x1a);
                  *(unsigned*)(vnT + (8 * chunk + 2 * e2 + 1) * 272 + j * 2) = pk2(x0b, x1b); } } }
        LDS_FENCE();
#pragma unroll 1
        for (int hf = 0; hf < 2; ++hf) {
        f32x4 acc[4][4];
#pragma unroll
        for (int a = 0; a < 4; ++a)
#pragma unroll
            for (int b = 0; b < 4; ++b) acc[a][b] = (f32x4){0.f, 0.f, 0.f, 0.f};
#pragma unroll
        for (int ks = 0; ks < 4; ++ks) if (ks < 2 * (hf + 1)) {
            bf16x8 bfv[4];
#pragma unroll
            for (int ct = 0; ct < 4; ++ct) bfv[ct] = *(const bf16x8*)(vnT + (16 * ct + fr) * 272 + (32 * ks + 8 * fq) * 2);
#pragma unroll
            for (int it = 0; it < 4; ++it) { const int i = 64 * hf + 16 * it + fr; const bf16x8 af = *(const bf16x8*)(wsb + (size_t)(g * 128 + i) * 128 + 32 * ks + 8 * fq);
#pragma unroll
                for (int ct = 0; ct < 4; ++ct) acc[it][ct] = MFMA16(bfv[ct], af, acc[it][ct]); } }
        u32x2 uu[4][4]; float bias[4];
#pragma unroll
        for (int it = 0; it < 4; ++it) { const int i = 64 * hf + 16 * it + fr, tok = 128 * nb + i; bias[it] = bsp[g * 128 + i];
#pragma unroll
            for (int ct = 0; ct < 4; ++ct) uu[it][ct] = *(const u32x2*)(su + (size_t)tok * 1024 + 64 * g + 16 * ct + 4 * fq); }
#pragma unroll
        for (int it = 0; it < 4; ++it) { const int i = 64 * hf + 16 * it + fr, tok = 128 * nb + i;
#pragma unroll
            for (int ct = 0; ct < 4; ++ct) { const int c = 64 * g + 16 * ct + 4 * fq; const u32x2 u2 = uu[it][ct];
                u32x2 w; w.x = pk2(bflo(u2.x) * (acc[it][ct][0] + bias[it]), bfhi(u2.x) * (acc[it][ct][1] + bias[it])); w.y = pk2(bflo(u2.y) * (acc[it][ct][2] + bias[it]), bfhi(u2.y) * (acc[it][ct][3] + bias[it]));
                *(u32x2*)(mix + (size_t)tok * 1024 + 512 + c) = w; } }
        }
    }
}

DI float dpp_x1(float v) { return __builtin_bit_cast(float, __builtin_amdgcn_update_dpp(0, __builtin_bit_cast(int, v), 0xB1, 0xF, 0xF, true)); }
DI float dpp_x2(float v) { return __builtin_bit_cast(float, __builtin_amdgcn_update_dpp(0, __builtin_bit_cast(int, v), 0x4E, 0xF, 0xF, true)); }
DI float dpp_hm(float v) { return __builtin_bit_cast(float, __builtin_amdgcn_update_dpp(0, __builtin_bit_cast(int, v), 0x141, 0xF, 0xF, true)); }
DI float red8(float p) { p += dpp_x1(p); p += dpp_x2(p); p += dpp_hm(p); return p; }
#define RED8X4(a, b, c, d) asm volatile("s_nop 1\n\t" \
    "v_add_f32_dpp %0, %0, %0 quad_perm:[1,0,3,2] row_mask:0xf bank_mask:0xf\n\tv_add_f32_dpp %1, %1, %1 quad_perm:[1,0,3,2] row_mask:0xf bank_mask:0xf\n\t" \
    "v_add_f32_dpp %2, %2, %2 quad_perm:[1,0,3,2] row_mask:0xf bank_mask:0xf\n\tv_add_f32_dpp %3, %3, %3 quad_perm:[1,0,3,2] row_mask:0xf bank_mask:0xf\n\t" \
    "v_add_f32_dpp %0, %0, %0 quad_perm:[2,3,0,1] row_mask:0xf bank_mask:0xf\n\tv_add_f32_dpp %1, %1, %1 quad_perm:[2,3,0,1] row_mask:0xf bank_mask:0xf\n\t" \
    "v_add_f32_dpp %2, %2, %2 quad_perm:[2,3,0,1] row_mask:0xf bank_mask:0xf\n\tv_add_f32_dpp %3, %3, %3 quad_perm:[2,3,0,1] row_mask:0xf bank_mask:0xf\n\t" \
    "v_add_f32_dpp %0, %0, %0 row_half_mirror row_mask:0xf bank_mask:0xf\n\tv_add_f32_dpp %1, %1, %1 row_half_mirror row_mask:0xf bank_mask:0xf\n\t" \
    "v_add_f32_dpp %2, %2, %2 row_half_mirror row_mask:0xf bank_mask:0xf\n\tv_add_f32_dpp %3, %3, %3 row_half_mirror row_mask:0xf bank_mask:0xf\n\ts_nop 1" \
    : "+v"(a), "+v"(b), "+v"(c), "+v"(d))
constexpr int SC = 16, NSC = LCH / SC, SARR = SC * 64, SBUF = 6 * SARR, SGRP = 2 * SBUF;
template <bool ISP> DI void scan1_chunk(const float* gl, float* gst, int NSCc, const float* G16, const float* KK, const float* Bb, const bf16* KPb, const bf16* Vb, const bf16* Rb,
                                         float* OUTY, int tb, int h, int gt, int srow0, int kg, f32x2 (&s)[4][4]) {
    const int lstep = gt >> 4, lc4 = (gt & 15) * 4;
    f32x4 lkk, lb; u32x2 lkp, lv, lr;
#define SCAN_LOAD(sc_) do { const size_t o_ = (size_t)(tb + (sc_) * SC + lstep) * RW + h * 64 + lc4; lkk = *(const f32x4*)(KK + o_); lb = *(const f32x4*)(Bb + o_); \
        lkp = *(const u32x2*)(KPb + o_); lv = *(const u32x2*)(Vb + o_); lr = *(const u32x2*)(Rb + o_); } while (0)
#define SCAN_STORE(b_) do { float* d_ = gst + (b_) * SBUF + lstep * 64 + lc4; *(f32x4*)(d_ + SARR) = lkk; *(f32x4*)(d_ + 2 * SARR) = lb; \
        *(f32x4*)(d_ + 3 * SARR) = (f32x4){bflo(lkp.x), bfhi(lkp.x), bflo(lkp.y), bfhi(lkp.y)}; *(f32x4*)(d_ + 4 * SARR) = (f32x4){bflo(lv.x), bfhi(lv.x), bflo(lv.y), bfhi(lv.y)}; \
        *(f32x4*)(d_ + 5 * SARR) = (f32x4){bflo(lr.x), bfhi(lr.x), bflo(lr.y), bfhi(lr.y)}; } while (0)
    __syncthreads();
    SCAN_LOAD(0); SCAN_STORE(0);
    __syncthreads();
    for (int sc = 0; sc < NSCc; ++sc) {
        const float* bf = gl + (sc & 1) * SBUF;
        if (sc + 1 < NSCc) SCAN_LOAD(sc + 1);
        const float* gp_ = G16 + (size_t)((tb >> 4) + sc) * RW + h * 64 + 8 * kg; const f32x4 gq0 = *(const f32x4*)gp_, gq1 = *(const f32x4*)(gp_ + 4);
#pragma unroll 2
        for (int st = 0; st < SC; ++st) {
            const float* p = bf + st * 64 + 8 * kg;
            const f32x4 k0 = *(const f32x4*)(p + SARR), k1 = *(const f32x4*)(p + SARR + 4), b0 = *(const f32x4*)(p + 2 * SARR), b1 = *(const f32x4*)(p + 2 * SARR + 4),
                        r0 = *(const f32x4*)(p + 5 * SARR), r1 = *(const f32x4*)(p + 5 * SARR + 4);
            const f32x2 k2[4] = {k0.xy, k0.zw, k1.xy, k1.zw}, b2[4] = {b0.xy, b0.zw, b1.xy, b1.zw}, r2[4] = {r0.xy, r0.zw, r1.xy, r1.zw};
            f32x2 q2[4]; f32x4 v4 = (f32x4){0.f, 0.f, 0.f, 0.f};
            if (!ISP) { const f32x4 q0 = *(const f32x4*)(p + 3 * SARR), q1 = *(const f32x4*)(p + 3 * SARR + 4); v4 = *(const f32x4*)(bf + 4 * SARR + st * 64 + srow0);
                q2[0] = q0.xy; q2[1] = q0.zw; q2[2] = q1.xy; q2[3] = q1.zw; }
            float pd[4], yd[4];
#pragma unroll
            for (int i = 0; i < 4; ++i) { f32x2 a = s[i][0] * k2[0]; a = s[i][1] * k2[1] + a; a = s[i][2] * k2[2] + a; a = s[i][3] * k2[3] + a; pd[i] = a.x + a.y; }
            RED8X4(pd[0], pd[1], pd[2], pd[3]);
#pragma unroll
            for (int i = 0; i < 4; ++i) { const f32x2 n2 = (f32x2){-pd[i], -pd[i]};
                if (ISP) {
#pragma unroll
                    for (int j = 0; j < 4; ++j) s[i][j] = s[i][j] + n2 * b2[j];
                } else { const f32x2 vv2 = (f32x2){v4[i], v4[i]};
#pragma unroll
                    for (int j = 0; j < 4; ++j) s[i][j] = vv2 * q2[j] + (n2 * b2[j] + s[i][j]);
                }
                f32x2 y = s[i][0] * r2[0]; y = s[i][1] * r2[1] + y; y = s[i][2] * r2[2] + y; y = s[i][3] * r2[3] + y; yd[i] = y.x + y.y; }
            RED8X4(yd[0], yd[1], yd[2], yd[3]);
            const f32x4 yv = (f32x4){yd[0], yd[1], yd[2], yd[3]};
            if (kg == 0) *(f32x4*)(OUTY + (size_t)(tb + sc * SC + st) * RW + h * 64 + srow0) = yv;
        }
        { const f32x2 g2[4] = {gq0.xy, gq0.zw, gq1.xy, gq1.zw};
#pragma unroll
          for (int i = 0; i < 4; ++i)
#pragma unroll
              for (int j = 0; j < 4; ++j) s[i][j] = s[i][j] * g2[j]; }
        if (sc + 1 < NSCc) SCAN_STORE((sc + 1) & 1);
        asm volatile("s_waitcnt lgkmcnt(0)" ::: "memory"); __builtin_amdgcn_s_barrier(); asm volatile("" ::: "memory");
    }
#undef SCAN_LOAD
#undef SCAN_STORE
}
DI void scan_pass1(Frame& F) {
    unsigned char* ws = F.ws; const int lane = F.lane, grp = F.wid >> 2, w4 = F.wid & 3, gt = F.tid & 255, rs = lane >> 3, kg = lane & 7;
    float* Wd = F.out; float* KK = F.out + (size_t)T * RW; const float* Bb = (const float*)(ws + WS_B); const float* G16 = (const float*)(ws + WS_G16);
    const bf16* Rb = (const bf16*)(ws + WS_R); const bf16* Vb = (const bf16*)(ws + WS_V); const bf16* KPb = (const bf16*)(ws + WS_KP);
    float* PT = (float*)(ws + WS_PT); float* SL = (float*)(ws + WS_SLOC);
    float* gl = (float*)F.lds + grp * SGRP;
    for (int pair0 = F.bid * 2; pair0 < NC * 8; pair0 += F.G * 2) {
        const int pair = pair0 + grp, c = pair >> 3, h = pair & 7, tb = c * LCH;
        const int vrow0 = 32 * ((w4 + 2 * grp) & 3) + 4 * rs;
        const bool isP = vrow0 < 64; const int srow0 = vrow0 & 63;
        f32x2 s[4][4];
#pragma unroll
        for (int i = 0; i < 4; ++i)
#pragma unroll
            for (int j = 0; j < 4; ++j) s[i][j] = (f32x2){(isP && (srow0 + i == 8 * kg + 2 * j)) ? 1.f : 0.f, (isP && (srow0 + i == 8 * kg + 2 * j + 1)) ? 1.f : 0.f};
        if (isP) {
            scan1_chunk<true>(gl, gl, NSC, G16, KK, Bb, KPb, Vb, Rb, Wd, tb, h, gt, srow0, kg, s);
#pragma unroll
            for (int j = 0; j < 8; ++j) *(f32x4*)(PT + ((size_t)(c * 8 + h) * 64 + 8 * kg + j) * 64 + srow0) = (f32x4){s[0][j >> 1][j & 1], s[1][j >> 1][j & 1], s[2][j >> 1][j & 1], s[3][j >> 1][j & 1]};
        } else {
            scan1_chunk<false>(gl, gl, NSC, G16, KK, Bb, KPb, Vb, Rb, KK, tb, h, gt, srow0, kg, s);
#pragma unroll
            for (int i = 0; i < 4; ++i) { float* sp = SL + ((size_t)(c * 8 + h) * 64 + srow0 + i) * 64 + 8 * kg;
                *(f32x4*)sp = (f32x4){s[i][0].x, s[i][0].y, s[i][1].x, s[i][1].y}; *(f32x4*)(sp + 4) = (f32x4){s[i][2].x, s[i][2].y, s[i][3].x, s[i][3].y}; }
        }
    }
}
DI void split8(const f32x4& x0, const f32x4& x1, bf16x8& hi, bf16x8& lo) {
    unsigned hb[8], lb[8];
#pragma unroll
    for (int e = 0; e < 8; ++e) { const float x = e < 4 ? x0[e & 3] : x1[e & 3]; hb[e] = __float_as_uint(x) & 0xffff0000u; lb[e] = __float_as_uint(x - __uint_as_float(hb[e])); }
    u32x4 h, l;
#pragma unroll
    for (int p = 0; p < 4; ++p) { h[p] = (hb[2 * p] >> 16) | hb[2 * p + 1]; l[p] = (lb[2 * p] >> 16) | (lb[2 * p + 1] & 0xffff0000u); }
    hi = __builtin_bit_cast(bf16x8, h); lo = __builtin_bit_cast(bf16x8, l);
}
DI void scan_pass3(Frame& F) {
    unsigned char* ws = F.ws; const int lane = F.lane, grp = F.wid >> 2, w4 = F.wid & 3, fr = lane & 15, fq = lane >> 4;
    const float* QT = F.out; const float* YL = F.out + (size_t)T * RW; const float* SST = (const float*)(ws + WS_SST);
    const bf16* Vb = (const bf16*)(ws + WS_V); const bf16* Gb = (const bf16*)(ws + WS_G); const float* bonus = (const float*)(ws + WS_BON); bf16* mix = (bf16*)(ws + WS_MIX);
    const float *lnxw = F.in[13], *lnxb = F.in[14];
    for (int pair0 = F.bid * 2; pair0 < NC * 8; pair0 += F.G * 2) {
        const int pair = pair0 + grp, c = pair >> 3, h = pair & 7, tb = c * LCH;
        f32x4 sst[4][4];
#pragma unroll
        for (int vt = 0; vt < 4; ++vt)
#pragma unroll
            for (int g4 = 0; g4 < 4; ++g4) sst[vt][g4] = *(const f32x4*)(SST + ((size_t)(c * 8 + h) * 64 + 16 * vt + fr) * 64 + 16 * g4 + 4 * fq);
        bf16x8 ah[4][2], al[4][2];
#pragma unroll
        for (int vt = 0; vt < 4; ++vt)
#pragma unroll
            for (int s2 = 0; s2 < 2; ++s2) split8(sst[vt][2 * s2], sst[vt][2 * s2 + 1], ah[vt][s2], al[vt][s2]);
#pragma unroll 1
        for (int tt = 0; tt < LCH / 64; ++tt) {
            const int t = tb + 16 * (w4 * (LCH / 64) + tt) + fr; const size_t o = (size_t)t * RW + h * 64;
            f32x4 q[4], acc[4]; u32x2 v2a[4], g2a[4];
#pragma unroll
            for (int g4 = 0; g4 < 4; ++g4) { q[g4] = *(const f32x4*)(QT + o + 16 * g4 + 4 * fq); acc[g4] = *(const f32x4*)(YL + o + 16 * g4 + 4 * fq); }
#pragma unroll
            for (int g4 = 0; g4 < 4; ++g4) { v2a[g4] = *(const u32x2*)(Vb + o + 16 * g4 + 4 * fq); g2a[g4] = *(const u32x2*)(Gb + o + 16 * g4 + 4 * fq); }
            const float bo = bonus[(size_t)t * 8 + h];
            bf16x8 bh[2], bl[2];
#pragma unroll
            for (int s2 = 0; s2 < 2; ++s2) split8(q[2 * s2], q[2 * s2 + 1], bh[s2], bl[s2]);
#pragma unroll
            for (int vt = 0; vt < 4; ++vt)
#pragma unroll
                for (int s2 = 0; s2 < 2; ++s2) { acc[vt] = MFMA16(ah[vt][s2], bh[s2], acc[vt]); acc[vt] = MFMA16(ah[vt][s2], bl[s2], acc[vt]); acc[vt] = MFMA16(al[vt][s2], bh[s2], acc[vt]); }
            float sm = 0.f;
#pragma unroll
            for (int vt = 0; vt < 4; ++vt) sm += (acc[vt][0] + acc[vt][1]) + (acc[vt][2] + acc[vt][3]);
            sm += __shfl_xor(sm, 16); sm += __shfl_xor(sm, 32);
            const float mean = sm * (1.0f / 64); float qq = 0.f;
#pragma unroll
            for (int vt = 0; vt < 4; ++vt) { acc[vt] = acc[vt] - mean; qq += (acc[vt][0] * acc[vt][0] + acc[vt][1] * acc[vt][1]) + (acc[vt][2] * acc[vt][2] + acc[vt][3] * acc[vt][3]); }
            qq += __shfl_xor(qq, 16); qq += __shfl_xor(qq, 32);
            const float rstd = rsqrtf(qq * (1.0f / 64) + 64e-5f);
#pragma unroll
            for (int vt = 0; vt < 4; ++vt) { const int c4 = 16 * vt + 4 * fq; const f32x4 lw4 = *(const f32x4*)(lnxw + h * 64 + c4), lb4 = *(const f32x4*)(lnxb + h * 64 + c4);
                const u32x2 v2 = v2a[vt], g2 = g2a[vt];
                const float vv[4] = {bflo(v2.x), bfhi(v2.x), bflo(v2.y), bfhi(v2.y)}, gg[4] = {bflo(g2.x), bfhi(g2.x), bflo(g2.y), bfhi(g2.y)}; float o4[4];
#pragma unroll
                for (int e = 0; e < 4; ++e) o4[e] = (acc[vt][e] * rstd * lw4[e] + lb4[e] + bo * vv[e]) * gg[e];
                u32x2 w; w.x = pk2(o4[0], o4[1]); w.y = pk2(o4[2], o4[3]); *(u32x2*)(mix + (size_t)t * 1024 + h * 64 + c4) = w; }
        }
    }
}
DI void scan_pass2(Frame& F, int task, int jt, float* xch, bool active) {
    unsigned char* ws = F.ws; const int lane = F.lane, fr = lane & 15, fq = lane >> 4, h = task >> 2, ib = task & 3;
    const float* PT = (const float*)(ws + WS_PT); const float* SL = (const float*)(ws + WS_SLOC); float* SST = (float*)(ws + WS_SST);
    f32x4 S[4];
#pragma unroll
    for (int j = 0; j < 4; ++j) S[j] = (f32x4){0.f, 0.f, 0.f, 0.f};
    f32x4 pv0[4], pv1[4], pv2[4], nl0, nl1, nl2, own = (f32x4){0.f, 0.f, 0.f, 0.f};
#define P2_LOAD(c_, PV, NL) do { const int cc_ = (c_) < NC - 1 ? (c_) : NC - 2; const size_t m_ = (size_t)(cc_ * 8 + h) * 4096; NL = *(const f32x4*)(SL + m_ + (16 * ib + fr) * 64 + 16 * jt + 4 * fq); \
        _Pragma("unroll") for (int t4 = 0; t4 < 4; ++t4) PV[t4] = *(const f32x4*)(PT + m_ + (16 * jt + fr) * 64 + 16 * t4 + 4 * fq); } while (0)
#define P2_STEP(c_, PV, NL) do { *(f32x4*)(SST + (size_t)((c_) * 8 + h) * 4096 + (16 * ib + fr) * 64 + 16 * jt + 4 * fq) = own; \
        _Pragma("unroll") for (int t4 = 0; t4 < 4; ++t4) _Pragma("unroll") for (int rg = 0; rg < 4; ++rg) NL = __builtin_amdgcn_mfma_f32_16x16x4f32(PV[t4][rg], S[t4][rg], NL, 0, 0, 0); \
        float* xb_ = xch + ((c_) & 1) * 1024; own = NL; *(f32x4*)(xb_ + jt * 256 + lane * 4) = NL; \
        P2_LOAD((c_) + 3, PV, NL); \
        asm volatile("s_waitcnt lgkmcnt(0)" ::: "memory"); __builtin_amdgcn_s_barrier(); asm volatile("" ::: "memory"); \
        _Pragma("unroll") for (int j = 0; j < 4; ++j) S[j] = *(const f32x4*)(xb_ + j * 256 + lane * 4); } while (0)
    static_assert((NC - 1) % 3 == 0, "pass 2 is unrolled by 3");
    if (!active) { for (int c = 0; c < NC - 1; ++c) { asm volatile("s_waitcnt lgkmcnt(0)" ::: "memory"); __builtin_amdgcn_s_barrier(); asm volatile("" ::: "memory"); } return; }
    P2_LOAD(0, pv0, nl0); P2_LOAD(1, pv1, nl1); P2_LOAD(2, pv2, nl2);
    for (int c = 0; c < NC - 1; c += 3) { P2_STEP(c, pv0, nl0); P2_STEP(c + 1, pv1, nl1); P2_STEP(c + 2, pv2, nl2); }
    *(f32x4*)(SST + (size_t)((NC - 1) * 8 + h) * 4096 + (16 * ib + fr) * 64 + 16 * jt + 4 * fq) = own;
#undef P2_STEP
#undef P2_LOAD
}


#ifndef MK_PER_PHASE
#define MK_PER_PHASE 0
#endif
constexpr int NPHASES = 12;
typedef KArgs Args;
static_assert(sizeof(Args) == 33 * 8 + 8, "no padding");

__global__ void __launch_bounds__(NTHR, 2) hybrid_fwd(Args args) {
    extern __shared__ __attribute__((aligned(16))) unsigned char lds[];
    cg::grid_group grid = cg::this_grid();
    Frame F;
    F.lds = lds; F.tid = threadIdx.x; F.lane = F.tid & 63; F.wid = __builtin_amdgcn_readfirstlane(F.tid >> 6); F.bid = blockIdx.x; F.G = gridDim.x;
    F.in.ka = (const __attribute__((address_space(4))) KArgs*)__builtin_amdgcn_kernarg_segment_ptr();
    F.out = args.out; F.ws = args.ws;
    unsigned char* ws = args.ws;
    PG8_LAS unsigned char* glds = (PG8_LAS unsigned char*)lds;
    float* ctl = (float*)(ws + WS_CTL); float *ss1 = ctl, *ss2 = ctl + T, *ss3 = ctl + 2 * T, *sg1 = ctl + 3 * T, *sg2 = ctl + 4 * T;
    const int lo = args.ph_lo, hi = args.ph_hi;
    const float rone = F.G > (1 << 20) ? 2.0f : 1.0f;
    volatile LAS unsigned* MISC = (volatile LAS unsigned*)(glds + LDS_BYTES - 64);
    if (F.tid < 16) MISC[F.tid] = 0u;
    __syncthreads();
    XcdBarrier bar = xcd_barrier_post((unsigned*)(ws + WS_CTL + 768 * KiB), MISC);
#ifndef PHMASK
#define PHMASK 0xfff
#endif
#define IN(k) (((PHMASK >> (k)) & 1) && lo <= (k) && (k) < hi)
#define SEAM(k) do { if ((k) + 1 < hi) { if (hi > NPHASES) grid.sync(); else xcd_barrier(bar); } } while (0)
#ifndef DBLMASK
#define DBLMASK 0
#endif
#define REPS(k) for (int rep = 0; rep < (((DBLMASK >> (k)) & 1) ? 2 : 1); ++rep)
    float* dummy = ctl + 8 * T;

    if (IN(0)) { REPS(0) p0_prologue(F); SEAM(0); }
    if (IN(1)) {
        REPS(1) { pg8::Gemm g{(const bf16*)(ws + WS_XB), (const bf16*)(ws + WS_WIN), T, NIN, D}; pg8::StaticOrder S; S.init(T, NIN, F.G, F.bid);
          fill_rs_table(F, T / 256, NIN / 256, (const float*)(ws + WS_RS0), false);
          EpiZ E{(bf16*)(ws + WS_ZR), (bf16*)(ws + WS_SU), (const float*)(F.lds + RS_TAB_OFF), rep ? dummy : sg1, rep ? dummy + T : sg2};
          pg8::gemm_phase<EpiZ, pg8::StaticOrder>(glds, g, S, E, nullptr); }
        { const int lb = F.bid - 192;
          if (lb >= 0 && lb < 56) tr_run(F, lb * NWAVES + F.wid, 56 * NWAVES, TR_LATE0, TR_DN0 - TR_LATE0, 1 << 30, 0); }
        { const int b = F.bid - (F.G - 8); const bool isk = b >= 0 && b < 4, isv = b >= 4 && b < 8;
          if (isk) { pg8::Gemm g{(const bf16*)(ws + WS_MB), (const bf16*)(ws + WS_WK), MEM, D, D}; FewOrder S{0, b, true}; EpiBf E{(bf16*)(ws + WS_KB), 256, nullptr, rone, 256 * 256};
              pg8::gemm_phase<EpiBf, FewOrder>(glds, g, S, E, nullptr); }
          if (isv) { pg8::Gemm g{(const bf16*)(ws + WS_MB), (const bf16*)(ws + WS_WV), MEM, D, D}; FewOrder S{0, b - 4, true}; EpiBf E{(bf16*)(ws + WS_VT), 256, nullptr, rone, 256 * 256};
              pg8::gemm_phase<EpiBf, FewOrder>(glds, g, S, E, nullptr); } }
        SEAM(1); }
    if (IN(2)) { REPS(2) prep_phase(F); SEAM(2); }
    if (IN(3)) { REPS(3) scan_pass1(F); SEAM(3); }
    if (IN(4)) {
        REPS(4) { if (F.bid < 32) scan_pass2(F, F.bid, F.wid & 3, (float*)F.lds, F.wid < 4);
        else if (F.bid < 48) {
            const int fu = F.bid - 32, fh = fu >> 2, fpm = fu & 3;
            pg8::Gemm g{(const bf16*)(ws + WS_WOTH) + (size_t)fh * D * 256, (const bf16*)(ws + WS_VT) + (size_t)fh * 256 * 256, D, 256, 256}; FewOrder S{fpm, 0, true};
            EpiBf E{(bf16*)(ws + WS_WO) + fh * 256, D, nullptr, rone};
            pg8::gemm_phase<EpiBf, FewOrder>(glds, g, S, E, nullptr); }
        else if (F.bid < 64) {
            const int fu = F.bid - 48, fh = fu >> 2, fpn = fu & 3;
            pg8::Gemm g{(const bf16*)(ws + WS_KB) + (size_t)fh * 256 * 256, (const bf16*)(ws + WS_WQ) + (size_t)fh * D * 256, 256, D, 256}; FewOrder S{0, fpn, true};
            EpiBf E{(bf16*)(ws + WS_WK) + (size_t)fh * 256 * D, D, nullptr, rone};
            pg8::gemm_phase<EpiBf, FewOrder>(glds, g, S, E, nullptr); }
        else { if (F.wid < 6) sgu_items(F, (F.bid - 64) * 6 + F.wid, 1 << 30); } }
        SEAM(4); }
    if (IN(5)) { REPS(5) scan_pass3(F); SEAM(5); }
    if (IN(6)) {
        REPS(6) { pg8::Gemm g{(const bf16*)(ws + WS_MIX), (const bf16*)(ws + WS_WOUT), T, D, D}; pg8::StaticOrder S; S.init(T, D, F.G, F.bid);
        EpiRes E{F.in[0], nullptr, (bf16*)(ws + WS_XB), rep ? dummy : ss1};
        pg8::gemm_phase<EpiRes, pg8::StaticOrder>(glds, g, S, E, nullptr); } SEAM(6); }
    if (IN(7)) {
        pg8::Gemm g{(const bf16*)(ws + WS_XB), (const bf16*)(ws + WS_WK), T, D, D}; pg8::StaticOrder S; S.init(T, D, F.G, F.bid);
        EpiSoftmax E{(bf16*)(ws + WS_OB), ss1};
        pg8::gemm_phase<EpiSoftmax, pg8::StaticOrder>(glds, g, S, E, nullptr); SEAM(7); }
    if (IN(9)) {
        pg8::Gemm g{(const bf16*)(ws + WS_OB), (const bf16*)(ws + WS_WO), T, D, D}; pg8::StaticOrder S; S.init(T, D, F.G, F.bid);
        EpiRes E{nullptr, (const bf16*)(ws + WS_XB), (bf16*)(ws + WS_XB), ss2};
        pg8::gemm_phase<EpiRes, pg8::StaticOrder>(glds, g, S, E, nullptr); SEAM(9); }
    if (IN(10)) {
        pg8::Gemm g{(const bf16*)(ws + WS_XB), (const bf16*)(ws + WS_WGU), T, 2 * FF, D}; pg8::StaticOrder S; S.init(T, 2 * FF, F.G, F.bid);
        fill_rs_table(F, T / 256, 2 * FF / 256, ss2, true);
        EpiSwi E{(bf16*)(ws + WS_HFF), (const float*)(F.lds + RS_TAB_OFF)};
        REPS(10) pg8::gemm_phase<EpiSwi, pg8::StaticOrder>(glds, g, S, E, nullptr);
        if (F.bid >= 128) tr_run(F, (F.bid - 128) * NWAVES + F.wid, (F.G - 128) * NWAVES, TR_DN0, TR_I_DN, 1 << 30, 0);
        SEAM(10); }
    if (IN(11)) {
        pg8::Gemm g{(const bf16*)(ws + WS_HFF), (const bf16*)(ws + WS_WD), T, D, FF}; pg8::StaticOrder S; S.init(T, D, F.G, F.bid);
        EpiFinal E{(const bf16*)(ws + WS_XB), F.out, ss3, (unsigned*)(ctl + 10 * T), F.in[30]};
        pg8::gemm_phase<EpiFinal, pg8::StaticOrder>(glds, g, S, E, nullptr); }
#ifdef SYNCX
    for (int i = 0; i < SYNCX; ++i) xcd_barrier(bar);
#endif
#undef IN
#undef SEAM
}

extern "C" void kernel_launch(void* const* d_in, const int* in_sizes, int n_in, void* d_out, int out_size, void* d_ws, size_t ws_size, hipStream_t stream) {
    static int grid = 0;
    if (grid == 0) {
        if (n_in != 31 || in_sizes[0] != T * D || out_size != T * D || ws_size < WS_END) { fprintf(stderr, "kernel_launch: unexpected shapes (n_in %d, in0 %d, out %d, ws %zu)\n", n_in, n_in > 0 ? in_sizes[0] : -1, out_size, ws_size); grid = -1; return; }
        int dev = 0, cus = 0, per_cu = 0;
        if (hipGetDevice(&dev) != hipSuccess || hipDeviceGetAttribute(&cus, hipDeviceAttributeMultiprocessorCount, dev) != hipSuccess) { grid = -1; return; }
        if (hipFuncSetAttribute((const void*)hybrid_fwd, hipFuncAttributeMaxDynamicSharedMemorySize, LDS_BYTES) != hipSuccess) { fprintf(stderr, "kernel_launch: hipFuncSetAttribute failed\n"); grid = -1; return; }
        if (hipOccupancyMaxActiveBlocksPerMultiprocessor(&per_cu, (const void*)hybrid_fwd, NTHR, LDS_BYTES) != hipSuccess || per_cu < 1) { fprintf(stderr, "kernel_launch: occupancy query says %d blocks per CU\n", per_cu); per_cu = 1; }
        (void)hipGetLastError();
        grid = cus * per_cu;
    }
    if (grid < 0) return;
    if (hipMemsetAsync((char*)d_ws + WS_CTL, 0, CTL_BYTES, stream) != hipSuccess) { fprintf(stderr, "kernel_launch: memset failed\n"); return; }
    Args a{};
    for (int i = 0; i < 31; ++i) a.in[i] = (const float*)d_in[i];
    a.out = (float*)d_out; a.ws = (unsigned char*)d_ws;
#if MK_PER_PHASE
    for (int p = 0; p < NPHASES; ++p) { a.ph_lo = p; a.ph_hi = p + 1; hipLaunchKernelGGL(hybrid_fwd, dim3(grid), dim3(NTHR), LDS_BYTES, stream, a); }
#else
    a.ph_lo = 0; a.ph_hi = NPHASES;
    void* kargs[] = {&a};
    hipError_t e = hipLaunchCooperativeKernel((const void*)hybrid_fwd, dim3(grid), dim3(NTHR), kargs, LDS_BYTES, stream);
    if (e != hipSuccess) fprintf(stderr, "kernel_launch: cooperative launch failed: %s (grid %d)\n", hipGetErrorString(e), grid);
#endif
}
```

```cpp
#include <hip/hip_runtime.h>
#include <hip/hip_cooperative_groups.h>
#include <cstdio>
namespace cg = cooperative_groups;

namespace pg8 {
#define PG8_LAS __attribute__((address_space(3)))
typedef unsigned short bf16_t;
typedef short bf16x8 __attribute__((ext_vector_type(8)));
typedef float f32x4 __attribute__((ext_vector_type(4)));
typedef unsigned u32x4 __attribute__((ext_vector_type(4)));
constexpr int BM = 256, BK = 64, HALF = 128, HTB = HALF * BK * 2  , STAGE_BYTES = 8 * HTB, NXCD = 8, WGM = 8;

__host__ __device__ __forceinline__ int lds_byte(int r, int c) { const int st = (r >> 4) * 2 + (c >> 5), rr = r & 15, cc = c & 31, ob = rr * 64 + cc * 2; return st * 1024 + (ob ^ (((ob >> 9) & 1) << 5)); }
__host__ __device__ __forceinline__ void stage_rc(int b, int& R, int& C) { const int st = b / 1024, sb = b % 1024, swz = sb ^ (((sb >> 9) & 1) << 5); R = (st >> 1) * 16 + swz / 64; C = (st & 1) * 32 + (swz % 64) / 2; }
__host__ __device__ __forceinline__ int perm32(int rho) { const int n = rho >> 4, i = rho & 15; return 8 * (i >> 2) + 4 * n + (i & 3); }

struct Unit { int pm, pn; };
struct Gemm { const bf16_t* A; const bf16_t* Bt; int M, N, K; };

struct StaticOrder {
    int nM, nN, nwg, G, c;
    __host__ __device__ void init(int M, int N, int G_, int c_) { nM = M / BM; nN = N / BM; nwg = nM * nN; G = G_; c = c_; }
    __host__ __device__ bool next(int i, Unit& u) const {
        const long L = (long)i * G + c; if (L >= nwg) return false;
        int wgid = (int)L; { const int q = nwg / NXCD, r = nwg % NXCD, xcd = wgid % NXCD, off = wgid / NXCD; wgid = (xcd < r ? xcd * (q + 1) : r * (q + 1) + (xcd - r) * q) + off; }
        const int nig = WGM * nN, gid = wgid / nig, fm = gid * WGM, gsz = (nM - fm) < WGM ? (nM - fm) : WGM;
        u.pm = fm + ((wgid % nig) % gsz); u.pn = (wgid % nig) / gsz; return true;
    }
    __device__ __forceinline__ void a_ready(const Unit&) const {}
    __device__ __forceinline__ void done(const Unit&) const {}
};
__device__ __forceinline__ unsigned cvt_pk_bf16(float lo, float hi) { unsigned r; asm volatile("v_cvt_pk_bf16_f32 %0, %1, %2" : "=v"(r) : "v"(lo), "v"(hi)); return r; }
typedef float f32x2 __attribute__((ext_vector_type(2)));
__device__ __forceinline__ f32x2 gelu_pk(f32x2 v) {
    const f32x2 av = __builtin_elementwise_abs(v), d = av * 0.2316418882f + 1.0f;
    f32x2 t; t.x = __builtin_amdgcn_rcpf(d.x); t.y = __builtin_amdgcn_rcpf(d.y);
    f32x2 q = t * 0.5307027145f + (-0.7265760135f); q = q * t + 0.7107068705f; q = q * t + (-0.142248368f); q = q * t + 0.127414796f; q = q * t;
    const f32x2 s = (v * v) * (-0.72134752044f);
    f32x2 e; e.x = __builtin_amdgcn_exp2f(s.x); e.y = __builtin_amdgcn_exp2f(s.y);
    const f32x2 m = v * (q * e), r = v - m;
    f32x2 o; o.x = v.x < 0.f ? m.x : r.x; o.y = v.y < 0.f ? m.y : r.y; return o;
}

template <class Epi, class Sched, bool STAMP = false>
__device__ __forceinline__ void gemm_phase(PG8_LAS unsigned char* lds, const Gemm g, const Sched& S, const Epi& E, unsigned long long* stamps) {
    const int tid = threadIdx.x, wid = __builtin_amdgcn_readfirstlane(tid >> 6), lane = tid & 63, wr = wid >> 2, wc = wid & 3, fr = lane & 15, fq = lane >> 4;
    const int K = g.K, nt = K / BK;
    int ts_lo = 0, ts_hi = 0, nts = 0; const unsigned long long rt_entry = STAMP ? (unsigned long long)wall_clock64() : 0ull;
#define PG8_STAMP() do { if (STAMP && wid == 0 && nts < 64) { const unsigned long long _c = (unsigned long long)clock64(); \
        ts_lo = (lane == nts) ? (int)(unsigned)_c : ts_lo; ts_hi = (lane == nts) ? (int)(unsigned)(_c >> 32) : ts_hi; ++nts; } } while (0)
    PG8_STAMP();
    unsigned voffA[2], voffB[2];
#pragma unroll
    for (int i = 0; i < 2; ++i) { int R, C; stage_rc(tid * 16 + i * 8192, R, C); const int Rb = Epi::PERM ? ((R & ~31) + perm32(R & 31)) : R;
        voffA[i] = (unsigned)(R * K + C) * 2u; voffB[i] = (unsigned)(Rb * K + C) * 2u; }
    const size_t kstep = (size_t)(BK * 2);
    const size_t hstep = (size_t)HALF * K * 2;
    const size_t tstep = 2 * hstep;
    const unsigned ldsw = (unsigned)wid * 1024u;
    const int aoff = lds_byte(wr * 64 + fr, fq * 8), boff = lds_byte(wc * 32 + fr, fq * 8);
#define PG8_SA(b, h) (((b) * 2 + (h)) * HTB)
#define PG8_SB(b, h) ((4 + (b) * 2 + (h)) * HTB)
#define PG8_STAGE(bufoff, gbase, voff) do { _Pragma("unroll") for (int _i = 0; _i < 2; ++_i) \
        __builtin_amdgcn_global_load_lds((const unsigned*)((const char*)(gbase) + (voff)[_i]), (PG8_LAS unsigned*)(lds + (bufoff) + ldsw + _i * 8192), 16, 0, 0); } while (0)
#define PG8_LDA(dst, b, h) do { _Pragma("unroll") for (int m = 0; m < 4; ++m) _Pragma("unroll") for (int k = 0; k < 2; ++k) dst[m][k] = *(const PG8_LAS bf16x8*)(lds + PG8_SA(b, h) + aoff + m * 2048 + k * 1024); } while (0)
#define PG8_LDB(dst, b, h) do { _Pragma("unroll") for (int n = 0; n < 2; ++n) _Pragma("unroll") for (int k = 0; k < 2; ++k) dst[n][k] = *(const PG8_LAS bf16x8*)(lds + PG8_SB(b, h) + boff + n * 2048 + k * 1024); } while (0)
#define PG8_MMA(ai, bj, At, Bt) do { __builtin_amdgcn_s_setprio(1); _Pragma("unroll") for (int m = 0; m < 4; ++m) _Pragma("unroll") for (int n = 0; n < 2; ++n) _Pragma("unroll") for (int k = 0; k < 2; ++k) \
        acc[ai][bj][m][n] = __builtin_amdgcn_mfma_f32_16x16x32_bf16(Bt[n][k], At[m][k], acc[ai][bj][m][n], 0, 0, 0); __builtin_amdgcn_s_setprio(0); } while (0)
#define PG8_WAIT_V(n) asm volatile("s_waitcnt vmcnt(" #n ")" ::: "memory")
#define PG8_WAIT_L(n) asm volatile("s_waitcnt lgkmcnt(" #n ")" ::: "memory")
#define PG8_BAR __builtin_amdgcn_s_barrier()
#define PG8_SCHED __builtin_amdgcn_sched_barrier(0)
    Unit cur, nxt; int ui = 0;
    if (!S.next(0, cur)) return;
    f32x4 acc[2][2][4][2];
#pragma unroll
    for (int a = 0; a < 2; ++a)
#pragma unroll
        for (int b = 0; b < 2; ++b)
#pragma unroll
            for (int m = 0; m < 4; ++m)
#pragma unroll
                for (int n = 0; n < 2; ++n) acc[a][b][m][n] = (f32x4){0.f, 0.f, 0.f, 0.f};
    bf16x8 At[4][2], B0[2][2], B1[2][2];
    const char* cA = (const char*)g.A + (size_t)cur.pm * tstep; const char* cB = (const char*)g.Bt + (size_t)cur.pn * tstep;
    S.a_ready(cur);
    PG8_STAGE(PG8_SB(0, 0), cB, voffB); PG8_STAGE(PG8_SA(0, 0), cA, voffA); PG8_STAGE(PG8_SB(0, 1), cB + hstep, voffB); PG8_STAGE(PG8_SA(0, 1), cA + hstep, voffA);
    if (wr == 1) PG8_BAR;
    PG8_WAIT_V(4); PG8_BAR;
    PG8_STAGE(PG8_SB(1, 0), cB + kstep, voffB); PG8_STAGE(PG8_SA(1, 0), cA + kstep, voffA); PG8_STAGE(PG8_SB(1, 1), cB + hstep + kstep, voffB);
    PG8_WAIT_V(6); PG8_BAR;
    PG8_STAMP();
    for (;;) {
        const bool has_next = S.next(ui + 1, nxt);
        const char* nA = has_next ? (const char*)g.A + (size_t)nxt.pm * tstep : cA; const char* nB = has_next ? (const char*)g.Bt + (size_t)nxt.pn * tstep : cB;
        for (int t = 0; t < nt; t += 2) {
            const bool last = (t == nt - 2);
            const char* a1 = cA + (size_t)(t + 1) * kstep;
            const char* a2 = last ? nA : cA + (size_t)(t + 2) * kstep; const char* b2 = last ? nB : cB + (size_t)(t + 2) * kstep;
            const char* a3 = a2 + kstep; const char* b3 = b2 + kstep;
            if (last && has_next) S.a_ready(nxt);
            PG8_LDB(B0, 0, 0); PG8_SCHED; PG8_LDA(At, 0, 0); PG8_STAGE(PG8_SA(1, 1), a1 + hstep, voffA);
            PG8_WAIT_L(8); PG8_BAR; PG8_WAIT_L(0); PG8_MMA(0, 0, At, B0); PG8_BAR; PG8_SCHED;
            PG8_LDB(B1, 0, 1); PG8_STAGE(PG8_SB(0, 0), b2, voffB);
            PG8_BAR; PG8_WAIT_L(0); PG8_MMA(0, 1, At, B1); PG8_BAR;
            PG8_LDA(At, 0, 1); PG8_STAGE(PG8_SA(0, 0), a2, voffA);
            PG8_BAR; PG8_WAIT_L(0); PG8_MMA(1, 0, At, B0); PG8_BAR; PG8_SCHED;
            PG8_STAGE(PG8_SB(0, 1), b2 + hstep, voffB);
            PG8_WAIT_V(6); PG8_BAR; PG8_MMA(1, 1, At, B1); PG8_BAR;
            PG8_LDB(B0, 1, 0); PG8_SCHED; PG8_LDA(At, 1, 0); PG8_STAGE(PG8_SA(0, 1), a2 + hstep, voffA);
            PG8_WAIT_L(8); PG8_BAR; PG8_WAIT_L(0); PG8_MMA(0, 0, At, B0); PG8_BAR; PG8_SCHED;
            PG8_LDB(B1, 1, 1); PG8_STAGE(PG8_SB(1, 0), b3, voffB);
            PG8_BAR; PG8_WAIT_L(0); PG8_MMA(0, 1, At, B1); PG8_BAR;
            PG8_LDA(At, 1, 1); PG8_STAGE(PG8_SA(1, 0), a3, voffA);
            PG8_BAR; PG8_WAIT_L(0); PG8_MMA(1, 0, At, B0); PG8_BAR; PG8_SCHED;
            PG8_STAGE(PG8_SB(1, 1), b3 + hstep, voffB);
            PG8_WAIT_V(6); PG8_BAR; PG8_MMA(1, 1, At, B1); PG8_BAR;
        }
        PG8_STAMP();
        if constexpr (!Epi::AFTER_DRAIN) { E(acc, cur, wr, wc, fr, fq); S.done(cur); }
        PG8_STAMP();
        if (!has_next) break;
#pragma unroll
        for (int a = 0; a < 2; ++a)
#pragma unroll
            for (int b = 0; b < 2; ++b)
#pragma unroll
                for (int m = 0; m < 4; ++m)
#pragma unroll
                    for (int n = 0; n < 2; ++n) acc[a][b][m][n] = (f32x4){0.f, 0.f, 0.f, 0.f};
        cur = nxt; cA = nA; cB = nB; ++ui;
    }
    PG8_WAIT_V(0);
    if (wr == 0) PG8_BAR;
    PG8_BAR;
    if constexpr (Epi::AFTER_DRAIN) { E.fused(acc, cur, wr, wc, fr, fq, lds, wid, lane); S.done(cur); }
    PG8_STAMP();
    if (STAMP && wid == 0) { stamps[lane] = lane < nts ? (((unsigned long long)(unsigned)ts_hi << 32) | (unsigned)ts_lo) : 0ull;
        if (lane == 62) stamps[62] = rt_entry; if (lane == 63) stamps[63] = (unsigned long long)wall_clock64(); }
#undef PG8_STAMP
#undef PG8_SA
#undef PG8_SB
#undef PG8_STAGE
#undef PG8_LDA
#undef PG8_LDB
#undef PG8_MMA
#undef PG8_WAIT_V
#undef PG8_WAIT_L
#undef PG8_BAR
#undef PG8_SCHED
}
}

using pg8::bf16x8; using pg8::f32x4; using pg8::u32x4; using pg8::Unit;
typedef unsigned short bf16;
typedef unsigned u32x2 __attribute__((ext_vector_type(2)));
typedef float f32x2 __attribute__((ext_vector_type(2)));
#define LAS __attribute__((address_space(3)))
#define DI __device__ __forceinline__
constexpr int T = 16384, D = 1024, NIN = 2816, RIN = 1792, RW = 512, FF = 2816, MEM = 256;
constexpr int NWAVES = 8, NTHR = 512;
constexpr int LCH = 256, NC = T / LCH;
constexpr float RMS_EPS = 1e-6f;
constexpr size_t MiB = (size_t)1 << 20, KiB = 1024;
constexpr size_t WS_CTL = 0, CTL_BYTES = 1 * MiB;
constexpr size_t WS_WIN = 2 * MiB, WS_WOUT = WS_WIN + (size_t)NIN * D * 2, WS_WQ = WS_WOUT + 2 * MiB, WS_WK = WS_WQ + 2 * MiB, WS_WV = WS_WK + 2 * MiB,
                 WS_WO = WS_WV + 2 * MiB, WS_WGU = WS_WO + 2 * MiB, WS_WD = WS_WGU + (size_t)2 * FF * D * 2;
constexpr size_t WS_XB = 34 * MiB;
constexpr size_t WS_R = WS_XB, WS_V = WS_XB + 16 * MiB;
constexpr size_t WS_G16 = WS_WIN;
constexpr size_t WS_ZR = 66 * MiB;
constexpr size_t WS_PT = WS_ZR, WS_SLOC = WS_ZR + 8 * MiB, WS_SST = WS_ZR + 16 * MiB;
constexpr size_t WS_Q = WS_ZR, WS_HFF = WS_ZR;
constexpr size_t WS_SU = 122 * MiB;
constexpr size_t WS_OB = WS_SU;
constexpr size_t WS_MIX = 154 * MiB;
constexpr size_t WS_B = 186 * MiB;
constexpr size_t WS_KP = 218 * MiB;
constexpr size_t WS_G = 234 * MiB;
constexpr size_t WS_MB = 251 * MiB, WS_KB = WS_MB + 512 * KiB, WS_VT = WS_KB + 512 * KiB, WS_WSB = WS_VT + 512 * KiB, WS_WLT = WS_WSB + 256 * KiB,
                 WS_ALT = WS_WLT + 64 * KiB, WS_GLT = WS_ALT + 64 * KiB, WS_RS0 = WS_GLT + 128 * KiB, WS_BON = WS_RS0 + 256 * KiB, WS_END = WS_BON + 512 * KiB;
constexpr size_t WS_WOTH = 254 * MiB;
static_assert(WS_WD + (size_t)D * FF * 2 <= WS_XB && WS_END <= WS_WOTH && WS_WOTH + 2 * MiB <= 256 * MiB, "ws map");
constexpr int LDS_BYTES = 147456;

DI float bf2f(unsigned b) { return __uint_as_float(b << 16); }
DI float bflo(unsigned w) { return __uint_as_float(w << 16); }
DI float bfhi(unsigned w) { return __uint_as_float(w & 0xffff0000u); }
DI unsigned pk2(float lo, float hi) { return pg8::cvt_pk_bf16(lo, hi); }
DI float wave_sum(float v) {
#pragma unroll
    for (int o = 1; o < 64; o <<= 1) v += __shfl_xor(v, o);
    return v; }
DI float sigmoidf_(float x) { return __builtin_amdgcn_rcpf(1.0f + __expf(-x)); }
DI float gelu_tanh(float v) { const float u2 = 1.5957691216f * (v + 0.044715f * v * v * v); return v * __builtin_amdgcn_rcpf(1.0f + __expf(-u2)); }
#define LDS_FENCE() asm volatile("s_waitcnt lgkmcnt(0)" ::: "memory")
#define MFMA16(a, b, c) __builtin_amdgcn_mfma_f32_16x16x32_bf16((a), (b), (c), 0, 0, 0)

struct KArgs { const float* in[31]; float* out; unsigned char* ws; int ph_lo, ph_hi; };
struct InTab { const __attribute__((address_space(4))) KArgs* ka; DI const float* operator[](int i) const { return ka->in[i]; } };
struct Frame {
    unsigned char* lds; int tid, lane, wid, bid, G;
    InTab in; float* out; unsigned char* ws;
};

#define XB_TMO      128
#define XB_XCNT(j)  (256  + 64 * (j))
#define XB_XSUB(j)  (1280 + 64 * (j))
#define XB_XGEN(j)  (2304 + 64 * (j))
#define XB_TOP      3328
#define XB_TOPGEN   3392
#define XCD_BAR_WORDS 3456
#define XB_SPIN_CAP (1u << 18)

__device__ __forceinline__ unsigned xb_ld(unsigned* p)              { return __hip_atomic_load(p, __ATOMIC_RELAXED, __HIP_MEMORY_SCOPE_AGENT); }
__device__ __forceinline__ unsigned xb_add(unsigned* p, unsigned v) { return __hip_atomic_fetch_add(p, v, __ATOMIC_RELAXED, __HIP_MEMORY_SCOPE_AGENT); }
__device__ __forceinline__ unsigned xb_xcc_id() { return (unsigned)__builtin_amdgcn_s_getreg((3 << 11) | 20) & 0xFu; }
#define XB_SPIN(cond, bar) do { unsigned _sp = 0; while (cond) { __builtin_amdgcn_s_sleep(1); \
    if ((++_sp & 255u) == 0u) { if (xb_ld(&(bar)[XB_TMO])) break; if (_sp > XB_SPIN_CAP) { atomicAdd(&(bar)[XB_TMO], 1u); break; } } } } while (0)

struct XcdBarrier {
    unsigned* bar; unsigned x;
    volatile LAS unsigned* st;
};

__device__ __forceinline__ XcdBarrier xcd_barrier_post(unsigned* bar, volatile LAS unsigned* st) {
    XcdBarrier b; b.bar = bar; b.x = xb_xcc_id(); b.st = st;
    if (threadIdx.x == 0) (void)xb_add(&bar[XB_XCNT(b.x)], 1u);
    return b;
}
__device__ __forceinline__ void xcd_barrier_complete(unsigned* bar, unsigned x, unsigned& nloc, unsigned& nx) {
    const unsigned G = gridDim.x * gridDim.y * gridDim.z;
    unsigned sum, cnt, mine, sp = 0u;
    for (;;) {
        sum = 0u; cnt = 0u; mine = 0u;
#pragma unroll
        for (unsigned j = 0; j < 16; ++j) { const unsigned c = xb_ld(&bar[XB_XCNT(j)]); sum += c; cnt += (c > 0u) ? 1u : 0u; mine = (j == x) ? c : mine; }
        if (sum == G) break;
        __builtin_amdgcn_s_sleep(1);
        if ((++sp & 255u) == 0u) { if (xb_ld(&bar[XB_TMO])) break; if (sp > XB_SPIN_CAP) { atomicAdd(&bar[XB_TMO], 1u); break; } }
    }
    nloc = mine > 0u ? mine : 1u; nx = cnt > 0u ? cnt : 1u;
}

__device__ __forceinline__ void xcd_barrier(const XcdBarrier& b) {
    asm volatile("s_waitcnt vmcnt(0)" ::: "memory");
    __syncthreads();
    if (threadIdx.x == 0) {
        unsigned* bar = b.bar;
        __builtin_amdgcn_s_waitcnt(0);
        unsigned nloc = b.st[0], nx = b.st[1];
        if (nloc == 0u) { xcd_barrier_complete(bar, b.x, nloc, nx); b.st[0] = nloc; b.st[1] = nx; }
        const unsigned old = xb_add(&bar[XB_XSUB(b.x)], 1u);
        const unsigned gen = old / nloc;
        if (old + 1u == (gen + 1u) * nloc) {
            __builtin_amdgcn_fence(__ATOMIC_RELEASE, "agent");
            asm volatile("s_waitcnt vmcnt(0)" ::: "memory");
            const unsigned og = xb_add(&bar[XB_TOP], 1u);
            const unsigned tg = og / nx;
            if (og + 1u == (tg + 1u) * nx) xb_add(&bar[XB_TOPGEN], 1u);
            else XB_SPIN(xb_ld(&bar[XB_TOPGEN]) == tg, bar);
            __builtin_amdgcn_fence(__ATOMIC_ACQUIRE, "agent");
            xb_add(&bar[XB_XGEN(b.x)], 1u);
            asm volatile("s_waitcnt vmcnt(0)" ::: "memory");
        } else {
            XB_SPIN(xb_ld(&bar[XB_XGEN(b.x)]) == gen, bar);
            __builtin_amdgcn_fence(__ATOMIC_ACQUIRE, "agent");
            asm volatile("s_waitcnt vmcnt(0)" ::: "memory");
        }
    }
    __syncthreads();
}

DI bool static_unit(int i, int G, int cid, int nM, int nN, int& pm, int& pn) {
    const int nwg = nM * nN; const long L = (long)i * G + cid; if (L >= nwg) return false;
    int wgid = (int)L; { const int q = nwg / pg8::NXCD, r = nwg % pg8::NXCD, xcd = wgid % pg8::NXCD, off = wgid / pg8::NXCD; wgid = (xcd < r ? xcd * (q + 1) : r * (q + 1) + (xcd - r) * q) + off; }
    const int nig = pg8::WGM * nN, gid = wgid / nig, fm = gid * pg8::WGM, gsz = (nM - fm) < pg8::WGM ? (nM - fm) : pg8::WGM;
    pm = fm + ((wgid % nig) % gsz); pn = (wgid % nig) / gsz; return true; }
constexpr int RS_TAB_OFF = 131072, RS_TAB_UNITS = 8;
DI void fill_rs_table(Frame& F, int nM, int nN, const float* src, bool is_ss) {
    float* tab = (float*)(F.lds + RS_TAB_OFF);
    for (int i = 0; i < RS_TAB_UNITS; ++i) { int pm, pn; if (!static_unit(i, F.G, F.bid, nM, nN, pm, pn)) break;
        if (F.tid < 256) { const float v = src[pm * 256 + F.tid]; tab[i * 256 + F.tid] = is_ss ? rsqrtf(v * (1.0f / D) + RMS_EPS) : v; } }
    __syncthreads();
}
struct EpiZ {
    static constexpr bool PERM = true, AFTER_DRAIN = false;
    bf16* zr; bf16* su; const float* rstab; float* sg1; float* sg2; mutable int ui = 0;
    DI void operator()(const f32x4 (&acc)[2][2][4][2], const Unit& u, int wr, int wc, int fr, int fq) const {
        const int row0 = u.pm * 256 + wr * 64 + fr; const bool isr = u.pn < 7, st = u.pn >= 9;
        bf16* base = isr ? zr : su; const int ldc = isr ? RIN : 1024; const int col0 = (isr ? u.pn : u.pn - 7) * 256 + wc * 32 + 8 * fq;
        float rsv[8];
#pragma unroll
        for (int i = 0; i < 8; ++i) rsv[i] = rstab[ui * 256 + wr * 64 + fr + (i >> 2) * 128 + (i & 3) * 16];
        ++ui;
#pragma unroll
        for (int ai = 0; ai < 2; ++ai)
#pragma unroll
            for (int m = 0; m < 4; ++m) { const int r = row0 + ai * 128 + m * 16; const float rs = rsv[ai * 4 + m]; bf16* rowp = base + (size_t)r * ldc + col0; float s1 = 0.f, s2 = 0.f;
#pragma unroll
                for (int bj = 0; bj < 2; ++bj) { f32x4 v0 = acc[ai][bj][m][0] * rs, v1 = acc[ai][bj][m][1] * rs;
                    if (!isr) {
#pragma unroll
                        for (int j = 0; j < 4; ++j) { v0[j] = gelu_tanh(v0[j]); v1[j] = gelu_tanh(v1[j]); }
#pragma unroll
                        for (int j = 0; j < 4; ++j) { s1 += v0[j] + v1[j]; s2 += v0[j] * v0[j] + v1[j] * v1[j]; } }
                    u32x4 w; w.x = pk2(v0[0], v0[1]); w.y = pk2(v0[2], v0[3]); w.z = pk2(v1[0], v1[1]); w.w = pk2(v1[2], v1[3]);
                    *(u32x4*)(rowp + bj * 128) = w; }
                if (st) { s1 += __shfl_xor(s1, 16); s1 += __shfl_xor(s1, 32); s2 += __shfl_xor(s2, 16); s2 += __shfl_xor(s2, 32);
                    if (fq == 0) { atomicAdd(sg1 + r, s1); atomicAdd(sg2 + r, s2); } } }
    }
};
struct EpiBf {
    static constexpr bool PERM = true, AFTER_DRAIN = false;
    bf16* O; int ldc; const float* ss; float one; int head_stride = 0;
    DI void operator()(const f32x4 (&acc)[2][2][4][2], const Unit& u, int wr, int wc, int fr, int fq) const {
        const int row0 = u.pm * 256 + wr * 64 + fr, col0 = (head_stride ? 0 : u.pn * 256) + wc * 32 + 8 * fq; bf16* Ob = O + (size_t)(head_stride ? u.pn : 0) * head_stride;
        float rsv[8];
#pragma unroll
        for (int i = 0; i < 8; ++i) rsv[i] = ss ? rsqrtf(ss[row0 + (i >> 2) * 128 + (i & 3) * 16] * (1.0f / D) + RMS_EPS) : one;
#pragma unroll
        for (int ai = 0; ai < 2; ++ai)
#pragma unroll
            for (int m = 0; m < 4; ++m) { const int r = row0 + ai * 128 + m * 16; const float rs = rsv[ai * 4 + m]; bf16* rowp = Ob + (size_t)r * ldc + col0;
#pragma unroll
                for (int bj = 0; bj < 2; ++bj) { const f32x4 v0 = acc[ai][bj][m][0] * rs, v1 = acc[ai][bj][m][1] * rs;
                    u32x4 w; w.x = pk2(v0[0], v0[1]); w.y = pk2(v0[2], v0[3]); w.z = pk2(v1[0], v1[1]); w.w = pk2(v1[2], v1[3]);
                    *(u32x4*)(rowp + bj * 128) = w; } }
    }
};
struct EpiRes {
    static constexpr bool PERM = false, AFTER_DRAIN = false;
    const float* basef; const bf16* baseb; bf16* xb; float* ss;
    DI void ld(f32x4 (&d)[4], size_t off) const {
        if (basef) {
#pragma unroll
            for (int q = 0; q < 4; ++q) d[q] = __builtin_nontemporal_load((const f32x4*)(basef + off + (q >> 1) * 128 + (q & 1) * 16));
        } else {
#pragma unroll
            for (int q = 0; q < 4; ++q) { const u32x2 w = *(const u32x2*)(baseb + off + (q >> 1) * 128 + (q & 1) * 16); d[q] = (f32x4){bflo(w.x), bfhi(w.x), bflo(w.y), bfhi(w.y)}; }
        } }
    DI void operator()(const f32x4 (&acc)[2][2][4][2], const Unit& u, int wr, int wc, int fr, int fq) const {
        const int row0 = u.pm * 256 + wr * 64 + fr, col0 = u.pn * 256 + wc * 32 + 4 * fq;
        f32x4 bc[4], bn[4];
        ld(bc, (size_t)row0 * D + col0);
#pragma unroll
        for (int idx = 0; idx < 8; ++idx) { const int ai = idx >> 2, m = idx & 3; const int r = row0 + ai * 128 + m * 16; const size_t off = (size_t)r * D + col0; float s2 = 0.f;
            if (idx + 1 < 8) ld(bn, (size_t)(row0 + ((idx + 1) >> 2) * 128 + ((idx + 1) & 3) * 16) * D + col0);
#pragma unroll
            for (int bj = 0; bj < 2; ++bj)
#pragma unroll
                for (int n = 0; n < 2; ++n) { const f32x4 o = bc[bj * 2 + n] + acc[ai][bj][m][n];
                    s2 += (o[0] * o[0] + o[1] * o[1]) + (o[2] * o[2] + o[3] * o[3]);
                    u32x2 w; w.x = pk2(o[0], o[1]); w.y = pk2(o[2], o[3]); *(u32x2*)(xb + off + bj * 128 + n * 16) = w; }
            s2 += __shfl_xor(s2, 16); s2 += __shfl_xor(s2, 32);
            if (fq == 0) atomicAdd(ss + r, s2);
#pragma unroll
            for (int q = 0; q < 4; ++q) bc[q] = bn[q];
            asm volatile("" ::: "memory"); }
    }
};
struct EpiFinal {
    static constexpr bool PERM = false, AFTER_DRAIN = true;
    const bf16* base; float* out; float* ss; unsigned* cnt; const float* gf;
    DI void ld(f32x4 (&d)[4], size_t off) const {
#pragma unroll
        for (int q = 0; q < 4; ++q) { const u32x2 w = *(const u32x2*)(base + off + (q >> 1) * 128 + (q & 1) * 16); d[q] = (f32x4){bflo(w.x), bfhi(w.x), bflo(w.y), bfhi(w.y)}; } }
    DI void fused(f32x4 (&acc)[2][2][4][2], const Unit& u, int wr, int wc, int fr, int fq, PG8_LAS unsigned char* lds, int wid, int lane) const {
        const int row0 = u.pm * 256 + wr * 64 + fr, col0 = u.pn * 256 + wc * 32 + 4 * fq;
        f32x4 bc[4], bn[4];
        ld(bc, (size_t)row0 * D + col0);
#pragma unroll
        for (int idx = 0; idx < 8; ++idx) { const int ai = idx >> 2, m = idx & 3; const int r = row0 + ai * 128 + m * 16; float s2 = 0.f;
            if (idx + 1 < 8) ld(bn, (size_t)(row0 + ((idx + 1) >> 2) * 128 + ((idx + 1) & 3) * 16) * D + col0);
#pragma unroll
            for (int bj = 0; bj < 2; ++bj)
#pragma unroll
                for (int n = 0; n < 2; ++n) { const f32x4 o = bc[bj * 2 + n] + acc[ai][bj][m][n]; acc[ai][bj][m][n] = o; s2 += (o[0] * o[0] + o[1] * o[1]) + (o[2] * o[2] + o[3] * o[3]); }
            s2 += __shfl_xor(s2, 16); s2 += __shfl_xor(s2, 32);
            if (fq == 0) atomicAdd(ss + r, s2);
#pragma unroll
            for (int q = 0; q < 4; ++q) bc[q] = bn[q];
            asm volatile("" ::: "memory"); }
        asm volatile("s_waitcnt vmcnt(0)" ::: "memory");
        __syncthreads();
        if (threadIdx.x == 0) { unsigned* c = cnt + 64 * u.pm; __hip_atomic_fetch_add(c, 1u, __ATOMIC_RELAXED, __HIP_MEMORY_SCOPE_AGENT);
            unsigned sp = 0; while (__hip_atomic_load(c, __ATOMIC_RELAXED, __HIP_MEMORY_SCOPE_AGENT) < (unsigned)(D / 256) && ++sp < (1u << 22)) __builtin_amdgcn_s_sleep(1); }
        __syncthreads();
        f32x4 g4[4];
#pragma unroll
        for (int q = 0; q < 4; ++q) g4[q] = *(const f32x4*)(gf + col0 + (q >> 1) * 128 + (q & 1) * 16);
#pragma unroll
        for (int idx = 0; idx < 8; ++idx) { const int ai = idx >> 2, m = idx & 3; const int r = row0 + ai * 128 + m * 16; const size_t off = (size_t)r * D + col0;
            const float rs = rsqrtf(__hip_atomic_load(ss + r, __ATOMIC_RELAXED, __HIP_MEMORY_SCOPE_AGENT) * (1.0f / D) + RMS_EPS);
#pragma unroll
            for (int bj = 0; bj < 2; ++bj)
#pragma unroll
                for (int n = 0; n < 2; ++n) *(f32x4*)(out + off + bj * 128 + n * 16) = acc[ai][bj][m][n] * rs * g4[bj * 2 + n]; }
    }
};
struct EpiSoftmax {
    static constexpr bool PERM = true, AFTER_DRAIN = true;
    bf16* P; const float* ss;
    DI void fused(f32x4 (&acc)[2][2][4][2], const Unit& u, int wr, int wc, int fr, int fq, PG8_LAS unsigned char* lds, int wid, int lane) const {
        PG8_LAS float* red = (PG8_LAS float*)lds;
        const int lrow0 = wr * 64 + fr, grow0 = u.pm * 256 + lrow0;
#pragma unroll
        for (int idx = 0; idx < 8; ++idx) { const int ai = idx >> 2, m = idx & 3, lr = lrow0 + ai * 128 + m * 16; const float rs = rsqrtf(ss[grow0 + ai * 128 + m * 16] * (1.0f / D) + RMS_EPS) * 0.0625f; float mx = -1e30f;
#pragma unroll
            for (int bj = 0; bj < 2; ++bj)
#pragma unroll
                for (int n = 0; n < 2; ++n) { const f32x4 v = acc[ai][bj][m][n] * rs; acc[ai][bj][m][n] = v; mx = fmaxf(mx, fmaxf(fmaxf(v[0], v[1]), fmaxf(v[2], v[3]))); }
            mx = fmaxf(mx, __shfl_xor(mx, 16)); mx = fmaxf(mx, __shfl_xor(mx, 32));
            if (fq == 0) red[lr * 4 + wc] = mx; }
        asm volatile("s_waitcnt lgkmcnt(0)" ::: "memory"); __builtin_amdgcn_s_barrier(); asm volatile("" ::: "memory");
#pragma unroll
        for (int idx = 0; idx < 8; ++idx) { const int ai = idx >> 2, m = idx & 3, lr = lrow0 + ai * 128 + m * 16; const f32x4 m4 = *(const PG8_LAS f32x4*)(red + lr * 4);
            const float mx = fmaxf(fmaxf(m4[0], m4[1]), fmaxf(m4[2], m4[3])); float sm = 0.f;
#pragma unroll
            for (int bj = 0; bj < 2; ++bj)
#pragma unroll
                for (int n = 0; n < 2; ++n) { f32x4 v = acc[ai][bj][m][n];
#pragma unroll
                    for (int e = 0; e < 4; ++e) { v[e] = __expf(v[e] - mx); sm += v[e]; }
                    acc[ai][bj][m][n] = v; }
            sm += __shfl_xor(sm, 16); sm += __shfl_xor(sm, 32);
            if (fq == 0) red[1024 + lr * 4 + wc] = sm; }
        asm volatile("s_waitcnt lgkmcnt(0)" ::: "memory"); __builtin_amdgcn_s_barrier(); asm volatile("" ::: "memory");
#pragma unroll
        for (int idx = 0; idx < 8; ++idx) { const int ai = idx >> 2, m = idx & 3, lr = lrow0 + ai * 128 + m * 16; const f32x4 s4 = *(const PG8_LAS f32x4*)(red + 1024 + lr * 4);
            const float inv = 1.0f / ((s4[0] + s4[1]) + (s4[2] + s4[3])); bf16* rowp = P + (size_t)(grow0 + ai * 128 + m * 16) * D + u.pn * 256 + wc * 32 + 8 * fq;
#pragma unroll
            for (int bj = 0; bj < 2; ++bj) { const f32x4 v0 = acc[ai][bj][m][0] * inv, v1 = acc[ai][bj][m][1] * inv;
                u32x4 w; w.x = pk2(v0[0], v0[1]); w.y = pk2(v0[2], v0[3]); w.z = pk2(v1[0], v1[1]); w.w = pk2(v1[2], v1[3]);
                *(u32x4*)(rowp + bj * 128) = w; } }
    }
};
struct EpiSwi {
    static constexpr bool PERM = true, AFTER_DRAIN = false;
    bf16* H; const float* rstab; mutable int ui = 0;
    DI void operator()(const f32x4 (&acc)[2][2][4][2], const Unit& u, int wr, int wc, int fr, int fq) const {
        const int row0 = u.pm * 256 + wr * 64 + fr, col0 = u.pn * 128 + wc * 32 + 8 * fq;
        float rsv[8];
#pragma unroll
        for (int i = 0; i < 8; ++i) rsv[i] = rstab[ui * 256 + wr * 64 + fr + (i >> 2) * 128 + (i & 3) * 16];
        ++ui;
#pragma unroll
        for (int ai = 0; ai < 2; ++ai)
#pragma unroll
            for (int m = 0; m < 4; ++m) { const int r = row0 + ai * 128 + m * 16; const float rs = rsv[ai * 4 + m]; float h[8];
#pragma unroll
                for (int n = 0; n < 2; ++n)
#pragma unroll
                    for (int j = 0; j < 4; ++j) { const float g = acc[ai][0][m][n][j] * rs, up = acc[ai][1][m][n][j] * rs; h[4 * n + j] = g * up * sigmoidf_(g); }
                u32x4 w; w.x = pk2(h[0], h[1]); w.y = pk2(h[2], h[3]); w.z = pk2(h[4], h[5]); w.w = pk2(h[6], h[7]);
                *(u32x4*)(H + (size_t)r * FF + col0) = w; }
    }
};
struct FewOrder {
    int pm, pn; bool has;
    DI bool next(int i, Unit& u) const { if (i != 0 || !has) return false; u.pm = pm; u.pn = pn; return true; }
    DI void a_ready(const Unit&) const {}
    DI void done(const Unit&) const {}
};

struct TrItem { const float* W; const float* ks; bf16* WT; int K, N, drow0, kb, nb; bool valid; };
DI void tr_load(const TrItem& I, f32x4 (&v)[8], int lane) {
    if (!I.valid) return;
    const int k0 = 64 * I.kb, n0 = 32 * I.nb;
#pragma unroll
    for (int i = 0; i < 8; ++i) { const int kk = (lane >> 3) + 8 * i; v[i] = *(const f32x4*)(I.W + (size_t)(k0 + kk) * I.N + n0 + 4 * (lane & 7)); }
}
DI void tr_finish(const TrItem& I, const f32x4 (&v)[8], float* scr, int lane) {
    if (!I.valid) return;
    const int k0 = 64 * I.kb;
#pragma unroll
    for (int i = 0; i < 8; ++i) { const int kk = (lane >> 3) + 8 * i; const float sc = I.ks ? I.ks[k0 + kk] : 1.0f; float* d = scr + kk * 33 + 4 * (lane & 7);
        d[0] = v[i][0] * sc; d[1] = v[i][1] * sc; d[2] = v[i][2] * sc; d[3] = v[i][3] * sc; }
    LDS_FENCE();
    const int c = lane & 7;
#pragma unroll
    for (int j = 0; j < 4; ++j) { const int n = (lane >> 3) + 8 * j; const float* s = scr + (8 * c) * 33 + n;
        u32x4 o; o.x = pk2(s[0 * 33], s[1 * 33]); o.y = pk2(s[2 * 33], s[3 * 33]); o.z = pk2(s[4 * 33], s[5 * 33]); o.w = pk2(s[6 * 33], s[7 * 33]);
        *(u32x4*)(I.WT + (size_t)(I.drow0 + n) * I.K + k0 + 8 * c) = o; }
    LDS_FENCE();
}
DI TrItem tr_decode(Frame& F, int it, int nitems) {
    TrItem I; I.valid = it < nitems; I.W = nullptr; I.ks = nullptr; I.WT = nullptr; I.K = 0; I.N = 0; I.drow0 = 0; I.kb = 0; I.nb = 0;
    if (!I.valid) return I;
    unsigned char* ws = F.ws; int r = it;
#define TR(Wp, K_, N_, SC, DST, DROW) { constexpr int ni_ = ((K_) / 64) * ((N_) / 32); if (r >= 0 && r < ni_) { I.kb = r / ((N_) / 32); I.nb = r % ((N_) / 32); const int n0 = I.nb * 32; (void)n0; \
            I.W = (Wp); I.K = (K_); I.N = (N_); I.ks = (SC); I.WT = (bf16*)(ws + (DST)); I.drow0 = (DROW); } r -= ni_; }
    TR(F.in[3], D, NIN, F.in[2], WS_WIN, n0)
    TR(F.in[23], D, D, (const float*)nullptr, WS_WK, n0)
    TR(F.in[24], D, D, (const float*)nullptr, WS_WV, n0)
    TR(F.in[6], 64, RW, (const float*)nullptr, WS_WLT, n0)
    TR(F.in[8], 64, RW, (const float*)nullptr, WS_ALT, n0)
    TR(F.in[9], 128, RW, (const float*)nullptr, WS_GLT, n0)
    TR(F.in[27], D, FF, F.in[26], WS_WGU, (n0 / 128) * 256 + (n0 % 128))
    TR(F.in[28], D, FF, F.in[26], WS_WGU, (n0 / 128) * 256 + 128 + (n0 % 128))
    TR(F.in[19], D, D, (const float*)nullptr, WS_WOUT, n0)
    TR(F.in[25] + 0 * 256 * D, 256, D, (const float*)nullptr, WS_WOTH + 0 * (size_t)D * 256 * 2, n0)
    TR(F.in[25] + 1 * 256 * D, 256, D, (const float*)nullptr, WS_WOTH + 1 * (size_t)D * 256 * 2, n0)
    TR(F.in[25] + 2 * 256 * D, 256, D, (const float*)nullptr, WS_WOTH + 2 * (size_t)D * 256 * 2, n0)
    TR(F.in[25] + 3 * 256 * D, 256, D, (const float*)nullptr, WS_WOTH + 3 * (size_t)D * 256 * 2, n0)
    TR(F.in[29], FF, D, (const float*)nullptr, WS_WD, n0)
#undef TR
    return I;
}
constexpr int TR_I_IN = (D / 64) * (NIN / 32), TR_I_SQ = (D / 64) * (D / 32), TR_I_FF = (D / 64) * (FF / 32), TR_I_DN = (FF / 64) * (D / 32), TR_I_L64 = 1 * (RW / 32), TR_I_L128 = 2 * (RW / 32);
constexpr int TR_NITEMS = TR_I_IN + 4 * TR_I_SQ + 2 * TR_I_FF + TR_I_DN + 2 * TR_I_L64 + TR_I_L128, TR_LATE0 = TR_I_IN + 2 * TR_I_SQ + 2 * TR_I_L64 + TR_I_L128 + 0 * TR_I_FF, TR_DN0 = TR_NITEMS - TR_I_DN;
DI void tr_run(Frame& F, int gw, int NGW, int base, int count, int skip_at, int skip_len) {
    float* scr = (float*)(F.lds + F.wid * 16384); const int lane = F.lane;
#define TR_REAL(v_) ((v_) < count ? ((base + (v_)) >= skip_at ? base + (v_) + skip_len : base + (v_)) : TR_NITEMS)
    f32x4 va[8], vb[8];
    TrItem Ia = tr_decode(F, TR_REAL(gw), TR_NITEMS); tr_load(Ia, va, lane);
    for (int it = gw; it < count; it += 2 * NGW) {
        TrItem Ib = tr_decode(F, TR_REAL(it + NGW), TR_NITEMS); tr_load(Ib, vb, lane);
        tr_finish(Ia, va, scr, lane);
        Ia = tr_decode(F, TR_REAL(it + 2 * NGW), TR_NITEMS); tr_load(Ia, va, lane);
        tr_finish(Ib, vb, scr, lane);
    }
#undef TR_REAL
}
DI void p0_prologue(Frame& F) {
    const int gw = F.bid * NWAVES + F.wid, NGW = F.G * NWAVES, lane = F.lane;
    unsigned char* ws = F.ws;
    tr_run(F, gw, NGW, 0, TR_LATE0, 1 << 30, 0);
    const float* x = F.in[0]; bf16* xb = (bf16*)(ws + WS_XB); float* rs0 = (float*)(ws + WS_RS0);
    { f32x4 vn[4];
#pragma unroll
      for (int j = 0; j < 4; ++j) vn[j] = __builtin_nontemporal_load((const f32x4*)(x + (size_t)gw * D) + lane + 64 * j);
      for (int m = gw; m < T; m += NGW) {
        f32x4 v[4]; float s = 0.f;
#pragma unroll
        for (int j = 0; j < 4; ++j) { v[j] = vn[j]; s += (v[j][0] * v[j][0] + v[j][1] * v[j][1]) + (v[j][2] * v[j][2] + v[j][3] * v[j][3]); }
        if (m + NGW < T) {
#pragma unroll
            for (int j = 0; j < 4; ++j) vn[j] = __builtin_nontemporal_load((const f32x4*)(x + (size_t)(m + NGW) * D) + lane + 64 * j); }
        s = wave_sum(s);
        if (lane == 0) rs0[m] = rsqrtf(s * (1.0f / D) + RMS_EPS);
        u32x2* o8 = (u32x2*)(xb + (size_t)m * D) + lane;
#pragma unroll
        for (int j = 0; j < 4; ++j) { u32x2 w; w.x = pk2(v[j][0], v[j][1]); w.y = pk2(v[j][2], v[j][3]); o8[64 * j] = w; }
      } }
    { const float* wq = F.in[22]; const float* g2 = F.in[20]; bf16* wqu = (bf16*)(ws + WS_WQ);
      for (int k = gw; k < D; k += NGW) { const float gk = g2[k];
#pragma unroll
          for (int j = 0; j < 4; ++j) { const f32x4 v = ((const f32x4*)(wq + (size_t)k * D) + lane)[64 * j]; u32x2 w; w.x = pk2(v[0] * gk, v[1] * gk); w.y = pk2(v[2] * gk, v[3] * gk);
              *(u32x2*)(wqu + (size_t)j * D * 256 + (size_t)k * 256 + 4 * lane) = w; } } }
    const float* mem = F.in[1]; const float* mg = F.in[21]; bf16* mb = (bf16*)(ws + WS_MB);
    for (int m = gw; m < MEM; m += NGW) {
        const f32x4* xr = (const f32x4*)(mem + (size_t)m * D) + lane; f32x4 v[4]; float s = 0.f;
#pragma unroll
        for (int j = 0; j < 4; ++j) { v[j] = xr[64 * j]; s += (v[j][0] * v[j][0] + v[j][1] * v[j][1]) + (v[j][2] * v[j][2] + v[j][3] * v[j][3]); }
        s = wave_sum(s); const float rs = rsqrtf(s * (1.0f / D) + RMS_EPS);
        u32x2* o8 = (u32x2*)(mb + (size_t)m * D) + lane;
#pragma unroll
        for (int j = 0; j < 4; ++j) { const f32x4 g = ((const f32x4*)mg)[lane + 64 * j]; u32x2 w; w.x = pk2(v[j][0] * rs * g[0], v[j][1] * rs * g[1]); w.y = pk2(v[j][2] * rs * g[2], v[j][3] * rs * g[3]); o8[64 * j] = w; }
    }
    const float* wsp = F.in[17]; bf16* wsb = (bf16*)(ws + WS_WSB);
    for (int e = F.bid * NTHR + F.tid; e < 8 * 128 * 128; e += F.G * NTHR) { const int i = (e >> 7) & 127, j = e & 127; wsb[e] = (bf16)(pk2(j <= i ? wsp[e] : 0.f, 0.f) & 0xffffu); }
}

DI f32x4 load_shift4(const bf16* zrow, int col, int t, const float* mu) {
    const u32x2 a = *(const u32x2*)(zrow + col); u32x2 p = (u32x2){0u, 0u}; if (t > 0) p = *(const u32x2*)(zrow - RIN + col);
    const f32x4 m4 = *(const f32x4*)(mu + col); const f32x4 z = (f32x4){bflo(a.x), bfhi(a.x), bflo(a.y), bfhi(a.y)}, pz = (f32x4){bflo(p.x), bfhi(p.x), bflo(p.y), bfhi(p.y)};
    return z + (pz - z) * m4; }
template <int N> DI float dpp_shr(float v, float old) { return __builtin_bit_cast(float, __builtin_amdgcn_update_dpp(__builtin_bit_cast(int, old), __builtin_bit_cast(int, v), 0x110 + N, 0xF, 0xF, false)); }
DI float scan16_mul(float x) { x *= dpp_shr<1>(x, 1.0f); x *= dpp_shr<2>(x, 1.0f); x *= dpp_shr<4>(x, 1.0f); x *= dpp_shr<8>(x, 1.0f); return x; }
DI void prep_phase(Frame& F) {
    unsigned char* ws = F.ws; const int tid = F.tid, lane = F.lane, h = F.wid, fr = lane & 15, fq = lane >> 4;
    const bf16* zr = (const bf16*)(ws + WS_ZR); const float* mu = F.in[4];
    const bf16* WlT = (const bf16*)(ws + WS_WLT); const bf16* AlT = (const bf16*)(ws + WS_ALT); const bf16* GlT = (const bf16*)(ws + WS_GLT);
    const float *w0 = F.in[5], *a0 = F.in[7], *k_k = F.in[10], *k_a = F.in[11], *r_k = F.in[12];
    float* G16 = (float*)(ws + WS_G16); float* KK = F.out + (size_t)T * RW; float* Bb = (float*)(ws + WS_B);
    bf16* Rb = (bf16*)(ws + WS_R); bf16* Vb = (bf16*)(ws + WS_V); bf16* KPb = (bf16*)(ws + WS_KP); bf16* Gb = (bf16*)(ws + WS_G); float* bonus = (float*)(ws + WS_BON);
    unsigned char* AL = F.lds;
    const float gone = F.G > (1 << 20) ? 2.0f : 1.0f;
    for (int tile = F.bid; tile < T / 64; tile += F.G) {
        const int t0 = tile * 64;
        __syncthreads();
        { const int tk = tid >> 3, cs = (tid & 7) * 32, t = t0 + tk, kind = cs < 64 ? 0 : (cs < 128 ? 1 : 2);
          const bf16* zrow = zr + (size_t)t * RIN + 1536 + cs;
#pragma unroll
          for (int q = 0; q < 4; ++q) { const u32x4 a = *(const u32x4*)(zrow + 8 * q); u32x4 p = (u32x4){0u, 0u, 0u, 0u}; if (t > 0) p = *(const u32x4*)(zrow - RIN + 8 * q);
              float o[8];
#pragma unroll
              for (int e2 = 0; e2 < 4; ++e2) { const float z0 = bflo(a[e2]), z1 = bfhi(a[e2]), p0 = bflo(p[e2]), p1 = bfhi(p[e2]);
                  const float m0 = mu[1536 + cs + 8 * q + 2 * e2], m1 = mu[1536 + cs + 8 * q + 2 * e2 + 1];
                  float h0 = z0 + (p0 - z0) * m0, h1 = z1 + (p1 - z1) * m1;
                  if (kind == 0) { h0 = 1.0f - 2.0f * __builtin_amdgcn_rcpf(1.0f + __expf(2.0f * h0)); h1 = 1.0f - 2.0f * __builtin_amdgcn_rcpf(1.0f + __expf(2.0f * h1)); }
                  if (kind == 2) { h0 = sigmoidf_(h0); h1 = sigmoidf_(h1); }
                  o[2 * e2] = h0; o[2 * e2 + 1] = h1; }
              u32x4 w; w.x = pk2(o[0], o[1]); w.y = pk2(o[2], o[3]); w.z = pk2(o[4], o[5]); w.w = pk2(o[6], o[7]);
              *(u32x4*)(AL + tk * 528 + (cs + 8 * q) * 2) = w; } }
        __syncthreads();
        float inv[4], bon[4];
#pragma unroll
        for (int mt = 0; mt < 4; ++mt) { const int t = t0 + 16 * mt + fr; const bf16* zrow = zr + (size_t)t * RIN; float ssq = 0.f;
#pragma unroll
            for (int nt = 0; nt < 4; ++nt) { const int c = 64 * h + 16 * nt + 4 * fq; const f32x4 k4 = load_shift4(zrow, 512 + c, t, mu); const f32x4 kk4 = *(const f32x4*)(k_k + c);
#pragma unroll
                for (int e = 0; e < 4; ++e) { const float q = k4[e] * kk4[e]; ssq += q * q; } }
            ssq += __shfl_xor(ssq, 16); ssq += __shfl_xor(ssq, 32);
            inv[mt] = 1.0f / fmaxf(sqrtf(ssq), 1e-12f); bon[mt] = 0.f; }
#pragma unroll 1
        for (int nt = 0; nt < 4; ++nt) {
            const int n = 64 * h + 16 * nt + fr, c = 64 * h + 16 * nt + 4 * fq;
            bf16x8 bw[2], ba[2], bg[4];
#pragma unroll
            for (int ks = 0; ks < 2; ++ks) { bw[ks] = *(const bf16x8*)(WlT + n * 64 + 32 * ks + 8 * fq); ba[ks] = *(const bf16x8*)(AlT + n * 64 + 32 * ks + 8 * fq); }
#pragma unroll
            for (int ks = 0; ks < 4; ++ks) bg[ks] = *(const bf16x8*)(GlT + n * 128 + 32 * ks + 8 * fq);
            const f32x4 w04 = *(const f32x4*)(w0 + c), a04 = *(const f32x4*)(a0 + c), kk4 = *(const f32x4*)(k_k + c), ka4 = *(const f32x4*)(k_a + c), rk4 = *(const f32x4*)(r_k + c);
#pragma unroll
            for (int mt = 0; mt < 4; ++mt) {
                const int t = t0 + 16 * mt + fr; const bf16* zrow = zr + (size_t)t * RIN; const size_t o = (size_t)t * RW + c;
                const f32x4 r4 = load_shift4(zrow, c, t, mu), k4 = load_shift4(zrow, 512 + c, t, mu), v4 = load_shift4(zrow, 1024 + c, t, mu);
                f32x4 aw = (f32x4){0.f, 0.f, 0.f, 0.f}, aa = aw, ag = aw;
                const unsigned char* arow = AL + (16 * mt + fr) * 528 + 16 * fq;
#pragma unroll
                for (int ks = 0; ks < 2; ++ks) { aw = MFMA16(bw[ks], *(const bf16x8*)(arow + 64 * ks), aw); aa = MFMA16(ba[ks], *(const bf16x8*)(arow + 128 + 64 * ks), aa); }
#pragma unroll
                for (int ks = 0; ks < 4; ++ks) ag = MFMA16(bg[ks], *(const bf16x8*)(arow + 256 + 64 * ks), ag);
                f32x4 dw, dk, db; float kp[4];
#pragma unroll
                for (int e = 0; e < 4; ++e) { const float wl = w04[e] + aw[e];
                    dw[e] = __expf(-0.6065306597f * sigmoidf_(wl));
                    const float a = sigmoidf_(a04[e] + aa[e]);
                    const float kkv = k4[e] * kk4[e] * inv[mt]; dk[e] = kkv; db[e] = kkv * a;
                    kp[e] = k4[e] * (1.0f + (a - 1.0f) * ka4[e]); bon[mt] += r4[e] * kp[e] * rk4[e]; }
                f32x4 gi, ge, gr;
#pragma unroll
                for (int e = 0; e < 4; ++e) { gi[e] = scan16_mul(dw[e]); ge[e] = dpp_shr<1>(gi[e], 1.0f); gr[e] = __builtin_amdgcn_rcpf(gi[e]); }
                if (fr == 15) *(f32x4*)(G16 + (size_t)(t >> 4) * RW + c) = gi;
                *(f32x4*)(KK + o) = dk * ge; *(f32x4*)(Bb + o) = db * gr;
                u32x2 w; w.x = pk2(r4[0] * gi[0], r4[1] * gi[1]); w.y = pk2(r4[2] * gi[2], r4[3] * gi[3]); *(u32x2*)(Rb + o) = w;
                w.x = pk2(v4[0], v4[1]); w.y = pk2(v4[2], v4[3]); *(u32x2*)(Vb + o) = w;
                w.x = pk2(kp[0] * gr[0], kp[1] * gr[1]); w.y = pk2(kp[2] * gr[2], kp[3] * gr[3]); *(u32x2*)(KPb + o) = w;
                { const f32x4 gv = ag * gone;
                  w.x = pk2(gv[0], gv[1]); w.y = pk2(gv[2], gv[3]); *(u32x2*)(Gb + o) = w; }
                asm volatile("" ::: "memory");
            }
        }
#pragma unroll
        for (int mt = 0; mt < 4; ++mt) { float bsum = bon[mt]; bsum += __shfl_xor(bsum, 16); bsum += __shfl_xor(bsum, 32); if (fq == 0) bonus[(size_t)(t0 + 16 * mt + fr) * 8 + h] = bsum; }
    }
}

DI void sgu_items(Frame& F, int first, int stride) {
    unsigned char* ws = F.ws; const int lane = F.lane, fr = lane & 15, fq = lane >> 4;
    const bf16* su = (const bf16*)(ws + WS_SU); bf16* mix = (bf16*)(ws + WS_MIX); const bf16* wsb = (const bf16*)(ws + WS_WSB);
    const float* sg1 = (const float*)(ws + WS_CTL) + 3 * T; const float* sg2 = sg1 + T; const float *lnw = F.in[15], *lnb = F.in[16], *bsp = F.in[18];
    unsigned char* vnT = F.lds + F.wid * 17408;
    for (int item = first; item < 1024; item += stride) {
        const int nb = item >> 3, g = item & 7; constexpr int KJ = 128;
        LDS_FENCE();
        { const int chunk = lane & 7, jp = lane >> 3;
          const f32x4 lw0 = *(const f32x4*)(lnw + 64 * g + 8 * chunk), lw1 = *(const f32x4*)(lnw + 64 * g + 8 * chunk + 4), lb0 = *(const f32x4*)(lnb + 64 * g + 8 * chunk), lb1 = *(const f32x4*)(lnb + 64 * g + 8 * chunk + 4);
          const float lwv[8] = {lw0[0], lw0[1], lw0[2], lw0[3], lw1[0], lw1[1], lw1[2], lw1[3]}, lbv[8] = {lb0[0], lb0[1], lb0[2], lb0[3], lb1[0], lb1[1], lb1[2], lb1[3]};
          u32x4 a0[8], a1[8]; float m0[8], m1[8], q0[8], q1[8];
#pragma unroll
          for (int it = 0; it < 8; ++it) if (it < KJ / 16) { const int tok = 128 * nb + 2 * (jp + 8 * it);
              a0[it] = *(const u32x4*)(su + (size_t)tok * 1024 + 512 + 64 * g + 8 * chunk); a1[it] = *(const u32x4*)(su + (size_t)(tok + 1) * 1024 + 512 + 64 * g + 8 * chunk);
              m0[it] = sg1[tok]; m1[it] = sg1[tok + 1]; q0[it] = sg2[tok]; q1[it] = sg2[tok + 1]; }
#pragma unroll
          for (int it = 0; it < 8; ++it) if (it < KJ / 16) { const int j = 2 * (jp + 8 * it);
              const float mm0 = m0[it] * (1.0f / 512), mm1 = m1[it] * (1.0f / 512);
              const float r0 = rsqrtf(fmaxf(q0[it] * (1.0f / 512) - mm0 * mm0, 0.f) + 1e-5f), r1 = rsqrtf(fmaxf(q1[it] * (1.0f / 512) - mm1 * mm1, 0.f) + 1e-5f);
#pragma unroll
              for (int e2 = 0; e2 < 4; ++e2) {
                  const float x0a = (bflo(a0[it][e2]) - mm0) * r0 * lwv[2 * e2] + lbv[2 * e2], x0b = (bfhi(a0[it][e2]) - mm0) * r0 * lwv[2 * e2 + 1] + lbv[2 * e2 + 1];
                  const float x1a = (bflo(a1[it][e2]) - mm1) * r1 * lwv[2 * e2] + lbv[2 * e2], x1b = (bfhi(a1[it][e2]) - mm1) * r1 * lwv[2 * e2 + 1] + lbv[2 * e2 + 1];
                  *(unsigned*)(vnT + (8 * chunk + 2 * e2) * 272 + j * 2) = pk2(x0a, x1a);
                  *(unsigned*)(vnT + (8 * chunk + 2 * e2 + 1) * 272 + j * 2) = pk2(x0b, x1b); } } }
        LDS_FENCE();
#pragma unroll 1
        for (int hf = 0; hf < 2; ++hf) {
        f32x4 acc[4][4];
#pragma unroll
        for (int a = 0; a < 4; ++a)
#pragma unroll
            for (int b = 0; b < 4; ++b) acc[a][b] = (f32x4){0.f, 0.f, 0.f, 0.f};
#pragma unroll
        for (int ks = 0; ks < 4; ++ks) if (ks < 2 * (hf + 1)) {
            bf16x8 bfv[4];
#pragma unroll
            for (int ct = 0; ct < 4; ++ct) bfv[ct] = *(const bf16x8*)(vnT + (16 * ct + fr) * 272 + (32 * ks + 8 * fq) * 2);
#pragma unroll
            for (int it = 0; it < 4; ++it) { const int i = 64 * hf + 16 * it + fr; const bf16x8 af = *(const bf16x8*)(wsb + (size_t)(g * 128 + i) * 128 + 32 * ks + 8 * fq);
#pragma unroll
                for (int ct = 0; ct < 4; ++ct) acc[it][ct] = MFMA16(bfv[ct], af, acc[it][ct]); } }
        u32x2 uu[4][4]; float bias[4];
#pragma unroll
        for (int it = 0; it < 4; ++it) { const int i = 64 * hf + 16 * it + fr, tok = 128 * nb + i; bias[it] = bsp[g * 128 + i];
#pragma unroll
            for (int ct = 0; ct < 4; ++ct) uu[it][ct] = *(const u32x2*)(su + (size_t)tok * 1024 + 64 * g + 16 * ct + 4 * fq); }
#pragma unroll
        for (int it = 0; it < 4; ++it) { const int i = 64 * hf + 16 * it + fr, tok = 128 * nb + i;
#pragma unroll
            for (int ct = 0; ct < 4; ++ct) { const int c = 64 * g + 16 * ct + 4 * fq; const u32x2 u2 = uu[it][ct];
                u32x2 w; w.x = pk2(bflo(u2.x) * (acc[it][ct][0] + bias[it]), bfhi(u2.x) * (acc[it][ct][1] + bias[it])); w.y = pk2(bflo(u2.y) * (acc[it][ct][2] + bias[it]), bfhi(u2.y) * (acc[it][ct][3] + bias[it]));
                *(u32x2*)(mix + (size_t)tok * 1024 + 512 + c) = w; } }
        }
    }
}

DI float dpp_x1(float v) { return __builtin_bit_cast(float, __builtin_amdgcn_update_dpp(0, __builtin_bit_cast(int, v), 0xB1, 0xF, 0xF, true)); }
DI float dpp_x2(float v) { return __builtin_bit_cast(float, __builtin_amdgcn_update_dpp(0, __builtin_bit_cast(int, v), 0x4E, 0xF, 0xF, true)); }
DI float dpp_hm(float v) { return __builtin_bit_cast(float, __builtin_amdgcn_update_dpp(0, __builtin_bit_cast(int, v), 0x141, 0xF, 0xF, true)); }
DI float red8(float p) { p += dpp_x1(p); p += dpp_x2(p); p += dpp_hm(p); return p; }
#define RED8X4(a, b, c, d) asm volatile("s_nop 1\n\t" \
    "v_add_f32_dpp %0, %0, %0 quad_perm:[1,0,3,2] row_mask:0xf bank_mask:0xf\n\tv_add_f32_dpp %1, %1, %1 quad_perm:[1,0,3,2] row_mask:0xf bank_mask:0xf\n\t" \
    "v_add_f32_dpp %2, %2, %2 quad_perm:[1,0,3,2] row_mask:0xf bank_mask:0xf\n\tv_add_f32_dpp %3, %3, %3 quad_perm:[1,0,3,2] row_mask:0xf bank_mask:0xf\n\t" \
    "v_add_f32_dpp %0, %0, %0 quad_perm:[2,3,0,1] row_mask:0xf bank_mask:0xf\n\tv_add_f32_dpp %1, %1, %1 quad_perm:[2,3,0,1] row_mask:0xf bank_mask:0xf\n\t" \
    "v_add_f32_dpp %2, %2, %2 quad_perm:[2,3,0,1] row_mask:0xf bank_mask:0xf\n\tv_add_f32_dpp %3, %3, %3 quad_perm:[2,3,0,1] row_mask:0xf bank_mask:0xf\n\t" \
    "v_add_f32_dpp %0, %0, %0 row_half_mirror row_mask:0xf bank_mask:0xf\n\tv_add_f32_dpp %1, %1, %1 row_half_mirror row_mask:0xf bank_mask:0xf\n\t" \
    "v_add_f32_dpp %2, %2, %2 row_half_mirror row_mask:0xf bank_mask:0xf\n\tv_add_f32_dpp %3, %3, %3 row_half_mirror row_mask:0xf bank_mask:0xf\n\ts_nop 1" \
    : "+v"(a), "+v"(b), "+v"(c), "+v"(d))
constexpr int SC = 16, NSC = LCH / SC, SARR = SC * 64, SBUF = 6 * SARR, SGRP = 2 * SBUF;
template <bool ISP> DI void scan1_chunk(const float* gl, float* gst, int NSCc, const float* G16, const float* KK, const float* Bb, const bf16* KPb, const bf16* Vb, const bf16* Rb,
                                         float* OUTY, int tb, int h, int gt, int srow0, int kg, f32x2 (&s)[4][4]) {
    const int lstep = gt >> 4, lc4 = (gt & 15) * 4;
    f32x4 lkk, lb; u32x2 lkp, lv, lr;
#define SCAN_LOAD(sc_) do { const size_t o_ = (size_t)(tb + (sc_) * SC + lstep) * RW + h * 64 + lc4; lkk = *(const f32x4*)(KK + o_); lb = *(const f32x4*)(Bb + o_); \
        lkp = *(const u32x2*)(KPb + o_); lv = *(const u32x2*)(Vb + o_); lr = *(const u32x2*)(Rb + o_); } while (0)
#define SCAN_STORE(b_) do { float* d_ = gst + (b_) * SBUF + lstep * 64 + lc4; *(f32x4*)(d_ + SARR) = lkk; *(f32x4*)(d_ + 2 * SARR) = lb; \
        *(f32x4*)(d_ + 3 * SARR) = (f32x4){bflo(lkp.x), bfhi(lkp.x), bflo(lkp.y), bfhi(lkp.y)}; *(f32x4*)(d_ + 4 * SARR) = (f32x4){bflo(lv.x), bfhi(lv.x), bflo(lv.y), bfhi(lv.y)}; \
        *(f32x4*)(d_ + 5 * SARR) = (f32x4){bflo(lr.x), bfhi(lr.x), bflo(lr.y), bfhi(lr.y)}; } while (0)
    __syncthreads();
    SCAN_LOAD(0); SCAN_STORE(0);
    __syncthreads();
    for (int sc = 0; sc < NSCc; ++sc) {
        const float* bf = gl + (sc & 1) * SBUF;
        if (sc + 1 < NSCc) SCAN_LOAD(sc + 1);
        const float* gp_ = G16 + (size_t)((tb >> 4) + sc) * RW + h * 64 + 8 * kg; const f32x4 gq0 = *(const f32x4*)gp_, gq1 = *(const f32x4*)(gp_ + 4);
#pragma unroll 2
        for (int st = 0; st < SC; ++st) {
            const float* p = bf + st * 64 + 8 * kg;
            const f32x4 k0 = *(const f32x4*)(p + SARR), k1 = *(const f32x4*)(p + SARR + 4), b0 = *(const f32x4*)(p + 2 * SARR), b1 = *(const f32x4*)(p + 2 * SARR + 4),
                        r0 = *(const f32x4*)(p + 5 * SARR), r1 = *(const f32x4*)(p + 5 * SARR + 4);
            const f32x2 k2[4] = {k0.xy, k0.zw, k1.xy, k1.zw}, b2[4] = {b0.xy, b0.zw, b1.xy, b1.zw}, r2[4] = {r0.xy, r0.zw, r1.xy, r1.zw};
            f32x2 q2[4]; f32x4 v4 = (f32x4){0.f, 0.f, 0.f, 0.f};
            if (!ISP) { const f32x4 q0 = *(const f32x4*)(p + 3 * SARR), q1 = *(const f32x4*)(p + 3 * SARR + 4); v4 = *(const f32x4*)(bf + 4 * SARR + st * 64 + srow0);
                q2[0] = q0.xy; q2[1] = q0.zw; q2[2] = q1.xy; q2[3] = q1.zw; }
            float pd[4], yd[4];
#pragma unroll
            for (int i = 0; i < 4; ++i) { f32x2 a = s[i][0] * k2[0]; a = s[i][1] * k2[1] + a; a = s[i][2] * k2[2] + a; a = s[i][3] * k2[3] + a; pd[i] = a.x + a.y; }
            RED8X4(pd[0], pd[1], pd[2], pd[3]);
#pragma unroll
            for (int i = 0; i < 4; ++i) { const f32x2 n2 = (f32x2){-pd[i], -pd[i]};
                if (ISP) {
#pragma unroll
                    for (int j = 0; j < 4; ++j) s[i][j] = s[i][j] + n2 * b2[j];
                } else { const f32x2 vv2 = (f32x2){v4[i], v4[i]};
#pragma unroll
                    for (int j = 0; j < 4; ++j) s[i][j] = vv2 * q2[j] + (n2 * b2[j] + s[i][j]);
                }
                f32x2 y = s[i][0] * r2[0]; y = s[i][1] * r2[1] + y; y = s[i][2] * r2[2] + y; y = s[i][3] * r2[3] + y; yd[i] = y.x + y.y; }
            RED8X4(yd[0], yd[1], yd[2], yd[3]);
            const f32x4 yv = (f32x4){yd[0], yd[1], yd[2], yd[3]};
            if (kg == 0) *(f32x4*)(OUTY + (size_t)(tb + sc * SC + st) * RW + h * 64 + srow0) = yv;
        }
        { const f32x2 g2[4] = {gq0.xy, gq0.zw, gq1.xy, gq1.zw};
#pragma unroll
          for (int i = 0; i < 4; ++i)
#pragma unroll
              for (int j = 0; j < 4; ++j) s[i][j] = s[i][j] * g2[j]; }
        if (sc + 1 < NSCc) SCAN_STORE((sc + 1) & 1);
        asm volatile("s_waitcnt lgkmcnt(0)" ::: "memory"); __builtin_amdgcn_s_barrier(); asm volatile("" ::: "memory");
    }
#undef SCAN_LOAD
#undef SCAN_STORE
}
DI void scan_pass1(Frame& F) {
    unsigned char* ws = F.ws; const int lane = F.lane, grp = F.wid >> 2, w4 = F.wid & 3, gt = F.tid & 255, rs = lane >> 3, kg = lane & 7;
    float* Wd = F.out; float* KK = F.out + (size_t)T * RW; const float* Bb = (const float*)(ws + WS_B); const float* G16 = (const float*)(ws + WS_G16);
    const bf16* Rb = (const bf16*)(ws + WS_R); const bf16* Vb = (const bf16*)(ws + WS_V); const bf16* KPb = (const bf16*)(ws + WS_KP);
    float* PT = (float*)(ws + WS_PT); float* SL = (float*)(ws + WS_SLOC);
    float* gl = (float*)F.lds + grp * SGRP;
    for (int pair0 = F.bid * 2; pair0 < NC * 8; pair0 += F.G * 2) {
        const int pair = pair0 + grp, c = pair >> 3, h = pair & 7, tb = c * LCH;
        const int vrow0 = 32 * ((w4 + 2 * grp) & 3) + 4 * rs;
        const bool isP = vrow0 < 64; const int srow0 = vrow0 & 63;
        f32x2 s[4][4];
#pragma unroll
        for (int i = 0; i < 4; ++i)
#pragma unroll
            for (int j = 0; j < 4; ++j) s[i][j] = (f32x2){(isP && (srow0 + i == 8 * kg + 2 * j)) ? 1.f : 0.f, (isP && (srow0 + i == 8 * kg + 2 * j + 1)) ? 1.f : 0.f};
        if (isP) {
            scan1_chunk<true>(gl, gl, NSC, G16, KK, Bb, KPb, Vb, Rb, Wd, tb, h, gt, srow0, kg, s);
#pragma unroll
            for (int j = 0; j < 8; ++j) *(f32x4*)(PT + ((size_t)(c * 8 + h) * 64 + 8 * kg + j) * 64 + srow0) = (f32x4){s[0][j >> 1][j & 1], s[1][j >> 1][j & 1], s[2][j >> 1][j & 1], s[3][j >> 1][j & 1]};
        } else {
            scan1_chunk<false>(gl, gl, NSC, G16, KK, Bb, KPb, Vb, Rb, KK, tb, h, gt, srow0, kg, s);
#pragma unroll
            for (int i = 0; i < 4; ++i) { float* sp = SL + ((size_t)(c * 8 + h) * 64 + srow0 + i) * 64 + 8 * kg;
                *(f32x4*)sp = (f32x4){s[i][0].x, s[i][0].y, s[i][1].x, s[i][1].y}; *(f32x4*)(sp + 4) = (f32x4){s[i][2].x, s[i][2].y, s[i][3].x, s[i][3].y}; }
        }
    }
}
DI void split8(const f32x4& x0, const f32x4& x1, bf16x8& hi, bf16x8& lo) {
    unsigned hb[8], lb[8];
#pragma unroll
    for (int e = 0; e < 8; ++e) { const float x = e < 4 ? x0[e & 3] : x1[e & 3]; hb[e] = __float_as_uint(x) & 0xffff0000u; lb[e] = __float_as_uint(x - __uint_as_float(hb[e])); }
    u32x4 h, l;
#pragma unroll
    for (int p = 0; p < 4; ++p) { h[p] = (hb[2 * p] >> 16) | hb[2 * p + 1]; l[p] = (lb[2 * p] >> 16) | (lb[2 * p + 1] & 0xffff0000u); }
    hi = __builtin_bit_cast(bf16x8, h); lo = __builtin_bit_cast(bf16x8, l);
}
DI void scan_pass3(Frame& F) {
    unsigned char* ws = F.ws; const int lane = F.lane, grp = F.wid >> 2, w4 = F.wid & 3, fr = lane & 15, fq = lane >> 4;
    const float* QT = F.out; const float* YL = F.out + (size_t)T * RW; const float* SST = (const float*)(ws + WS_SST);
    const bf16* Vb = (const bf16*)(ws + WS_V); const bf16* Gb = (const bf16*)(ws + WS_G); const float* bonus = (const float*)(ws + WS_BON); bf16* mix = (bf16*)(ws + WS_MIX);
    const float *lnxw = F.in[13], *lnxb = F.in[14];
    for (int pair0 = F.bid * 2; pair0 < NC * 8; pair0 += F.G * 2) {
        const int pair = pair0 + grp, c = pair >> 3, h = pair & 7, tb = c * LCH;
        f32x4 sst[4][4];
#pragma unroll
        for (int vt = 0; vt < 4; ++vt)
#pragma unroll
            for (int g4 = 0; g4 < 4; ++g4) sst[vt][g4] = *(const f32x4*)(SST + ((size_t)(c * 8 + h) * 64 + 16 * vt + fr) * 64 + 16 * g4 + 4 * fq);
        bf16x8 ah[4][2], al[4][2];
#pragma unroll
        for (int vt = 0; vt < 4; ++vt)
#pragma unroll
            for (int s2 = 0; s2 < 2; ++s2) split8(sst[vt][2 * s2], sst[vt][2 * s2 + 1], ah[vt][s2], al[vt][s2]);
#pragma unroll 1
        for (int tt = 0; tt < LCH / 64; ++tt) {
            const int t = tb + 16 * (w4 * (LCH / 64) + tt) + fr; const size_t o = (size_t)t * RW + h * 64;
            f32x4 q[4], acc[4]; u32x2 v2a[4], g2a[4];
#pragma unroll
            for (int g4 = 0; g4 < 4; ++g4) { q[g4] = *(const f32x4*)(QT + o + 16 * g4 + 4 * fq); acc[g4] = *(const f32x4*)(YL + o + 16 * g4 + 4 * fq); }
#pragma unroll
            for (int g4 = 0; g4 < 4; ++g4) { v2a[g4] = *(const u32x2*)(Vb + o + 16 * g4 + 4 * fq); g2a[g4] = *(const u32x2*)(Gb + o + 16 * g4 + 4 * fq); }
            const float bo = bonus[(size_t)t * 8 + h];
            bf16x8 bh[2], bl[2];
#pragma unroll
            for (int s2 = 0; s2 < 2; ++s2) split8(q[2 * s2], q[2 * s2 + 1], bh[s2], bl[s2]);
#pragma unroll
            for (int vt = 0; vt < 4; ++vt)
#pragma unroll
                for (int s2 = 0; s2 < 2; ++s2) { acc[vt] = MFMA16(ah[vt][s2], bh[s2], acc[vt]); acc[vt] = MFMA16(ah[vt][s2], bl[s2], acc[vt]); acc[vt] = MFMA16(al[vt][s2], bh[s2], acc[vt]); }
            float sm = 0.f;
#pragma unroll
            for (int vt = 0; vt < 4; ++vt) sm += (acc[vt][0] + acc[vt][1]) + (acc[vt][2] + acc[vt][3]);
            sm += __shfl_xor(sm, 16); sm += __shfl_xor(sm, 32);
            const float mean = sm * (1.0f / 64); float qq = 0.f;
#pragma unroll
            for (int vt = 0; vt < 4; ++vt) { acc[vt] = acc[vt] - mean; qq += (acc[vt][0] * acc[vt][0] + acc[vt][1] * acc[vt][1]) + (acc[vt][2] * acc[vt][2] + acc[vt][3] * acc[vt][3]); }
            qq += __shfl_xor(qq, 16); qq += __shfl_xor(qq, 32);
            const float rstd = rsqrtf(qq * (1.0f / 64) + 64e-5f);
#pragma unroll
            for (int vt = 0; vt < 4; ++vt) { const int c4 = 16 * vt + 4 * fq; const f32x4 lw4 = *(const f32x4*)(lnxw + h * 64 + c4), lb4 = *(const f32x4*)(lnxb + h * 64 + c4);
                const u32x2 v2 = v2a[vt], g2 = g2a[vt];
                const float vv[4] = {bflo(v2.x), bfhi(v2.x), bflo(v2.y), bfhi(v2.y)}, gg[4] = {bflo(g2.x), bfhi(g2.x), bflo(g2.y), bfhi(g2.y)}; float o4[4];
#pragma unroll
                for (int e = 0; e < 4; ++e) o4[e] = (acc[vt][e] * rstd * lw4[e] + lb4[e] + bo * vv[e]) * gg[e];
                u32x2 w; w.x = pk2(o4[0], o4[1]); w.y = pk2(o4[2], o4[3]); *(u32x2*)(mix + (size_t)t * 1024 + h * 64 + c4) = w; }
        }
    }
}
DI void scan_pass2(Frame& F, int task, int jt, float* xch, bool active) {
    unsigned char* ws = F.ws; const int lane = F.lane, fr = lane & 15, fq = lane >> 4, h = task >> 2, ib = task & 3;
    const float* PT = (const float*)(ws + WS_PT); const float* SL = (const float*)(ws + WS_SLOC); float* SST = (float*)(ws + WS_SST);
    f32x4 S[4];
#pragma unroll
    for (int j = 0; j < 4; ++j) S[j] = (f32x4){0.f, 0.f, 0.f, 0.f};
    f32x4 pv0[4], pv1[4], pv2[4], nl0, nl1, nl2, own = (f32x4){0.f, 0.f, 0.f, 0.f};
#define P2_LOAD(c_, PV, NL) do { const int cc_ = (c_) < NC - 1 ? (c_) : NC - 2; const size_t m_ = (size_t)(cc_ * 8 + h) * 4096; NL = *(const f32x4*)(SL + m_ + (16 * ib + fr) * 64 + 16 * jt + 4 * fq); \
        _Pragma("unroll") for (int t4 = 0; t4 < 4; ++t4) PV[t4] = *(const f32x4*)(PT + m_ + (16 * jt + fr) * 64 + 16 * t4 + 4 * fq); } while (0)
#define P2_STEP(c_, PV, NL) do { *(f32x4*)(SST + (size_t)((c_) * 8 + h) * 4096 + (16 * ib + fr) * 64 + 16 * jt + 4 * fq) = own; \
        _Pragma("unroll") for (int t4 = 0; t4 < 4; ++t4) _Pragma("unroll") for (int rg = 0; rg < 4; ++rg) NL = __builtin_amdgcn_mfma_f32_16x16x4f32(PV[t4][rg], S[t4][rg], NL, 0, 0, 0); \
        float* xb_ = xch + ((c_) & 1) * 1024; own = NL; *(f32x4*)(xb_ + jt * 256 + lane * 4) = NL; \
        P2_LOAD((c_) + 3, PV, NL); \
        asm volatile("s_waitcnt lgkmcnt(0)" ::: "memory"); __builtin_amdgcn_s_barrier(); asm volatile("" ::: "memory"); \
        _Pragma("unroll") for (int j = 0; j < 4; ++j) S[j] = *(const f32x4*)(xb_ + j * 256 + lane * 4); } while (0)
    static_assert((NC - 1) % 3 == 0, "pass 2 is unrolled by 3");
    if (!active) { for (int c = 0; c < NC - 1; ++c) { asm volatile("s_waitcnt lgkmcnt(0)" ::: "memory"); __builtin_amdgcn_s_barrier(); asm volatile("" ::: "memory"); } return; }
    P2_LOAD(0, pv0, nl0); P2_LOAD(1, pv1, nl1); P2_LOAD(2, pv2, nl2);
    for (int c = 0; c < NC - 1; c += 3) { P2_STEP(c, pv0, nl0); P2_STEP(c + 1, pv1, nl1); P2_STEP(c + 2, pv2, nl2); }
    *(f32x4*)(SST + (size_t)((NC - 1) * 8 + h) * 4096 + (16 * ib + fr) * 64 + 16 * jt + 4 * fq) = own;
#undef P2_STEP
#undef P2_LOAD
}


#ifndef MK_PER_PHASE
#define MK_PER_PHASE 0
#endif
constexpr int NPHASES = 12;
typedef KArgs Args;
static_assert(sizeof(Args) == 33 * 8 + 8, "no padding");

__global__ void __launch_bounds__(NTHR, 2) hybrid_fwd(Args args) {
    extern __shared__ __attribute__((aligned(16))) unsigned char lds[];
    cg::grid_group grid = cg::this_grid();
    Frame F;
    F.lds = lds; F.tid = threadIdx.x; F.lane = F.tid & 63; F.wid = __builtin_amdgcn_readfirstlane(F.tid >> 6); F.bid = blockIdx.x; F.G = gridDim.x;
    F.in.ka = (const __attribute__((address_space(4))) KArgs*)__builtin_amdgcn_kernarg_segment_ptr();
    F.out = args.out; F.ws = args.ws;
    unsigned char* ws = args.ws;
    PG8_LAS unsigned char* glds = (PG8_LAS unsigned char*)lds;
    float* ctl = (float*)(ws + WS_CTL); float *ss1 = ctl, *ss2 = ctl + T, *ss3 = ctl + 2 * T, *sg1 = ctl + 3 * T, *sg2 = ctl + 4 * T;
    const int lo = args.ph_lo, hi = args.ph_hi;
    const float rone = F.G > (1 << 20) ? 2.0f : 1.0f;
    volatile LAS unsigned* MISC = (volatile LAS unsigned*)(glds + LDS_BYTES - 64);
    if (F.tid < 16) MISC[F.tid] = 0u;
    __syncthreads();
    XcdBarrier bar = xcd_barrier_post((unsigned*)(ws + WS_CTL + 768 * KiB), MISC);
#ifndef PHMASK
#define PHMASK 0xfff
#endif
#define IN(k) (((PHMASK >> (k)) & 1) && lo <= (k) && (k) < hi)
#define SEAM(k) do { if ((k) + 1 < hi) { if (hi > NPHASES) grid.sync(); else xcd_barrier(bar); } } while (0)
#ifndef DBLMASK
#define DBLMASK 0
#endif
#define REPS(k) for (int rep = 0; rep < (((DBLMASK >> (k)) & 1) ? 2 : 1); ++rep)
    float* dummy = ctl + 8 * T;

    if (IN(0)) { REPS(0) p0_prologue(F); SEAM(0); }
    if (IN(1)) {
        REPS(1) { pg8::Gemm g{(const bf16*)(ws + WS_XB), (const bf16*)(ws + WS_WIN), T, NIN, D}; pg8::StaticOrder S; S.init(T, NIN, F.G, F.bid);
          fill_rs_table(F, T / 256, NIN / 256, (const float*)(ws + WS_RS0), false);
          EpiZ E{(bf16*)(ws + WS_ZR), (bf16*)(ws + WS_SU), (const float*)(F.lds + RS_TAB_OFF), rep ? dummy : sg1, rep ? dummy + T : sg2};
          pg8::gemm_phase<EpiZ, pg8::StaticOrder>(glds, g, S, E, nullptr); }
        { const int lb = F.bid - 192;
          if (lb >= 0 && lb < 56) tr_run(F, lb * NWAVES + F.wid, 56 * NWAVES, TR_LATE0, TR_DN0 - TR_LATE0, 1 << 30, 0); }
        { const int b = F.bid - (F.G - 8); const bool isk = b >= 0 && b < 4, isv = b >= 4 && b < 8;
          if (isk) { pg8::Gemm g{(const bf16*)(ws + WS_MB), (const bf16*)(ws + WS_WK), MEM, D, D}; FewOrder S{0, b, true}; EpiBf E{(bf16*)(ws + WS_KB), 256, nullptr, rone, 256 * 256};
              pg8::gemm_phase<EpiBf, FewOrder>(glds, g, S, E, nullptr); }
          if (isv) { pg8::Gemm g{(const bf16*)(ws + WS_MB), (const bf16*)(ws + WS_WV), MEM, D, D}; FewOrder S{0, b - 4, true}; EpiBf E{(bf16*)(ws + WS_VT), 256, nullptr, rone, 256 * 256};
              pg8::gemm_phase<EpiBf, FewOrder>(glds, g, S, E, nullptr); } }
        SEAM(1); }
    if (IN(2)) { REPS(2) prep_phase(F); SEAM(2); }
    if (IN(3)) { REPS(3) scan_pass1(F); SEAM(3); }
    if (IN(4)) {
        REPS(4) { if (F.bid < 32) scan_pass2(F, F.bid, F.wid & 3, (float*)F.lds, F.wid < 4);
        else if (F.bid < 48) {
            const int fu = F.bid - 32, fh = fu >> 2, fpm = fu & 3;
            pg8::Gemm g{(const bf16*)(ws + WS_WOTH) + (size_t)fh * D * 256, (const bf16*)(ws + WS_VT) + (size_t)fh * 256 * 256, D, 256, 256}; FewOrder S{fpm, 0, true};
            EpiBf E{(bf16*)(ws + WS_WO) + fh * 256, D, nullptr, rone};
            pg8::gemm_phase<EpiBf, FewOrder>(glds, g, S, E, nullptr); }
        else if (F.bid < 64) {
            const int fu = F.bid - 48, fh = fu >> 2, fpn = fu & 3;
            pg8::Gemm g{(const bf16*)(ws + WS_KB) + (size_t)fh * 256 * 256, (const bf16*)(ws + WS_WQ) + (size_t)fh * D * 256, 256, D, 256}; FewOrder S{0, fpn, true};
            EpiBf E{(bf16*)(ws + WS_WK) + (size_t)fh * 256 * D, D, nullptr, rone};
            pg8::gemm_phase<EpiBf, FewOrder>(glds, g, S, E, nullptr); }
        else sgu_items(F, (F.bid - 64) * NWAVES + F.wid, (F.G - 64) * NWAVES); }
        SEAM(4); }
    if (IN(5)) { REPS(5) scan_pass3(F); SEAM(5); }
    if (IN(6)) {
        REPS(6) { pg8::Gemm g{(const bf16*)(ws + WS_MIX), (const bf16*)(ws + WS_WOUT), T, D, D}; pg8::StaticOrder S; S.init(T, D, F.G, F.bid);
        EpiRes E{F.in[0], nullptr, (bf16*)(ws + WS_XB), rep ? dummy : ss1};
        pg8::gemm_phase<EpiRes, pg8::StaticOrder>(glds, g, S, E, nullptr); } SEAM(6); }
    if (IN(7)) {
        pg8::Gemm g{(const bf16*)(ws + WS_XB), (const bf16*)(ws + WS_WK), T, D, D}; pg8::StaticOrder S; S.init(T, D, F.G, F.bid);
        EpiSoftmax E{(bf16*)(ws + WS_OB), ss1};
        pg8::gemm_phase<EpiSoftmax, pg8::StaticOrder>(glds, g, S, E, nullptr); SEAM(7); }
    if (IN(9)) {
        pg8::Gemm g{(const bf16*)(ws + WS_OB), (const bf16*)(ws + WS_WO), T, D, D}; pg8::StaticOrder S; S.init(T, D, F.G, F.bid);
        EpiRes E{nullptr, (const bf16*)(ws + WS_XB), (bf16*)(ws + WS_XB), ss2};
        pg8::gemm_phase<EpiRes, pg8::StaticOrder>(glds, g, S, E, nullptr); SEAM(9); }
    if (IN(10)) {
        pg8::Gemm g{(const bf16*)(ws + WS_XB), (const bf16*)(ws + WS_WGU), T, 2 * FF, D}; pg8::StaticOrder S; S.init(T, 2 * FF, F.G, F.bid);
        fill_rs_table(F, T / 256, 2 * FF / 256, ss2, true);
        EpiSwi E{(bf16*)(ws + WS_HFF), (const float*)(F.lds + RS_TAB_OFF)};
        REPS(10) pg8::gemm_phase<EpiSwi, pg8::StaticOrder>(glds, g, S, E, nullptr);
        if (F.bid >= 128) tr_run(F, (F.bid - 128) * NWAVES + F.wid, (F.G - 128) * NWAVES, TR_DN0, TR_I_DN, 1 << 30, 0);
        SEAM(10); }
    if (IN(11)) {
        pg8::Gemm g{(const bf16*)(ws + WS_HFF), (const bf16*)(ws + WS_WD), T, D, FF}; pg8::StaticOrder S; S.init(T, D, F.G, F.bid);
        EpiFinal E{(const bf16*)(ws + WS_XB), F.out, ss3, (unsigned*)(ctl + 10 * T), F.in[30]};
        pg8::gemm_phase<EpiFinal, pg8::StaticOrder>(glds, g, S, E, nullptr); }
#ifdef SYNCX
    for (int i = 0; i < SYNCX; ++i) xcd_barrier(bar);
#endif
#undef IN
#undef SEAM
}

extern "C" void kernel_launch(void* const* d_in, const int* in_sizes, int n_in, void* d_out, int out_size, void* d_ws, size_t ws_size, hipStream_t stream) {
    static int grid = 0;
    if (grid == 0) {
        if (n_in != 31 || in_sizes[0] != T * D || out_size != T * D || ws_size < WS_END) { fprintf(stderr, "kernel_launch: unexpected shapes (n_in %d, in0 %d, out %d, ws %zu)\n", n_in, n_in > 0 ? in_sizes[0] : -1, out_size, ws_size); grid = -1; return; }
        int dev = 0, cus = 0, per_cu = 0;
        if (hipGetDevice(&dev) != hipSuccess || hipDeviceGetAttribute(&cus, hipDeviceAttributeMultiprocessorCount, dev) != hipSuccess) { grid = -1; return; }
        if (hipFuncSetAttribute((const void*)hybrid_fwd, hipFuncAttributeMaxDynamicSharedMemorySize, LDS_BYTES) != hipSuccess) { fprintf(stderr, "kernel_launch: hipFuncSetAttribute failed\n"); grid = -1; return; }
        if (hipOccupancyMaxActiveBlocksPerMultiprocessor(&per_cu, (const void*)hybrid_fwd, NTHR, LDS_BYTES) != hipSuccess || per_cu < 1) { fprintf(stderr, "kernel_launch: occupancy query says %d blocks per CU\n", per_cu); per_cu = 1; }
        (void)hipGetLastError();
        grid = cus * per_cu;
    }
    if (grid < 0) return;
    if (hipMemsetAsync((char*)d_ws + WS_CTL, 0, CTL_BYTES, stream) != hipSuccess) { fprintf(stderr, "kernel_launch: memset failed\n"); return; }
    Args a{};
    for (int i = 0; i < 31; ++i) a.in[i] = (const float*)d_in[i];
    a.out = (float*)d_out; a.ws = (unsigned char*)d_ws;
#if MK_PER_PHASE
    for (int p = 0; p < NPHASES; ++p) { a.ph_lo = p; a.ph_hi = p + 1; hipLaunchKernelGGL(hybrid_fwd, dim3(grid), dim3(NTHR), LDS_BYTES, stream, a); }
#else
    a.ph_lo = 0; a.ph_hi = NPHASES;
    void* kargs[] = {&a};
    hipError_t e = hipLaunchCooperativeKernel((const void*)hybrid_fwd, dim3(grid), dim3(NTHR), kargs, LDS_BYTES, stream);
    if (e != hipSuccess) fprintf(stderr, "kernel_launch: cooperative launch failed: %s (grid %d)\n", hipGetErrorString(e), grid);
#endif
}
```

```cpp
#include <hip/hip_runtime.h>
#include <hip/hip_cooperative_groups.h>
#include <cstdio>
namespace cg = cooperative_groups;

namespace pg8 {
#define PG8_LAS __attribute__((address_space(3)))
typedef unsigned short bf16_t;
typedef short bf16x8 __attribute__((ext_vector_type(8)));
typedef float f32x4 __attribute__((ext_vector_type(4)));
typedef unsigned u32x4 __attribute__((ext_vector_type(4)));
constexpr int BM = 256, BK = 64, HALF = 128, HTB = HALF * BK * 2  , STAGE_BYTES = 8 * HTB, NXCD = 8, WGM = 8;

__host__ __device__ __forceinline__ int lds_byte(int r, int c) { const int st = (r >> 4) * 2 + (c >> 5), rr = r & 15, cc = c & 31, ob = rr * 64 + cc * 2; return st * 1024 + (ob ^ (((ob >> 9) & 1) << 5)); }
__host__ __device__ __forceinline__ void stage_rc(int b, int& R, int& C) { const int st = b / 1024, sb = b % 1024, swz = sb ^ (((sb >> 9) & 1) << 5); R = (st >> 1) * 16 + swz / 64; C = (st & 1) * 32 + (swz % 64) / 2; }
__host__ __device__ __forceinline__ int perm32(int rho) { const int n = rho >> 4, i = rho & 15; return 8 * (i >> 2) + 4 * n + (i & 3); }

struct Unit { int pm, pn; };
struct Gemm { const bf16_t* A; const bf16_t* Bt; int M, N, K; };

struct StaticOrder {
    int nM, nN, nwg, G, c;
    __host__ __device__ void init(int M, int N, int G_, int c_) { nM = M / BM; nN = N / BM; nwg = nM * nN; G = G_; c = c_; }
    __host__ __device__ bool next(int i, Unit& u) const {
        const long L = (long)i * G + c; if (L >= nwg) return false;
        int wgid = (int)L; { const int q = nwg / NXCD, r = nwg % NXCD, xcd = wgid % NXCD, off = wgid / NXCD; wgid = (xcd < r ? xcd * (q + 1) : r * (q + 1) + (xcd - r) * q) + off; }
        const int nig = WGM * nN, gid = wgid / nig, fm = gid * WGM, gsz = (nM - fm) < WGM ? (nM - fm) : WGM;
        u.pm = fm + ((wgid % nig) % gsz); u.pn = (wgid % nig) / gsz; return true;
    }
    __device__ __forceinline__ void a_ready(const Unit&) const {}
    __device__ __forceinline__ void done(const Unit&) const {}
};
__device__ __forceinline__ unsigned cvt_pk_bf16(float lo, float hi) { unsigned r; asm volatile("v_cvt_pk_bf16_f32 %0, %1, %2" : "=v"(r) : "v"(lo), "v"(hi)); return r; }
typedef float f32x2 __attribute__((ext_vector_type(2)));
__device__ __forceinline__ f32x2 gelu_pk(f32x2 v) {
    const f32x2 av = __builtin_elementwise_abs(v), d = av * 0.2316418882f + 1.0f;
    f32x2 t; t.x = __builtin_amdgcn_rcpf(d.x); t.y = __builtin_amdgcn_rcpf(d.y);
    f32x2 q = t * 0.5307027145f + (-0.7265760135f); q = q * t + 0.7107068705f; q = q * t + (-0.142248368f); q = q * t + 0.127414796f; q = q * t;
    const f32x2 s = (v * v) * (-0.72134752044f);
    f32x2 e; e.x = __builtin_amdgcn_exp2f(s.x); e.y = __builtin_amdgcn_exp2f(s.y);
    const f32x2 m = v * (q * e), r = v - m;
    f32x2 o; o.x = v.x < 0.f ? m.x : r.x; o.y = v.y < 0.f ? m.y : r.y; return o;
}

template <class Epi, class Sched, bool STAMP = false>
__device__ __forceinline__ void gemm_phase(PG8_LAS unsigned char* lds, const Gemm g, const Sched& S, const Epi& E, unsigned long long* stamps) {
    const int tid = threadIdx.x, wid = __builtin_amdgcn_readfirstlane(tid >> 6), lane = tid & 63, wr = wid >> 2, wc = wid & 3, fr = lane & 15, fq = lane >> 4;
    const int K = g.K, nt = K / BK;
    int ts_lo = 0, ts_hi = 0, nts = 0; const unsigned long long rt_entry = STAMP ? (unsigned long long)wall_clock64() : 0ull;
#define PG8_STAMP() do { if (STAMP && wid == 0 && nts < 64) { const unsigned long long _c = (unsigned long long)clock64(); \
        ts_lo = (lane == nts) ? (int)(unsigned)_c : ts_lo; ts_hi = (lane == nts) ? (int)(unsigned)(_c >> 32) : ts_hi; ++nts; } } while (0)
    PG8_STAMP();
    unsigned voffA[2], voffB[2];
#pragma unroll
    for (int i = 0; i < 2; ++i) { int R, C; stage_rc(tid * 16 + i * 8192, R, C); const int Rb = Epi::PERM ? ((R & ~31) + perm32(R & 31)) : R;
        voffA[i] = (unsigned)(R * K + C) * 2u; voffB[i] = (unsigned)(Rb * K + C) * 2u; }
    const size_t kstep = (size_t)(BK * 2);
    const size_t hstep = (size_t)HALF * K * 2;
    const size_t tstep = 2 * hstep;
    const unsigned ldsw = (unsigned)wid * 1024u;
    const int aoff = lds_byte(wr * 64 + fr, fq * 8), boff = lds_byte(wc * 32 + fr, fq * 8);
#define PG8_SA(b, h) (((b) * 2 + (h)) * HTB)
#define PG8_SB(b, h) ((4 + (b) * 2 + (h)) * HTB)
#define PG8_STAGE(bufoff, gbase, voff) do { _Pragma("unroll") for (int _i = 0; _i < 2; ++_i) \
        __builtin_amdgcn_global_load_lds((const unsigned*)((const char*)(gbase) + (voff)[_i]), (PG8_LAS unsigned*)(lds + (bufoff) + ldsw + _i * 8192), 16, 0, 0); } while (0)
#define PG8_LDA(dst, b, h) do { _Pragma("unroll") for (int m = 0; m < 4; ++m) _Pragma("unroll") for (int k = 0; k < 2; ++k) dst[m][k] = *(const PG8_LAS bf16x8*)(lds + PG8_SA(b, h) + aoff + m * 2048 + k * 1024); } while (0)
#define PG8_LDB(dst, b, h) do { _Pragma("unroll") for (int n = 0; n < 2; ++n) _Pragma("unroll") for (int k = 0; k < 2; ++k) dst[n][k] = *(const PG8_LAS bf16x8*)(lds + PG8_SB(b, h) + boff + n * 2048 + k * 1024); } while (0)
#define PG8_MMA(ai, bj, At, Bt) do { __builtin_amdgcn_s_setprio(1); _Pragma("unroll") for (int m = 0; m < 4; ++m) _Pragma("unroll") for (int n = 0; n < 2; ++n) _Pragma("unroll") for (int k = 0; k < 2; ++k) \
        acc[ai][bj][m][n] = __builtin_amdgcn_mfma_f32_16x16x32_bf16(Bt[n][k], At[m][k], acc[ai][bj][m][n], 0, 0, 0); __builtin_amdgcn_s_setprio(0); } while (0)
#define PG8_WAIT_V(n) asm volatile("s_waitcnt vmcnt(" #n ")" ::: "memory")
#define PG8_WAIT_L(n) asm volatile("s_waitcnt lgkmcnt(" #n ")" ::: "memory")
#define PG8_BAR __builtin_amdgcn_s_barrier()
#define PG8_SCHED __builtin_amdgcn_sched_barrier(0)
    Unit cur, nxt; int ui = 0;
    if (!S.next(0, cur)) return;
    f32x4 acc[2][2][4][2];
#pragma unroll
    for (int a = 0; a < 2; ++a)
#pragma unroll
        for (int b = 0; b < 2; ++b)
#pragma unroll
            for (int m = 0; m < 4; ++m)
#pragma unroll
                for (int n = 0; n < 2; ++n) acc[a][b][m][n] = (f32x4){0.f, 0.f, 0.f, 0.f};
    bf16x8 At[4][2], B0[2][2], B1[2][2];
    const char* cA = (const char*)g.A + (size_t)cur.pm * tstep; const char* cB = (const char*)g.Bt + (size_t)cur.pn * tstep;
    S.a_ready(cur);
    PG8_STAGE(PG8_SB(0, 0), cB, voffB); PG8_STAGE(PG8_SA(0, 0), cA, voffA); PG8_STAGE(PG8_SB(0, 1), cB + hstep, voffB); PG8_STAGE(PG8_SA(0, 1), cA + hstep, voffA);
    if (wr == 1) PG8_BAR;
    PG8_WAIT_V(4); PG8_BAR;
    PG8_STAGE(PG8_SB(1, 0), cB + kstep, voffB); PG8_STAGE(PG8_SA(1, 0), cA + kstep, voffA); PG8_STAGE(PG8_SB(1, 1), cB + hstep + kstep, voffB);
    PG8_WAIT_V(6); PG8_BAR;
    PG8_STAMP();
    for (;;) {
        const bool has_next = S.next(ui + 1, nxt);
        const char* nA = has_next ? (const char*)g.A + (size_t)nxt.pm * tstep : cA; const char* nB = has_next ? (const char*)g.Bt + (size_t)nxt.pn * tstep : cB;
        for (int t = 0; t < nt; t += 2) {
            const bool last = (t == nt - 2);
            const char* a1 = cA + (size_t)(t + 1) * kstep;
            const char* a2 = last ? nA : cA + (size_t)(t + 2) * kstep; const char* b2 = last ? nB : cB + (size_t)(t + 2) * kstep;
            const char* a3 = a2 + kstep; const char* b3 = b2 + kstep;
            if (last && has_next) S.a_ready(nxt);
            PG8_LDB(B0, 0, 0); PG8_SCHED; PG8_LDA(At, 0, 0); PG8_STAGE(PG8_SA(1, 1), a1 + hstep, voffA);
            PG8_WAIT_L(8); PG8_BAR; PG8_WAIT_L(0); PG8_MMA(0, 0, At, B0); PG8_BAR; PG8_SCHED;
            PG8_LDB(B1, 0, 1); PG8_STAGE(PG8_SB(0, 0), b2, voffB);
            PG8_BAR; PG8_WAIT_L(0); PG8_MMA(0, 1, At, B1); PG8_BAR;
            PG8_LDA(At, 0, 1); PG8_STAGE(PG8_SA(0, 0), a2, voffA);
            PG8_BAR; PG8_WAIT_L(0); PG8_MMA(1, 0, At, B0); PG8_BAR; PG8_SCHED;
            PG8_STAGE(PG8_SB(0, 1), b2 + hstep, voffB);
            PG8_WAIT_V(6); PG8_BAR; PG8_MMA(1, 1, At, B1); PG8_BAR;
            PG8_LDB(B0, 1, 0); PG8_SCHED; PG8_LDA(At, 1, 0); PG8_STAGE(PG8_SA(0, 1), a2 + hstep, voffA);
            PG8_WAIT_L(8); PG8_BAR; PG8_WAIT_L(0); PG8_MMA(0, 0, At, B0); PG8_BAR; PG8_SCHED;
            PG8_LDB(B1, 1, 1); PG8_STAGE(PG8_SB(1, 0), b3, voffB);
            PG8_BAR; PG8_WAIT_L(0); PG8_MMA(0, 1, At, B1); PG8_BAR;
            PG8_LDA(At, 1, 1); PG8_STAGE(PG8_SA(1, 0), a3, voffA);
            PG8_BAR; PG8_WAIT_L(0); PG8_MMA(1, 0, At, B0); PG8_BAR; PG8_SCHED;
            PG8_STAGE(PG8_SB(1, 1), b3 + hstep, voffB);
            PG8_WAIT_V(6); PG8_BAR; PG8_MMA(1, 1, At, B1); PG8_BAR;
        }
        PG8_STAMP();
        if constexpr (!Epi::AFTER_DRAIN) { E(acc, cur, wr, wc, fr, fq); S.done(cur); }
        PG8_STAMP();
        if (!has_next) break;
#pragma unroll
        for (int a = 0; a < 2; ++a)
#pragma unroll
            for (int b = 0; b < 2; ++b)
#pragma unroll
                for (int m = 0; m < 4; ++m)
#pragma unroll
                    for (int n = 0; n < 2; ++n) acc[a][b][m][n] = (f32x4){0.f, 0.f, 0.f, 0.f};
        cur = nxt; cA = nA; cB = nB; ++ui;
    }
    PG8_WAIT_V(0);
    if (wr == 0) PG8_BAR;
    PG8_BAR;
    if constexpr (Epi::AFTER_DRAIN) { E.fused(acc, cur, wr, wc, fr, fq, lds, wid, lane); S.done(cur); }
    PG8_STAMP();
    if (STAMP && wid == 0) { stamps[lane] = lane < nts ? (((unsigned long long)(unsigned)ts_hi << 32) | (unsigned)ts_lo) : 0ull;
        if (lane == 62) stamps[62] = rt_entry; if (lane == 63) stamps[63] = (unsigned long long)wall_clock64(); }
#undef PG8_STAMP
#undef PG8_SA
#undef PG8_SB
#undef PG8_STAGE
#undef PG8_LDA
#undef PG8_LDB
#undef PG8_MMA
#undef PG8_WAIT_V
#undef PG8_WAIT_L
#undef PG8_BAR
#undef PG8_SCHED
}
}

using pg8::bf16x8; using pg8::f32x4; using pg8::u32x4; using pg8::Unit;
typedef unsigned short bf16;
typedef unsigned u32x2 __attribute__((ext_vector_type(2)));
typedef float f32x2 __attribute__((ext_vector_type(2)));
#define LAS __attribute__((address_space(3)))
#define DI __device__ __forceinline__
constexpr int T = 16384, D = 1024, NIN = 2816, RIN = 1792, RW = 512, FF = 2816, MEM = 256;
constexpr int NWAVES = 8, NTHR = 512;
constexpr int LCH = 256, NC = T / LCH;
constexpr float RMS_EPS = 1e-6f;
constexpr size_t MiB = (size_t)1 << 20, KiB = 1024;
constexpr size_t WS_CTL = 0, CTL_BYTES = 1 * MiB;
constexpr size_t WS_WIN = 2 * MiB, WS_WOUT = WS_WIN + (size_t)NIN * D * 2, WS_WQ = WS_WOUT + 2 * MiB, WS_WK = WS_WQ + 2 * MiB, WS_WV = WS_WK + 2 * MiB,
                 WS_WO = WS_WV + 2 * MiB, WS_WGU = WS_WO + 2 * MiB, WS_WD = WS_WGU + (size_t)2 * FF * D * 2;
constexpr size_t WS_XB = 34 * MiB;
constexpr size_t WS_R = WS_XB, WS_V = WS_XB + 16 * MiB;
constexpr size_t WS_G16 = WS_WIN;
constexpr size_t WS_ZR = 66 * MiB;
constexpr size_t WS_PT = WS_ZR, WS_SLOC = WS_ZR + 8 * MiB, WS_SST = WS_ZR + 16 * MiB;
constexpr size_t WS_Q = WS_ZR, WS_HFF = WS_ZR;
constexpr size_t WS_SU = 122 * MiB;
constexpr size_t WS_OB = WS_SU;
constexpr size_t WS_MIX = 154 * MiB;
constexpr size_t WS_B = 186 * MiB;
constexpr size_t WS_KP = 218 * MiB;
constexpr size_t WS_G = 234 * MiB;
constexpr size_t WS_MB = 251 * MiB, WS_KB = WS_MB + 512 * KiB, WS_VT = WS_KB + 512 * KiB, WS_WSB = WS_VT + 512 * KiB, WS_WLT = WS_WSB + 256 * KiB,
                 WS_ALT = WS_WLT + 64 * KiB, WS_GLT = WS_ALT + 64 * KiB, WS_RS0 = WS_GLT + 128 * KiB, WS_BON = WS_RS0 + 256 * KiB, WS_END = WS_BON + 512 * KiB;
constexpr size_t WS_WOTH = 254 * MiB;
static_assert(WS_WD + (size_t)D * FF * 2 <= WS_XB && WS_END <= WS_WOTH && WS_WOTH + 2 * MiB <= 256 * MiB, "ws map");
constexpr int LDS_BYTES = 147456;

DI float bf2f(unsigned b) { return __uint_as_float(b << 16); }
DI float bflo(unsigned w) { return __uint_as_float(w << 16); }
DI float bfhi(unsigned w) { return __uint_as_float(w & 0xffff0000u); }
DI unsigned pk2(float lo, float hi) { return pg8::cvt_pk_bf16(lo, hi); }
DI float wave_sum(float v) {
#pragma unroll
    for (int o = 1; o < 64; o <<= 1) v += __shfl_xor(v, o);
    return v; }
DI float sigmoidf_(float x) { return __builtin_amdgcn_rcpf(1.0f + __expf(-x)); }
DI float gelu_tanh(float v) { const float u2 = 1.5957691216f * (v + 0.044715f * v * v * v); return v * __builtin_amdgcn_rcpf(1.0f + __expf(-u2)); }
#define LDS_FENCE() asm volatile("s_waitcnt lgkmcnt(0)" ::: "memory")
#define MFMA16(a, b, c) __builtin_amdgcn_mfma_f32_16x16x32_bf16((a), (b), (c), 0, 0, 0)

struct KArgs { const float* in[31]; float* out; unsigned char* ws; int ph_lo, ph_hi; };
struct InTab { const __attribute__((address_space(4))) KArgs* ka; DI const float* operator[](int i) const { return ka->in[i]; } };
struct Frame {
    unsigned char* lds; int tid, lane, wid, bid, G;
    InTab in; float* out; unsigned char* ws;
};

#define XB_TMO      128
#define XB_XCNT(j)  (256  + 64 * (j))
#define XB_XSUB(j)  (1280 + 64 * (j))
#define XB_XGEN(j)  (2304 + 64 * (j))
#define XB_TOP      3328
#define XB_TOPGEN   3392
#define XCD_BAR_WORDS 3456
#define XB_SPIN_CAP (1u << 18)

__device__ __forceinline__ unsigned xb_ld(unsigned* p)              { return __hip_atomic_load(p, __ATOMIC_RELAXED, __HIP_MEMORY_SCOPE_AGENT); }
__device__ __forceinline__ unsigned xb_add(unsigned* p, unsigned v) { return __hip_atomic_fetch_add(p, v, __ATOMIC_RELAXED, __HIP_MEMORY_SCOPE_AGENT); }
__device__ __forceinline__ unsigned xb_xcc_id() { return (unsigned)__builtin_amdgcn_s_getreg((3 << 11) | 20) & 0xFu; }
#define XB_SPIN(cond, bar) do { unsigned _sp = 0; while (cond) { __builtin_amdgcn_s_sleep(1); \
    if ((++_sp & 255u) == 0u) { if (xb_ld(&(bar)[XB_TMO])) break; if (_sp > XB_SPIN_CAP) { atomicAdd(&(bar)[XB_TMO], 1u); break; } } } } while (0)

struct XcdBarrier {
    unsigned* bar; unsigned x;
    volatile LAS unsigned* st;
};

__device__ __forceinline__ XcdBarrier xcd_barrier_post(unsigned* bar, volatile LAS unsigned* st) {
    XcdBarrier b; b.bar = bar; b.x = xb_xcc_id(); b.st = st;
    if (threadIdx.x == 0) (void)xb_add(&bar[XB_XCNT(b.x)], 1u);
    return b;
}
__device__ __forceinline__ void xcd_barrier_complete(unsigned* bar, unsigned x, unsigned& nloc, unsigned& nx) {
    const unsigned G = gridDim.x * gridDim.y * gridDim.z;
    unsigned sum, cnt, mine, sp = 0u;
    for (;;) {
        sum = 0u; cnt = 0u; mine = 0u;
#pragma unroll
        for (unsigned j = 0; j < 16; ++j) { const unsigned c = xb_ld(&bar[XB_XCNT(j)]); sum += c; cnt += (c > 0u) ? 1u : 0u; mine = (j == x) ? c : mine; }
        if (sum == G) break;
        __builtin_amdgcn_s_sleep(1);
        if ((++sp & 255u) == 0u) { if (xb_ld(&bar[XB_TMO])) break; if (sp > XB_SPIN_CAP) { atomicAdd(&bar[XB_TMO], 1u); break; } }
    }
    nloc = mine > 0u ? mine : 1u; nx = cnt > 0u ? cnt : 1u;
}

__device__ __forceinline__ void xcd_barrier(const XcdBarrier& b) {
    asm volatile("s_waitcnt vmcnt(0)" ::: "memory");
    __syncthreads();
    if (threadIdx.x == 0) {
        unsigned* bar = b.bar;
        __builtin_amdgcn_s_waitcnt(0);
        unsigned nloc = b.st[0], nx = b.st[1];
        if (nloc == 0u) { xcd_barrier_complete(bar, b.x, nloc, nx); b.st[0] = nloc; b.st[1] = nx; }
        const unsigned old = xb_add(&bar[XB_XSUB(b.x)], 1u);
        const unsigned gen = old / nloc;
        if (old + 1u == (gen + 1u) * nloc) {
            __builtin_amdgcn_fence(__ATOMIC_RELEASE, "agent");
            asm volatile("s_waitcnt vmcnt(0)" ::: "memory");
            const unsigned og = xb_add(&bar[XB_TOP], 1u);
            const unsigned tg = og / nx;
            if (og + 1u == (tg + 1u) * nx) xb_add(&bar[XB_TOPGEN], 1u);
            else XB_SPIN(xb_ld(&bar[XB_TOPGEN]) == tg, bar);
            __builtin_amdgcn_fence(__ATOMIC_ACQUIRE, "agent");
            xb_add(&bar[XB_XGEN(b.x)], 1u);
            asm volatile("s_waitcnt vmcnt(0)" ::: "memory");
        } else {
            XB_SPIN(xb_ld(&bar[XB_XGEN(b.x)]) == gen, bar);
            __builtin_amdgcn_fence(__ATOMIC_ACQUIRE, "agent");
            asm volatile("s_waitcnt vmcnt(0)" ::: "memory");
        }
    }
    __syncthreads();
}

DI bool static_unit(int i, int G, int cid, int nM, int nN, int& pm, int& pn) {
    const int nwg = nM * nN; const long L = (long)i * G + cid; if (L >= nwg) return false;
    int wgid = (int)L; { const int q = nwg / pg8::NXCD, r = nwg % pg8::NXCD, xcd = wgid % pg8::NXCD, off = wgid / pg8::NXCD; wgid = (xcd < r ? xcd * (q + 1) : r * (q + 1) + (xcd - r) * q) + off; }
    const int nig = pg8::WGM * nN, gid = wgid / nig, fm = gid * pg8::WGM, gsz = (nM - fm) < pg8::WGM ? (nM - fm) : pg8::WGM;
    pm = fm + ((wgid % nig) % gsz); pn = (wgid % nig) / gsz; return true; }
constexpr int RS_TAB_OFF = 131072, RS_TAB_UNITS = 8;
DI void fill_rs_table(Frame& F, int nM, int nN, const float* src, bool is_ss) {
    float* tab = (float*)(F.lds + RS_TAB_OFF);
    for (int i = 0; i < RS_TAB_UNITS; ++i) { int pm, pn; if (!static_unit(i, F.G, F.bid, nM, nN, pm, pn)) break;
        if (F.tid < 256) { const float v = src[pm * 256 + F.tid]; tab[i * 256 + F.tid] = is_ss ? rsqrtf(v * (1.0f / D) + RMS_EPS) : v; } }
    __syncthreads();
}
struct EpiZ {
    static constexpr bool PERM = true, AFTER_DRAIN = false;
    bf16* zr; bf16* su; const float* rstab; float* sg1; float* sg2; mutable int ui = 0;
    DI void operator()(const f32x4 (&acc)[2][2][4][2], const Unit& u, int wr, int wc, int fr, int fq) const {
        const int row0 = u.pm * 256 + wr * 64 + fr; const bool isr = u.pn < 7, st = u.pn >= 9;
        bf16* base = isr ? zr : su; const int ldc = isr ? RIN : 1024; const int col0 = (isr ? u.pn : u.pn - 7) * 256 + wc * 32 + 8 * fq;
        float rsv[8];
#pragma unroll
        for (int i = 0; i < 8; ++i) rsv[i] = rstab[ui * 256 + wr * 64 + fr + (i >> 2) * 128 + (i & 3) * 16];
        ++ui;
#pragma unroll
        for (int ai = 0; ai < 2; ++ai)
#pragma unroll
            for (int m = 0; m < 4; ++m) { const int r = row0 + ai * 128 + m * 16; const float rs = rsv[ai * 4 + m]; bf16* rowp = base + (size_t)r * ldc + col0; float s1 = 0.f, s2 = 0.f;
#pragma unroll
                for (int bj = 0; bj < 2; ++bj) { f32x4 v0 = acc[ai][bj][m][0] * rs, v1 = acc[ai][bj][m][1] * rs;
                    if (!isr) {
#pragma unroll
                        for (int j = 0; j < 4; ++j) { v0[j] = gelu_tanh(v0[j]); v1[j] = gelu_tanh(v1[j]); }
#pragma unroll
                        for (int j = 0; j < 4; ++j) { s1 += v0[j] + v1[j]; s2 += v0[j] * v0[j] + v1[j] * v1[j]; } }
                    u32x4 w; w.x = pk2(v0[0], v0[1]); w.y = pk2(v0[2], v0[3]); w.z = pk2(v1[0], v1[1]); w.w = pk2(v1[2], v1[3]);
                    *(u32x4*)(rowp + bj * 128) = w; }
                if (st) { s1 += __shfl_xor(s1, 16); s1 += __shfl_xor(s1, 32); s2 += __shfl_xor(s2, 16); s2 += __shfl_xor(s2, 32);
                    if (fq == 0) { atomicAdd(sg1 + r, s1); atomicAdd(sg2 + r, s2); } } }
    }
};
struct EpiBf {
    static constexpr bool PERM = true, AFTER_DRAIN = false;
    bf16* O; int ldc; const float* ss; float one; int head_stride = 0;
    DI void operator()(const f32x4 (&acc)[2][2][4][2], const Unit& u, int wr, int wc, int fr, int fq) const {
        const int row0 = u.pm * 256 + wr * 64 + fr, col0 = (head_stride ? 0 : u.pn * 256) + wc * 32 + 8 * fq; bf16* Ob = O + (size_t)(head_stride ? u.pn : 0) * head_stride;
        float rsv[8];
#pragma unroll
        for (int i = 0; i < 8; ++i) rsv[i] = ss ? rsqrtf(ss[row0 + (i >> 2) * 128 + (i & 3) * 16] * (1.0f / D) + RMS_EPS) : one;
#pragma unroll
        for (int ai = 0; ai < 2; ++ai)
#pragma unroll
            for (int m = 0; m < 4; ++m) { const int r = row0 + ai * 128 + m * 16; const float rs = rsv[ai * 4 + m]; bf16* rowp = Ob + (size_t)r * ldc + col0;
#pragma unroll
                for (int bj = 0; bj < 2; ++bj) { const f32x4 v0 = acc[ai][bj][m][0] * rs, v1 = acc[ai][bj][m][1] * rs;
                    u32x4 w; w.x = pk2(v0[0], v0[1]); w.y = pk2(v0[2], v0[3]); w.z = pk2(v1[0], v1[1]); w.w = pk2(v1[2], v1[3]);
                    *(u32x4*)(rowp + bj * 128) = w; } }
    }
};
struct EpiRes {
    static constexpr bool PERM = false, AFTER_DRAIN = false;
    const float* basef; const bf16* baseb; bf16* xb; float* ss;
    DI void ld(f32x4 (&d)[4], size_t off) const {
        if (basef) {
#pragma unroll
            for (int q = 0; q < 4; ++q) d[q] = __builtin_nontemporal_load((const f32x4*)(basef + off + (q >> 1) * 128 + (q & 1) * 16));
        } else {
#pragma unroll
            for (int q = 0; q < 4; ++q) { const u32x2 w = *(const u32x2*)(baseb + off + (q >> 1) * 128 + (q & 1) * 16); d[q] = (f32x4){bflo(w.x), bfhi(w.x), bflo(w.y), bfhi(w.y)}; }
        } }
    DI void operator()(const f32x4 (&acc)[2][2][4][2], const Unit& u, int wr, int wc, int fr, int fq) const {
        const int row0 = u.pm * 256 + wr * 64 + fr, col0 = u.pn * 256 + wc * 32 + 4 * fq;
        f32x4 bc[4], bn[4];
        ld(bc, (size_t)row0 * D + col0);
#pragma unroll
        for (int idx = 0; idx < 8; ++idx) { const int ai = idx >> 2, m = idx & 3; const int r = row0 + ai * 128 + m * 16; const size_t off = (size_t)r * D + col0; float s2 = 0.f;
            if (idx + 1 < 8) ld(bn, (size_t)(row0 + ((idx + 1) >> 2) * 128 + ((idx + 1) & 3) * 16) * D + col0);
#pragma unroll
            for (int bj = 0; bj < 2; ++bj)
#pragma unroll
                for (int n = 0; n < 2; ++n) { const f32x4 o = bc[bj * 2 + n] + acc[ai][bj][m][n];
                    s2 += (o[0] * o[0] + o[1] * o[1]) + (o[2] * o[2] + o[3] * o[3]);
                    u32x2 w; w.x = pk2(o[0], o[1]); w.y = pk2(o[2], o[3]); *(u32x2*)(xb + off + bj * 128 + n * 16) = w; }
            s2 += __shfl_xor(s2, 16); s2 += __shfl_xor(s2, 32);
            if (fq == 0) atomicAdd(ss + r, s2);
#pragma unroll
            for (int q = 0; q < 4; ++q) bc[q] = bn[q];
            asm volatile("" ::: "memory"); }
    }
};
struct EpiFinal {
    static constexpr bool PERM = false, AFTER_DRAIN = true;
    const bf16* base; float* out; float* ss; unsigned* cnt; const float* gf;
    DI void ld(f32x4 (&d)[4], size_t off) const {
#pragma unroll
        for (int q = 0; q < 4; ++q) { const u32x2 w = *(const u32x2*)(base + off + (q >> 1) * 128 + (q & 1) * 16); d[q] = (f32x4){bflo(w.x), bfhi(w.x), bflo(w.y), bfhi(w.y)}; } }
    DI void fused(f32x4 (&acc)[2][2][4][2], const Unit& u, int wr, int wc, int fr, int fq, PG8_LAS unsigned char* lds, int wid, int lane) const {
        const int row0 = u.pm * 256 + wr * 64 + fr, col0 = u.pn * 256 + wc * 32 + 4 * fq;
        f32x4 bc[4], bn[4];
        ld(bc, (size_t)row0 * D + col0);
#pragma unroll
        for (int idx = 0; idx < 8; ++idx) { const int ai = idx >> 2, m = idx & 3; const int r = row0 + ai * 128 + m * 16; float s2 = 0.f;
            if (idx + 1 < 8) ld(bn, (size_t)(row0 + ((idx + 1) >> 2) * 128 + ((idx + 1) & 3) * 16) * D + col0);
#pragma unroll
            for (int bj = 0; bj < 2; ++bj)
#pragma unroll
                for (int n = 0; n < 2; ++n) { const f32x4 o = bc[bj * 2 + n] + acc[ai][bj][m][n]; acc[ai][bj][m][n] = o; s2 += (o[0] * o[0] + o[1] * o[1]) + (o[2] * o[2] + o[3] * o[3]); }
            s2 += __shfl_xor(s2, 16); s2 += __shfl_xor(s2, 32);
            if (fq == 0) atomicAdd(ss + r, s2);
#pragma unroll
            for (int q = 0; q < 4; ++q) bc[q] = bn[q];
            asm volatile("" ::: "memory"); }
        asm volatile("s_waitcnt vmcnt(0)" ::: "memory");
        __syncthreads();
        if (threadIdx.x == 0) { unsigned* c = cnt + 64 * u.pm; __hip_atomic_fetch_add(c, 1u, __ATOMIC_RELAXED, __HIP_MEMORY_SCOPE_AGENT);
            unsigned sp = 0; while (__hip_atomic_load(c, __ATOMIC_RELAXED, __HIP_MEMORY_SCOPE_AGENT) < (unsigned)(D / 256) && ++sp < (1u << 22)) __builtin_amdgcn_s_sleep(1); }
        __syncthreads();
        f32x4 g4[4];
#pragma unroll
        for (int q = 0; q < 4; ++q) g4[q] = *(const f32x4*)(gf + col0 + (q >> 1) * 128 + (q & 1) * 16);
#pragma unroll
        for (int idx = 0; idx < 8; ++idx) { const int ai = idx >> 2, m = idx & 3; const int r = row0 + ai * 128 + m * 16; const size_t off = (size_t)r * D + col0;
            const float rs = rsqrtf(__hip_atomic_load(ss + r, __ATOMIC_RELAXED, __HIP_MEMORY_SCOPE_AGENT) * (1.0f / D) + RMS_EPS);
#pragma unroll
            for (int bj = 0; bj < 2; ++bj)
#pragma unroll
                for (int n = 0; n < 2; ++n) *(f32x4*)(out + off + bj * 128 + n * 16) = acc[ai][bj][m][n] * rs * g4[bj * 2 + n]; }
    }
};
struct EpiSoftmax {
    static constexpr bool PERM = true, AFTER_DRAIN = true;
    bf16* P; const float* ss;
    DI void fused(f32x4 (&acc)[2][2][4][2], const Unit& u, int wr, int wc, int fr, int fq, PG8_LAS unsigned char* lds, int wid, int lane) const {
        PG8_LAS float* red = (PG8_LAS float*)lds;
        const int lrow0 = wr * 64 + fr, grow0 = u.pm * 256 + lrow0;
#pragma unroll
        for (int idx = 0; idx < 8; ++idx) { const int ai = idx >> 2, m = idx & 3, lr = lrow0 + ai * 128 + m * 16; const float rs = rsqrtf(ss[grow0 + ai * 128 + m * 16] * (1.0f / D) + RMS_EPS) * 0.0625f; float mx = -1e30f;
#pragma unroll
            for (int bj = 0; bj < 2; ++bj)
#pragma unroll
                for (int n = 0; n < 2; ++n) { const f32x4 v = acc[ai][bj][m][n] * rs; acc[ai][bj][m][n] = v; mx = fmaxf(mx, fmaxf(fmaxf(v[0], v[1]), fmaxf(v[2], v[3]))); }
            mx = fmaxf(mx, __shfl_xor(mx, 16)); mx = fmaxf(mx, __shfl_xor(mx, 32));
            if (fq == 0) red[lr * 4 + wc] = mx; }
        asm volatile("s_waitcnt lgkmcnt(0)" ::: "memory"); __builtin_amdgcn_s_barrier(); asm volatile("" ::: "memory");
#pragma unroll
        for (int idx = 0; idx < 8; ++idx) { const int ai = idx >> 2, m = idx & 3, lr = lrow0 + ai * 128 + m * 16; const f32x4 m4 = *(const PG8_LAS f32x4*)(red + lr * 4);
            const float mx = fmaxf(fmaxf(m4[0], m4[1]), fmaxf(m4[2], m4[3])); float sm = 0.f;
#pragma unroll
            for (int bj = 0; bj < 2; ++bj)
#pragma unroll
                for (int n = 0; n < 2; ++n) { f32x4 v = acc[ai][bj][m][n];
#pragma unroll
                    for (int e = 0; e < 4; ++e) { v[e] = __expf(v[e] - mx); sm += v[e]; }
                    acc[ai][bj][m][n] = v; }
            sm += __shfl_xor(sm, 16); sm += __shfl_xor(sm, 32);
            if (fq == 0) red[1024 + lr * 4 + wc] = sm; }
        asm volatile("s_waitcnt lgkmcnt(0)" ::: "memory"); __builtin_amdgcn_s_barrier(); asm volatile("" ::: "memory");
#pragma unroll
        for (int idx = 0; idx < 8; ++idx) { const int ai = idx >> 2, m = idx & 3, lr = lrow0 + ai * 128 + m * 16; const f32x4 s4 = *(const PG8_LAS f32x4*)(red + 1024 + lr * 4);
            const float inv = 1.0f / ((s4[0] + s4[1]) + (s4[2] + s4[3])); bf16* rowp = P + (size_t)(grow0 + ai * 128 + m * 16) * D + u.pn * 256 + wc * 32 + 8 * fq;
#pragma unroll
            for (int bj = 0; bj < 2; ++bj) { const f32x4 v0 = acc[ai][bj][m][0] * inv, v1 = acc[ai][bj][m][1] * inv;
                u32x4 w; w.x = pk2(v0[0], v0[1]); w.y = pk2(v0[2], v0[3]); w.z = pk2(v1[0], v1[1]); w.w = pk2(v1[2], v1[3]);
                *(u32x4*)(rowp + bj * 128) = w; } }
    }
};
struct EpiSwi {
    static constexpr bool PERM = true, AFTER_DRAIN = false;
    bf16* H; const float* rstab; mutable int ui = 0;
    DI void operator()(const f32x4 (&acc)[2][2][4][2], const Unit& u, int wr, int wc, int fr, int fq) const {
        const int row0 = u.pm * 256 + wr * 64 + fr, col0 = u.pn * 128 + wc * 32 + 8 * fq;
        float rsv[8];
#pragma unroll
        for (int i = 0; i < 8; ++i) rsv[i] = rstab[ui * 256 + wr * 64 + fr + (i >> 2) * 128 + (i & 3) * 16];
        ++ui;
#pragma unroll
        for (int ai = 0; ai < 2; ++ai)
#pragma unroll
            for (int m = 0; m < 4; ++m) { const int r = row0 + ai * 128 + m * 16; const float rs = rsv[ai * 4 + m]; float h[8];
#pragma unroll
                for (int n = 0; n < 2; ++n)
#pragma unroll
                    for (int j = 0; j < 4; ++j) { const float g = acc[ai][0][m][n][j] * rs, up = acc[ai][1][m][n][j] * rs; h[4 * n + j] = g * up * sigmoidf_(g); }
                u32x4 w; w.x = pk2(h[0], h[1]); w.y = pk2(h[2], h[3]); w.z = pk2(h[4], h[5]); w.w = pk2(h[6], h[7]);
                *(u32x4*)(H + (size_t)r * FF + col0) = w; }
    }
};
struct FewOrder {
    int pm, pn; bool has;
    DI bool next(int i, Unit& u) const { if (i != 0 || !has) return false; u.pm = pm; u.pn = pn; return true; }
    DI void a_ready(const Unit&) const {}
    DI void done(const Unit&) const {}
};

struct TrItem { const float* W; const float* ks; bf16* WT; int K, N, drow0, kb, nb; bool valid; };
DI void tr_load(const TrItem& I, f32x4 (&v)[8], int lane) {
    if (!I.valid) return;
    const int k0 = 64 * I.kb, n0 = 32 * I.nb;
#pragma unroll
    for (int i = 0; i < 8; ++i) { const int kk = (lane >> 3) + 8 * i; v[i] = __builtin_nontemporal_load((const f32x4*)(I.W + (size_t)(k0 + kk) * I.N + n0 + 4 * (lane & 7))); }
}
DI void tr_finish(const TrItem& I, const f32x4 (&v)[8], float* scr, int lane) {
    if (!I.valid) return;
    const int k0 = 64 * I.kb;
#pragma unroll
    for (int i = 0; i < 8; ++i) { const int kk = (lane >> 3) + 8 * i; const float sc = I.ks ? I.ks[k0 + kk] : 1.0f; float* d = scr + kk * 33 + 4 * (lane & 7);
        d[0] = v[i][0] * sc; d[1] = v[i][1] * sc; d[2] = v[i][2] * sc; d[3] = v[i][3] * sc; }
    LDS_FENCE();
    const int c = lane & 7;
#pragma unroll
    for (int j = 0; j < 4; ++j) { const int n = (lane >> 3) + 8 * j; const float* s = scr + (8 * c) * 33 + n;
        u32x4 o; o.x = pk2(s[0 * 33], s[1 * 33]); o.y = pk2(s[2 * 33], s[3 * 33]); o.z = pk2(s[4 * 33], s[5 * 33]); o.w = pk2(s[6 * 33], s[7 * 33]);
        *(u32x4*)(I.WT + (size_t)(I.drow0 + n) * I.K + k0 + 8 * c) = o; }
    LDS_FENCE();
}
DI TrItem tr_decode(Frame& F, int it, int nitems) {
    TrItem I; I.valid = it < nitems; I.W = nullptr; I.ks = nullptr; I.WT = nullptr; I.K = 0; I.N = 0; I.drow0 = 0; I.kb = 0; I.nb = 0;
    if (!I.valid) return I;
    unsigned char* ws = F.ws; int r = it;
#define TR(Wp, K_, N_, SC, DST, DROW) { constexpr int ni_ = ((K_) / 64) * ((N_) / 32); if (r >= 0 && r < ni_) { I.kb = r / ((N_) / 32); I.nb = r % ((N_) / 32); const int n0 = I.nb * 32; (void)n0; \
            I.W = (Wp); I.K = (K_); I.N = (N_); I.ks = (SC); I.WT = (bf16*)(ws + (DST)); I.drow0 = (DROW); } r -= ni_; }
    TR(F.in[3], D, NIN, F.in[2], WS_WIN, n0)
    TR(F.in[23], D, D, (const float*)nullptr, WS_WK, n0)
    TR(F.in[24], D, D, (const float*)nullptr, WS_WV, n0)
    TR(F.in[6], 64, RW, (const float*)nullptr, WS_WLT, n0)
    TR(F.in[8], 64, RW, (const float*)nullptr, WS_ALT, n0)
    TR(F.in[9], 128, RW, (const float*)nullptr, WS_GLT, n0)
    TR(F.in[27], D, FF, F.in[26], WS_WGU, (n0 / 128) * 256 + (n0 % 128))
    TR(F.in[28], D, FF, F.in[26], WS_WGU, (n0 / 128) * 256 + 128 + (n0 % 128))
    TR(F.in[19], D, D, (const float*)nullptr, WS_WOUT, n0)
    TR(F.in[25] + 0 * 256 * D, 256, D, (const float*)nullptr, WS_WOTH + 0 * (size_t)D * 256 * 2, n0)
    TR(F.in[25] + 1 * 256 * D, 256, D, (const float*)nullptr, WS_WOTH + 1 * (size_t)D * 256 * 2, n0)
    TR(F.in[25] + 2 * 256 * D, 256, D, (const float*)nullptr, WS_WOTH + 2 * (size_t)D * 256 * 2, n0)
    TR(F.in[25] + 3 * 256 * D, 256, D, (const float*)nullptr, WS_WOTH + 3 * (size_t)D * 256 * 2, n0)
    TR(F.in[29], FF, D, (const float*)nullptr, WS_WD, n0)
#undef TR
    return I;
}
constexpr int TR_I_IN = (D / 64) * (NIN / 32), TR_I_SQ = (D / 64) * (D / 32), TR_I_FF = (D / 64) * (FF / 32), TR_I_DN = (FF / 64) * (D / 32), TR_I_L64 = 1 * (RW / 32), TR_I_L128 = 2 * (RW / 32);
constexpr int TR_NITEMS = TR_I_IN + 4 * TR_I_SQ + 2 * TR_I_FF + TR_I_DN + 2 * TR_I_L64 + TR_I_L128, TR_LATE0 = TR_I_IN + 2 * TR_I_SQ + 2 * TR_I_L64 + TR_I_L128 + 0 * TR_I_FF, TR_DN0 = TR_NITEMS - TR_I_DN;
DI void tr_run(Frame& F, int gw, int NGW, int base, int count, int skip_at, int skip_len) {
    float* scr = (float*)(F.lds + F.wid * 16384); const int lane = F.lane;
#define TR_REAL(v_) ((v_) < count ? ((base + (v_)) >= skip_at ? base + (v_) + skip_len : base + (v_)) : TR_NITEMS)
    f32x4 va[8], vb[8];
    TrItem Ia = tr_decode(F, TR_REAL(gw), TR_NITEMS); tr_load(Ia, va, lane);
    for (int it = gw; it < count; it += 2 * NGW) {
        TrItem Ib = tr_decode(F, TR_REAL(it + NGW), TR_NITEMS); tr_load(Ib, vb, lane);
        tr_finish(Ia, va, scr, lane);
        Ia = tr_decode(F, TR_REAL(it + 2 * NGW), TR_NITEMS); tr_load(Ia, va, lane);
        tr_finish(Ib, vb, scr, lane);
    }
#undef TR_REAL
}
DI void p0_prologue(Frame& F) {
    const int gw = F.bid * NWAVES + F.wid, NGW = F.G * NWAVES, lane = F.lane;
    unsigned char* ws = F.ws;
    tr_run(F, gw, NGW, 0, TR_LATE0, 1 << 30, 0);
    const float* x = F.in[0]; bf16* xb = (bf16*)(ws + WS_XB); float* rs0 = (float*)(ws + WS_RS0);
    { f32x4 vn[4];
#pragma unroll
      for (int j = 0; j < 4; ++j) vn[j] = __builtin_nontemporal_load((const f32x4*)(x + (size_t)gw * D) + lane + 64 * j);
      for (int m = gw; m < T; m += NGW) {
        f32x4 v[4]; float s = 0.f;
#pragma unroll
        for (int j = 0; j < 4; ++j) { v[j] = vn[j]; s += (v[j][0] * v[j][0] + v[j][1] * v[j][1]) + (v[j][2] * v[j][2] + v[j][3] * v[j][3]); }
        if (m + NGW < T) {
#pragma unroll
            for (int j = 0; j < 4; ++j) vn[j] = __builtin_nontemporal_load((const f32x4*)(x + (size_t)(m + NGW) * D) + lane + 64 * j); }
        s = wave_sum(s);
        if (lane == 0) rs0[m] = rsqrtf(s * (1.0f / D) + RMS_EPS);
        u32x2* o8 = (u32x2*)(xb + (size_t)m * D) + lane;
#pragma unroll
        for (int j = 0; j < 4; ++j) { u32x2 w; w.x = pk2(v[j][0], v[j][1]); w.y = pk2(v[j][2], v[j][3]); o8[64 * j] = w; }
      } }
    { const float* wq = F.in[22]; const float* g2 = F.in[20]; bf16* wqu = (bf16*)(ws + WS_WQ);
      for (int k = gw; k < D; k += NGW) { const float gk = g2[k];
#pragma unroll
          for (int j = 0; j < 4; ++j) { const f32x4 v = ((const f32x4*)(wq + (size_t)k * D) + lane)[64 * j]; u32x2 w; w.x = pk2(v[0] * gk, v[1] * gk); w.y = pk2(v[2] * gk, v[3] * gk);
              *(u32x2*)(wqu + (size_t)j * D * 256 + (size_t)k * 256 + 4 * lane) = w; } } }
    const float* mem = F.in[1]; const float* mg = F.in[21]; bf16* mb = (bf16*)(ws + WS_MB);
    for (int m = gw; m < MEM; m += NGW) {
        const f32x4* xr = (const f32x4*)(mem + (size_t)m * D) + lane; f32x4 v[4]; float s = 0.f;
#pragma unroll
        for (int j = 0; j < 4; ++j) { v[j] = xr[64 * j]; s += (v[j][0] * v[j][0] + v[j][1] * v[j][1]) + (v[j][2] * v[j][2] + v[j][3] * v[j][3]); }
        s = wave_sum(s); const float rs = rsqrtf(s * (1.0f / D) + RMS_EPS);
        u32x2* o8 = (u32x2*)(mb + (size_t)m * D) + lane;
#pragma unroll
        for (int j = 0; j < 4; ++j) { const f32x4 g = ((const f32x4*)mg)[lane + 64 * j]; u32x2 w; w.x = pk2(v[j][0] * rs * g[0], v[j][1] * rs * g[1]); w.y = pk2(v[j][2] * rs * g[2], v[j][3] * rs * g[3]); o8[64 * j] = w; }
    }
    const float* wsp = F.in[17]; bf16* wsb = (bf16*)(ws + WS_WSB);
    for (int e = F.bid * NTHR + F.tid; e < 8 * 128 * 128; e += F.G * NTHR) { const int i = (e >> 7) & 127, j = e & 127; wsb[e] = (bf16)(pk2(j <= i ? wsp[e] : 0.f, 0.f) & 0xffffu); }
}

DI f32x4 load_shift4(const bf16* zrow, int col, int t, const float* mu) {
    const u32x2 a = *(const u32x2*)(zrow + col); u32x2 p = (u32x2){0u, 0u}; if (t > 0) p = *(const u32x2*)(zrow - RIN + col);
    const f32x4 m4 = *(const f32x4*)(mu + col); const f32x4 z = (f32x4){bflo(a.x), bfhi(a.x), bflo(a.y), bfhi(a.y)}, pz = (f32x4){bflo(p.x), bfhi(p.x), bflo(p.y), bfhi(p.y)};
    return z + (pz - z) * m4; }
template <int N> DI float dpp_shr(float v, float old) { return __builtin_bit_cast(float, __builtin_amdgcn_update_dpp(__builtin_bit_cast(int, old), __builtin_bit_cast(int, v), 0x110 + N, 0xF, 0xF, false)); }
DI float scan16_mul(float x) { x *= dpp_shr<1>(x, 1.0f); x *= dpp_shr<2>(x, 1.0f); x *= dpp_shr<4>(x, 1.0f); x *= dpp_shr<8>(x, 1.0f); return x; }
DI void prep_phase(Frame& F) {
    unsigned char* ws = F.ws; const int tid = F.tid, lane = F.lane, h = F.wid, fr = lane & 15, fq = lane >> 4;
    const bf16* zr = (const bf16*)(ws + WS_ZR); const float* mu = F.in[4];
    const bf16* WlT = (const bf16*)(ws + WS_WLT); const bf16* AlT = (const bf16*)(ws + WS_ALT); const bf16* GlT = (const bf16*)(ws + WS_GLT);
    const float *w0 = F.in[5], *a0 = F.in[7], *k_k = F.in[10], *k_a = F.in[11], *r_k = F.in[12];
    float* G16 = (float*)(ws + WS_G16); float* KK = F.out + (size_t)T * RW; float* Bb = (float*)(ws + WS_B);
    bf16* Rb = (bf16*)(ws + WS_R); bf16* Vb = (bf16*)(ws + WS_V); bf16* KPb = (bf16*)(ws + WS_KP); bf16* Gb = (bf16*)(ws + WS_G); float* bonus = (float*)(ws + WS_BON);
    unsigned char* AL = F.lds;
    const float gone = F.G > (1 << 20) ? 2.0f : 1.0f;
    for (int tile = F.bid; tile < T / 64; tile += F.G) {
        const int t0 = tile * 64;
        __syncthreads();
        { const int tk = tid >> 3, cs = (tid & 7) * 32, t = t0 + tk, kind = cs < 64 ? 0 : (cs < 128 ? 1 : 2);
          const bf16* zrow = zr + (size_t)t * RIN + 1536 + cs;
#pragma unroll
          for (int q = 0; q < 4; ++q) { const u32x4 a = *(const u32x4*)(zrow + 8 * q); u32x4 p = (u32x4){0u, 0u, 0u, 0u}; if (t > 0) p = *(const u32x4*)(zrow - RIN + 8 * q);
              float o[8];
#pragma unroll
              for (int e2 = 0; e2 < 4; ++e2) { const float z0 = bflo(a[e2]), z1 = bfhi(a[e2]), p0 = bflo(p[e2]), p1 = bfhi(p[e2]);
                  const float m0 = mu[1536 + cs + 8 * q + 2 * e2], m1 = mu[1536 + cs + 8 * q + 2 * e2 + 1];
                  float h0 = z0 + (p0 - z0) * m0, h1 = z1 + (p1 - z1) * m1;
                  if (kind == 0) { h0 = 1.0f - 2.0f * __builtin_amdgcn_rcpf(1.0f + __expf(2.0f * h0)); h1 = 1.0f - 2.0f * __builtin_amdgcn_rcpf(1.0f + __expf(2.0f * h1)); }
                  if (kind == 2) { h0 = sigmoidf_(h0); h1 = sigmoidf_(h1); }
                  o[2 * e2] = h0; o[2 * e2 + 1] = h1; }
              u32x4 w; w.x = pk2(o[0], o[1]); w.y = pk2(o[2], o[3]); w.z = pk2(o[4], o[5]); w.w = pk2(o[6], o[7]);
              *(u32x4*)(AL + tk * 528 + (cs + 8 * q) * 2) = w; } }
        __syncthreads();
        float inv[4], bon[4];
#pragma unroll
        for (int mt = 0; mt < 4; ++mt) { const int t = t0 + 16 * mt + fr; const bf16* zrow = zr + (size_t)t * RIN; float ssq = 0.f;
#pragma unroll
            for (int nt = 0; nt < 4; ++nt) { const int c = 64 * h + 16 * nt + 4 * fq; const f32x4 k4 = load_shift4(zrow, 512 + c, t, mu); const f32x4 kk4 = *(const f32x4*)(k_k + c);
#pragma unroll
                for (int e = 0; e < 4; ++e) { const float q = k4[e] * kk4[e]; ssq += q * q; } }
            ssq += __shfl_xor(ssq, 16); ssq += __shfl_xor(ssq, 32);
            inv[mt] = 1.0f / fmaxf(sqrtf(ssq), 1e-12f); bon[mt] = 0.f; }
#pragma unroll 1
        for (int nt = 0; nt < 4; ++nt) {
            const int n = 64 * h + 16 * nt + fr, c = 64 * h + 16 * nt + 4 * fq;
            bf16x8 bw[2], ba[2], bg[4];
#pragma unroll
            for (int ks = 0; ks < 2; ++ks) { bw[ks] = *(const bf16x8*)(WlT + n * 64 + 32 * ks + 8 * fq); ba[ks] = *(const bf16x8*)(AlT + n * 64 + 32 * ks + 8 * fq); }
#pragma unroll
            for (int ks = 0; ks < 4; ++ks) bg[ks] = *(const bf16x8*)(GlT + n * 128 + 32 * ks + 8 * fq);
            const f32x4 w04 = *(const f32x4*)(w0 + c), a04 = *(const f32x4*)(a0 + c), kk4 = *(const f32x4*)(k_k + c), ka4 = *(const f32x4*)(k_a + c), rk4 = *(const f32x4*)(r_k + c);
#pragma unroll
            for (int mt = 0; mt < 4; ++mt) {
                const int t = t0 + 16 * mt + fr; const bf16* zrow = zr + (size_t)t * RIN; const size_t o = (size_t)t * RW + c;
                const f32x4 r4 = load_shift4(zrow, c, t, mu), k4 = load_shift4(zrow, 512 + c, t, mu), v4 = load_shift4(zrow, 1024 + c, t, mu);
                f32x4 aw = (f32x4){0.f, 0.f, 0.f, 0.f}, aa = aw, ag = aw;
                const unsigned char* arow = AL + (16 * mt + fr) * 528 + 16 * fq;
#pragma unroll
                for (int ks = 0; ks < 2; ++ks) { aw = MFMA16(bw[ks], *(const bf16x8*)(arow + 64 * ks), aw); aa = MFMA16(ba[ks], *(const bf16x8*)(arow + 128 + 64 * ks), aa); }
#pragma unroll
                for (int ks = 0; ks < 4; ++ks) ag = MFMA16(bg[ks], *(const bf16x8*)(arow + 256 + 64 * ks), ag);
                f32x4 dw, dk, db; float kp[4];
#pragma unroll
                for (int e = 0; e < 4; ++e) { const float wl = w04[e] + aw[e];
                    dw[e] = __expf(-0.6065306597f * sigmoidf_(wl));
                    const float a = sigmoidf_(a04[e] + aa[e]);
                    const float kkv = k4[e] * kk4[e] * inv[mt]; dk[e] = kkv; db[e] = kkv * a;
                    kp[e] = k4[e] * (1.0f + (a - 1.0f) * ka4[e]); bon[mt] += r4[e] * kp[e] * rk4[e]; }
                f32x4 gi, ge, gr;
#pragma unroll
                for (int e = 0; e < 4; ++e) { gi[e] = scan16_mul(dw[e]); ge[e] = dpp_shr<1>(gi[e], 1.0f); gr[e] = __builtin_amdgcn_rcpf(gi[e]); }
                if (fr == 15) *(f32x4*)(G16 + (size_t)(t >> 4) * RW + c) = gi;
                *(f32x4*)(KK + o) = dk * ge; *(f32x4*)(Bb + o) = db * gr;
                u32x2 w; w.x = pk2(r4[0] * gi[0], r4[1] * gi[1]); w.y = pk2(r4[2] * gi[2], r4[3] * gi[3]); *(u32x2*)(Rb + o) = w;
                w.x = pk2(v4[0], v4[1]); w.y = pk2(v4[2], v4[3]); *(u32x2*)(Vb + o) = w;
                w.x = pk2(kp[0] * gr[0], kp[1] * gr[1]); w.y = pk2(kp[2] * gr[2], kp[3] * gr[3]); *(u32x2*)(KPb + o) = w;
                { const f32x4 gv = ag * gone;
                  w.x = pk2(gv[0], gv[1]); w.y = pk2(gv[2], gv[3]); *(u32x2*)(Gb + o) = w; }
                asm volatile("" ::: "memory");
            }
        }
#pragma unroll
        for (int mt = 0; mt < 4; ++mt) { float bsum = bon[mt]; bsum += __shfl_xor(bsum, 16); bsum += __shfl_xor(bsum, 32); if (fq == 0) bonus[(size_t)(t0 + 16 * mt + fr) * 8 + h] = bsum; }
    }
}

DI void sgu_items(Frame& F, int first, int stride) {
    unsigned char* ws = F.ws; const int lane = F.lane, fr = lane & 15, fq = lane >> 4;
    const bf16* su = (const bf16*)(ws + WS_SU); bf16* mix = (bf16*)(ws + WS_MIX); const bf16* wsb = (const bf16*)(ws + WS_WSB);
    const float* sg1 = (const float*)(ws + WS_CTL) + 3 * T; const float* sg2 = sg1 + T; const float *lnw = F.in[15], *lnb = F.in[16], *bsp = F.in[18];
    unsigned char* vnT = F.lds + F.wid * 17408;
    for (int item = first; item < 1024; item += stride) {
        const int nb = item >> 3, g = item & 7; constexpr int KJ = 128;
        LDS_FENCE();
        { const int chunk = lane & 7, jp = lane >> 3;
          const f32x4 lw0 = *(const f32x4*)(lnw + 64 * g + 8 * chunk), lw1 = *(const f32x4*)(lnw + 64 * g + 8 * chunk + 4), lb0 = *(const f32x4*)(lnb + 64 * g + 8 * chunk), lb1 = *(const f32x4*)(lnb + 64 * g + 8 * chunk + 4);
          const float lwv[8] = {lw0[0], lw0[1], lw0[2], lw0[3], lw1[0], lw1[1], lw1[2], lw1[3]}, lbv[8] = {lb0[0], lb0[1], lb0[2], lb0[3], lb1[0], lb1[1], lb1[2], lb1[3]};
          u32x4 a0[8], a1[8]; float m0[8], m1[8], q0[8], q1[8];
#pragma unroll
          for (int it = 0; it < 8; ++it) if (it < KJ / 16) { const int tok = 128 * nb + 2 * (jp + 8 * it);
              a0[it] = *(const u32x4*)(su + (size_t)tok * 1024 + 512 + 64 * g + 8 * chunk); a1[it] = *(const u32x4*)(su + (size_t)(tok + 1) * 1024 + 512 + 64 * g + 8 * chunk);
              m0[it] = sg1[tok]; m1[it] = sg1[tok + 1]; q0[it] = sg2[tok]; q1[it] = sg2[tok + 1]; }
#pragma unroll
          for (int it = 0; it < 8; ++it) if (it < KJ / 16) { const int j = 2 * (jp + 8 * it);
              const float mm0 = m0[it] * (1.0f / 512), mm1 = m1[it] * (1.0f / 512);
              const float r0 = rsqrtf(fmaxf(q0[it] * (1.0f / 512) - mm0 * mm0, 0.f) + 1e-5f), r1 = rsqrtf(fmaxf(q1[it] * (1.0f / 512) - mm1 * mm1, 0.f) + 1e-5f);
#pragma unroll
              for (int e2 = 0; e2 < 4; ++e2) {
                  const float x0a = (bflo(a0[it][e2]) - mm0) * r0 * lwv[2 * e2] + lbv[2 * e2], x0b = (bfhi(a0[it][e2]) - mm0) * r0 * lwv[2 * e2 + 1] + lbv[2 * e2 + 1];
                  const float x1a = (bflo(a1[it][e2]) - mm1) * r1 * lwv[2 * e2] + lbv[2 * e2], x1b = (bfhi(a1[it][e2]) - mm1) * r1 * lwv[2 * e2 + 1] + lbv[2 * e2 + 1];
                  *(unsigned*)(vnT + (8 * chunk + 2 * e2) * 272 + j * 2) = pk2(x0a, x1a);
                  *(unsigned*)(vnT + (8 * chunk + 2 * e2 + 1) * 272 + j * 2) = pk2(x0b, x1b); } } }
        LDS_FENCE();
#pragma unroll 1
        for (int hf = 0; hf < 2; ++hf) {
        f32x4 acc[4][4];
#pragma unroll
        for (int a = 0; a < 4; ++a)
#pragma unroll
            for (int b = 0; b < 4; ++b) acc[a][b] = (f32x4){0.f, 0.f, 0.f, 0.f};
#pragma unroll
        for (int ks = 0; ks < 4; ++ks) if (ks < 2 * (hf + 1)) {
            bf16x8 bfv[4];
#pragma unroll
            for (int ct = 0; ct < 4; ++ct) bfv[ct] = *(const bf16x8*)(vnT + (16 * ct + fr) * 272 + (32 * ks + 8 * fq) * 2);
#pragma unroll
            for (int it = 0; it < 4; ++it) { const int i = 64 * hf + 16 * it + fr; const bf16x8 af = *(const bf16x8*)(wsb + (size_t)(g * 128 + i) * 128 + 32 * ks + 8 * fq);
#pragma unroll
                for (int ct = 0; ct < 4; ++ct) acc[it][ct] = MFMA16(bfv[ct], af, acc[it][ct]); } }
        u32x2 uu[4][4]; float bias[4];
#pragma unroll
        for (int it = 0; it < 4; ++it) { const int i = 64 * hf + 16 * it + fr, tok = 128 * nb + i; bias[it] = bsp[g * 128 + i];
#pragma unroll
            for (int ct = 0; ct < 4; ++ct) uu[it][ct] = *(const u32x2*)(su + (size_t)tok * 1024 + 64 * g + 16 * ct + 4 * fq); }
#pragma unroll
        for (int it = 0; it < 4; ++it) { const int i = 64 * hf + 16 * it + fr, tok = 128 * nb + i;
#pragma unroll
            for (int ct = 0; ct < 4; ++ct) { const int c = 64 * g + 16 * ct + 4 * fq; const u32x2 u2 = uu[it][ct];
                u32x2 w; w.x = pk2(bflo(u2.x) * (acc[it][ct][0] + bias[it]), bfhi(u2.x) * (acc[it][ct][1] + bias[it])); w.y = pk2(bflo(u2.y) * (acc[it][ct][2] + bias[it]), bfhi(u2.y) * (acc[it][ct][3] + bias[it]));
                *(u32x2*)(mix + (size_t)tok * 1024 + 512 + c) = w; } }
        }
    }
}

DI float dpp_x1(float v) { return __builtin_bit_cast(float, __builtin_amdgcn_update_dpp(0, __builtin_bit_cast(int, v), 0xB1, 0xF, 0xF, true)); }
DI float dpp_x2(float v) { return __builtin_bit_cast(float, __builtin_amdgcn_update_dpp(0, __builtin_bit_cast(int, v), 0x4E, 0xF, 0xF, true)); }
DI float dpp_hm(float v) { return __builtin_bit_cast(float, __builtin_amdgcn_update_dpp(0, __builtin_bit_cast(int, v), 0x141, 0xF, 0xF, true)); }
DI float red8(float p) { p += dpp_x1(p); p += dpp_x2(p); p += dpp_hm(p); return p; }
#define RED8X4(a, b, c, d) asm volatile("s_nop 1\n\t" \
    "v_add_f32_dpp %0, %0, %0 quad_perm:[1,0,3,2] row_mask:0xf bank_mask:0xf\n\tv_add_f32_dpp %1, %1, %1 quad_perm:[1,0,3,2] row_mask:0xf bank_mask:0xf\n\t" \
    "v_add_f32_dpp %2, %2, %2 quad_perm:[1,0,3,2] row_mask:0xf bank_mask:0xf\n\tv_add_f32_dpp %3, %3, %3 quad_perm:[1,0,3,2] row_mask:0xf bank_mask:0xf\n\t" \
    "v_add_f32_dpp %0, %0, %0 quad_perm:[2,3,0,1] row_mask:0xf bank_mask:0xf\n\tv_add_f32_dpp %1, %1, %1 quad_perm:[2,3,0,1] row_mask:0xf bank_mask:0xf\n\t" \
    "v_add_f32_dpp %2, %2, %2 quad_perm:[2,3,0,1] row_mask:0xf bank_mask:0xf\n\tv_add_f32_dpp %3, %3, %3 quad_perm:[2,3,0,1] row_mask:0xf bank_mask:0xf\n\t" \
    "v_add_f32_dpp %0, %0, %0 row_half_mirror row_mask:0xf bank_mask:0xf\n\tv_add_f32_dpp %1, %1, %1 row_half_mirror row_mask:0xf bank_mask:0xf\n\t" \
    "v_add_f32_dpp %2, %2, %2 row_half_mirror row_mask:0xf bank_mask:0xf\n\tv_add_f32_dpp %3, %3, %3 row_half_mirror row_mask:0xf bank_mask:0xf\n\ts_nop 1" \
    : "+v"(a), "+v"(b), "+v"(c), "+v"(d))
constexpr int SC = 16, NSC = LCH / SC, SARR = SC * 64, SBUF = 6 * SARR, SGRP = 2 * SBUF;
template <bool ISP> DI void scan1_chunk(const float* gl, float* gst, int NSCc, const float* G16, const float* KK, const float* Bb, const bf16* KPb, const bf16* Vb, const bf16* Rb,
                                         float* OUTY, int tb, int h, int gt, int srow0, int kg, f32x2 (&s)[4][4]) {
    const int lstep = gt >> 4, lc4 = (gt & 15) * 4;
    f32x4 lkk, lb; u32x2 lkp, lv, lr;
#define SCAN_LOAD(sc_) do { const size_t o_ = (size_t)(tb + (sc_) * SC + lstep) * RW + h * 64 + lc4; lkk = __builtin_nontemporal_load((const f32x4*)(KK + o_)); lb = __builtin_nontemporal_load((const f32x4*)(Bb + o_)); \
        lkp = __builtin_nontemporal_load((const u32x2*)(KPb + o_)); lv = *(const u32x2*)(Vb + o_); lr = __builtin_nontemporal_load((const u32x2*)(Rb + o_)); } while (0)
#define SCAN_STORE(b_) do { float* d_ = gst + (b_) * SBUF + lstep * 64 + lc4; *(f32x4*)(d_ + SARR) = lkk; *(f32x4*)(d_ + 2 * SARR) = lb; \
        *(f32x4*)(d_ + 3 * SARR) = (f32x4){bflo(lkp.x), bfhi(lkp.x), bflo(lkp.y), bfhi(lkp.y)}; *(f32x4*)(d_ + 4 * SARR) = (f32x4){bflo(lv.x), bfhi(lv.x), bflo(lv.y), bfhi(lv.y)}; \
        *(f32x4*)(d_ + 5 * SARR) = (f32x4){bflo(lr.x), bfhi(lr.x), bflo(lr.y), bfhi(lr.y)}; } while (0)
    __syncthreads();
    SCAN_LOAD(0); SCAN_STORE(0);
    __syncthreads();
    for (int sc = 0; sc < NSCc; ++sc) {
        const float* bf = gl + (sc & 1) * SBUF;
        if (sc + 1 < NSCc) SCAN_LOAD(sc + 1);
        const float* gp_ = G16 + (size_t)((tb >> 4) + sc) * RW + h * 64 + 8 * kg; const f32x4 gq0 = *(const f32x4*)gp_, gq1 = *(const f32x4*)(gp_ + 4);
#pragma unroll 2
        for (int st = 0; st < SC; ++st) {
            const float* p = bf + st * 64 + 8 * kg;
            const f32x4 k0 = *(const f32x4*)(p + SARR), k1 = *(const f32x4*)(p + SARR + 4), b0 = *(const f32x4*)(p + 2 * SARR), b1 = *(const f32x4*)(p + 2 * SARR + 4),
                        r0 = *(const f32x4*)(p + 5 * SARR), r1 = *(const f32x4*)(p + 5 * SARR + 4);
            const f32x2 k2[4] = {k0.xy, k0.zw, k1.xy, k1.zw}, b2[4] = {b0.xy, b0.zw, b1.xy, b1.zw}, r2[4] = {r0.xy, r0.zw, r1.xy, r1.zw};
            f32x2 q2[4]; f32x4 v4 = (f32x4){0.f, 0.f, 0.f, 0.f};
            if (!ISP) { const f32x4 q0 = *(const f32x4*)(p + 3 * SARR), q1 = *(const f32x4*)(p + 3 * SARR + 4); v4 = *(const f32x4*)(bf + 4 * SARR + st * 64 + srow0);
                q2[0] = q0.xy; q2[1] = q0.zw; q2[2] = q1.xy; q2[3] = q1.zw; }
            float pd[4], yd[4];
#pragma unroll
            for (int i = 0; i < 4; ++i) { f32x2 a = s[i][0] * k2[0]; a = s[i][1] * k2[1] + a; a = s[i][2] * k2[2] + a; a = s[i][3] * k2[3] + a; pd[i] = a.x + a.y; }
            RED8X4(pd[0], pd[1], pd[2], pd[3]);
#pragma unroll
            for (int i = 0; i < 4; ++i) { const f32x2 n2 = (f32x2){-pd[i], -pd[i]};
                if (ISP) {
#pragma unroll
                    for (int j = 0; j < 4; ++j) s[i][j] = s[i][j] + n2 * b2[j];
                } else { const f32x2 vv2 = (f32x2){v4[i], v4[i]};
#pragma unroll
                    for (int j = 0; j < 4; ++j) s[i][j] = vv2 * q2[j] + (n2 * b2[j] + s[i][j]);
                }
                f32x2 y = s[i][0] * r2[0]; y = s[i][1] * r2[1] + y; y = s[i][2] * r2[2] + y; y = s[i][3] * r2[3] + y; yd[i] = y.x + y.y; }
            RED8X4(yd[0], yd[1], yd[2], yd[3]);
            const f32x4 yv = (f32x4){yd[0], yd[1], yd[2], yd[3]};
            if (kg == 0) *(f32x4*)(OUTY + (size_t)(tb + sc * SC + st) * RW + h * 64 + srow0) = yv;
        }
        { const f32x2 g2[4] = {gq0.xy, gq0.zw, gq1.xy, gq1.zw};
#pragma unroll
          for (int i = 0; i < 4; ++i)
#pragma unroll
              for (int j = 0; j < 4; ++j) s[i][j] = s[i][j] * g2[j]; }
        if (sc + 1 < NSCc) SCAN_STORE((sc + 1) & 1);
        asm volatile("s_waitcnt lgkmcnt(0)" ::: "memory"); __builtin_amdgcn_s_barrier(); asm volatile("" ::: "memory");
    }
#undef SCAN_LOAD
#undef SCAN_STORE
}
DI void scan_pass1(Frame& F) {
    unsigned char* ws = F.ws; const int lane = F.lane, grp = F.wid >> 2, w4 = F.wid & 3, gt = F.tid & 255, rs = lane >> 3, kg = lane & 7;
    float* Wd = F.out; float* KK = F.out + (size_t)T * RW; const float* Bb = (const float*)(ws + WS_B); const float* G16 = (const float*)(ws + WS_G16);
    const bf16* Rb = (const bf16*)(ws + WS_R); const bf16* Vb = (const bf16*)(ws + WS_V); const bf16* KPb = (const bf16*)(ws + WS_KP);
    float* PT = (float*)(ws + WS_PT); float* SL = (float*)(ws + WS_SLOC);
    float* gl = (float*)F.lds + grp * SGRP;
    for (int pair0 = F.bid * 2; pair0 < NC * 8; pair0 += F.G * 2) {
        const int pair = pair0 + grp, c = pair >> 3, h = pair & 7, tb = c * LCH;
        const int vrow0 = 32 * ((w4 + 2 * grp) & 3) + 4 * rs;
        const bool isP = vrow0 < 64; const int srow0 = vrow0 & 63;
        f32x2 s[4][4];
#pragma unroll
        for (int i = 0; i < 4; ++i)
#pragma unroll
            for (int j = 0; j < 4; ++j) s[i][j] = (f32x2){(isP && (srow0 + i == 8 * kg + 2 * j)) ? 1.f : 0.f, (isP && (srow0 + i == 8 * kg + 2 * j + 1)) ? 1.f : 0.f};
        if (isP) {
            scan1_chunk<true>(gl, gl, NSC, G16, KK, Bb, KPb, Vb, Rb, Wd, tb, h, gt, srow0, kg, s);
#pragma unroll
            for (int j = 0; j < 8; ++j) *(f32x4*)(PT + ((size_t)(c * 8 + h) * 64 + 8 * kg + j) * 64 + srow0) = (f32x4){s[0][j >> 1][j & 1], s[1][j >> 1][j & 1], s[2][j >> 1][j & 1], s[3][j >> 1][j & 1]};
        } else {
            scan1_chunk<false>(gl, gl, NSC, G16, KK, Bb, KPb, Vb, Rb, KK, tb, h, gt, srow0, kg, s);
#pragma unroll
            for (int i = 0; i < 4; ++i) { float* sp = SL + ((size_t)(c * 8 + h) * 64 + srow0 + i) * 64 + 8 * kg;
                *(f32x4*)sp = (f32x4){s[i][0].x, s[i][0].y, s[i][1].x, s[i][1].y}; *(f32x4*)(sp + 4) = (f32x4){s[i][2].x, s[i][2].y, s[i][3].x, s[i][3].y}; }
        }
    }
}
DI void split8(const f32x4& x0, const f32x4& x1, bf16x8& hi, bf16x8& lo) {
    unsigned hb[8], lb[8];
#pragma unroll
    for (int e = 0; e < 8; ++e) { const float x = e < 4 ? x0[e & 3] : x1[e & 3]; hb[e] = __float_as_uint(x) & 0xffff0000u; lb[e] = __float_as_uint(x - __uint_as_float(hb[e])); }
    u32x4 h, l;
#pragma unroll
    for (int p = 0; p < 4; ++p) { h[p] = (hb[2 * p] >> 16) | hb[2 * p + 1]; l[p] = (lb[2 * p] >> 16) | (lb[2 * p + 1] & 0xffff0000u); }
    hi = __builtin_bit_cast(bf16x8, h); lo = __builtin_bit_cast(bf16x8, l);
}
DI void scan_pass3(Frame& F) {
    unsigned char* ws = F.ws; const int lane = F.lane, grp = F.wid >> 2, w4 = F.wid & 3, fr = lane & 15, fq = lane >> 4;
    const float* QT = F.out; const float* YL = F.out + (size_t)T * RW; const float* SST = (const float*)(ws + WS_SST);
    const bf16* Vb = (const bf16*)(ws + WS_V); const bf16* Gb = (const bf16*)(ws + WS_G); const float* bonus = (const float*)(ws + WS_BON); bf16* mix = (bf16*)(ws + WS_MIX);
    const float *lnxw = F.in[13], *lnxb = F.in[14];
    for (int pair0 = F.bid * 2; pair0 < NC * 8; pair0 += F.G * 2) {
        const int pair = pair0 + grp, c = pair >> 3, h = pair & 7, tb = c * LCH;
        f32x4 sst[4][4];
#pragma unroll
        for (int vt = 0; vt < 4; ++vt)
#pragma unroll
            for (int g4 = 0; g4 < 4; ++g4) sst[vt][g4] = *(const f32x4*)(SST + ((size_t)(c * 8 + h) * 64 + 16 * vt + fr) * 64 + 16 * g4 + 4 * fq);
        bf16x8 ah[4][2], al[4][2];
#pragma unroll
        for (int vt = 0; vt < 4; ++vt)
#pragma unroll
            for (int s2 = 0; s2 < 2; ++s2) split8(sst[vt][2 * s2], sst[vt][2 * s2 + 1], ah[vt][s2], al[vt][s2]);
#pragma unroll 1
        for (int tt = 0; tt < LCH / 64; ++tt) {
            const int t = tb + 16 * (w4 * (LCH / 64) + tt) + fr; const size_t o = (size_t)t * RW + h * 64;
            f32x4 q[4], acc[4]; u32x2 v2a[4], g2a[4];
#pragma unroll
            for (int g4 = 0; g4 < 4; ++g4) { q[g4] = __builtin_nontemporal_load((const f32x4*)(QT + o + 16 * g4 + 4 * fq)); acc[g4] = __builtin_nontemporal_load((const f32x4*)(YL + o + 16 * g4 + 4 * fq)); }
#pragma unroll
            for (int g4 = 0; g4 < 4; ++g4) { v2a[g4] = __builtin_nontemporal_load((const u32x2*)(Vb + o + 16 * g4 + 4 * fq)); g2a[g4] = __builtin_nontemporal_load((const u32x2*)(Gb + o + 16 * g4 + 4 * fq)); }
            const float bo = bonus[(size_t)t * 8 + h];
            bf16x8 bh[2], bl[2];
#pragma unroll
            for (int s2 = 0; s2 < 2; ++s2) split8(q[2 * s2], q[2 * s2 + 1], bh[s2], bl[s2]);
#pragma unroll
            for (int vt = 0; vt < 4; ++vt)
#pragma unroll
                for (int s2 = 0; s2 < 2; ++s2) { acc[vt] = MFMA16(ah[vt][s2], bh[s2], acc[vt]); acc[vt] = MFMA16(ah[vt][s2], bl[s2], acc[vt]); acc[vt] = MFMA16(al[vt][s2], bh[s2], acc[vt]); }
            float sm = 0.f;
#pragma unroll
            for (int vt = 0; vt < 4; ++vt) sm += (acc[vt][0] + acc[vt][1]) + (acc[vt][2] + acc[vt][3]);
            sm += __shfl_xor(sm, 16); sm += __shfl_xor(sm, 32);
            const float mean = sm * (1.0f / 64); float qq = 0.f;
#pragma unroll
            for (int vt = 0; vt < 4; ++vt) { acc[vt] = acc[vt] - mean; qq += (acc[vt][0] * acc[vt][0] + acc[vt][1] * acc[vt][1]) + (acc[vt][2] * acc[vt][2] + acc[vt][3] * acc[vt][3]); }
            qq += __shfl_xor(qq, 16); qq += __shfl_xor(qq, 32);
            const float rstd = rsqrtf(qq * (1.0f / 64) + 64e-5f);
#pragma unroll
            for (int vt = 0; vt < 4; ++vt) { const int c4 = 16 * vt + 4 * fq; const f32x4 lw4 = *(const f32x4*)(lnxw + h * 64 + c4), lb4 = *(const f32x4*)(lnxb + h * 64 + c4);
                const u32x2 v2 = v2a[vt], g2 = g2a[vt];
                const float vv[4] = {bflo(v2.x), bfhi(v2.x), bflo(v2.y), bfhi(v2.y)}, gg[4] = {bflo(g2.x), bfhi(g2.x), bflo(g2.y), bfhi(g2.y)}; float o4[4];
#pragma unroll
                for (int e = 0; e < 4; ++e) o4[e] = (acc[vt][e] * rstd * lw4[e] + lb4[e] + bo * vv[e]) * gg[e];
                u32x2 w; w.x = pk2(o4[0], o4[1]); w.y = pk2(o4[2], o4[3]); *(u32x2*)(mix + (size_t)t * 1024 + h * 64 + c4) = w; }
        }
    }
}
DI void scan_pass2(Frame& F, int task, int jt, float* xch, bool active) {
    unsigned char* ws = F.ws; const int lane = F.lane, fr = lane & 15, fq = lane >> 4, h = task >> 2, ib = task & 3;
    const float* PT = (const float*)(ws + WS_PT); const float* SL = (const float*)(ws + WS_SLOC); float* SST = (float*)(ws + WS_SST);
    f32x4 S[4];
#pragma unroll
    for (int j = 0; j < 4; ++j) S[j] = (f32x4){0.f, 0.f, 0.f, 0.f};
    f32x4 pv0[4], pv1[4], pv2[4], nl0, nl1, nl2, own = (f32x4){0.f, 0.f, 0.f, 0.f};
#define P2_LOAD(c_, PV, NL) do { const int cc_ = (c_) < NC - 1 ? (c_) : NC - 2; const size_t m_ = (size_t)(cc_ * 8 + h) * 4096; NL = *(const f32x4*)(SL + m_ + (16 * ib + fr) * 64 + 16 * jt + 4 * fq); \
        _Pragma("unroll") for (int t4 = 0; t4 < 4; ++t4) PV[t4] = *(const f32x4*)(PT + m_ + (16 * jt + fr) * 64 + 16 * t4 + 4 * fq); } while (0)
#define P2_STEP(c_, PV, NL) do { *(f32x4*)(SST + (size_t)((c_) * 8 + h) * 4096 + (16 * ib + fr) * 64 + 16 * jt + 4 * fq) = own; \
        _Pragma("unroll") for (int t4 = 0; t4 < 4; ++t4) _Pragma("unroll") for (int rg = 0; rg < 4; ++rg) NL = __builtin_amdgcn_mfma_f32_16x16x4f32(PV[t4][rg], S[t4][rg], NL, 0, 0, 0); \
        float* xb_ = xch + ((c_) & 1) * 1024; own = NL; *(f32x4*)(xb_ + jt * 256 + lane * 4) = NL; \
        P2_LOAD((c_) + 3, PV, NL); \
        asm volatile("s_waitcnt lgkmcnt(0)" ::: "memory"); __builtin_amdgcn_s_barrier(); asm volatile("" ::: "memory"); \
        _Pragma("unroll") for (int j = 0; j < 4; ++j) S[j] = *(const f32x4*)(xb_ + j * 256 + lane * 4); } while (0)
    static_assert((NC - 1) % 3 == 0, "pass 2 is unrolled by 3");
    if (!active) { for (int c = 0; c < NC - 1; ++c) { asm volatile("s_waitcnt lgkmcnt(0)" ::: "memory"); __builtin_amdgcn_s_barrier(); asm volatile("" ::: "memory"); } return; }
    P2_LOAD(0, pv0, nl0); P2_LOAD(1, pv1, nl1); P2_LOAD(2, pv2, nl2);
    for (int c = 0; c < NC - 1; c += 3) { P2_STEP(c, pv0, nl0); P2_STEP(c + 1, pv1, nl1); P2_STEP(c + 2, pv2, nl2); }
    *(f32x4*)(SST + (size_t)((NC - 1) * 8 + h) * 4096 + (16 * ib + fr) * 64 + 16 * jt + 4 * fq) = own;
#undef P2_STEP
#undef P2_LOAD
}


#ifndef MK_PER_PHASE
#define MK_PER_PHASE 0
#endif
constexpr int NPHASES = 12;
typedef KArgs Args;
static_assert(sizeof(Args) == 33 * 8 + 8, "no padding");

__global__ void __launch_bounds__(NTHR, 2) hybrid_fwd(Args args) {
    extern __shared__ __attribute__((aligned(16))) unsigned char lds[];
    cg::grid_group grid = cg::this_grid();
    Frame F;
    F.lds = lds; F.tid = threadIdx.x; F.lane = F.tid & 63; F.wid = __builtin_amdgcn_readfirstlane(F.tid >> 6); F.bid = blockIdx.x; F.G = gridDim.x;
    F.in.ka = (const __attribute__((address_space(4))) KArgs*)__builtin_amdgcn_kernarg_segment_ptr();
    F.out = args.out; F.ws = args.ws;
    unsigned char* ws = args.ws;
    PG8_LAS unsigned char* glds = (PG8_LAS unsigned char*)lds;
    float* ctl = (float*)(ws + WS_CTL); float *ss1 = ctl, *ss2 = ctl + T, *ss3 = ctl + 2 * T, *sg1 = ctl + 3 * T, *sg2 = ctl + 4 * T;
    const int lo = args.ph_lo, hi = args.ph_hi;
    const float rone = F.G > (1 << 20) ? 2.0f : 1.0f;
    volatile LAS unsigned* MISC = (volatile LAS unsigned*)(glds + LDS_BYTES - 64);
    if (F.tid < 16) MISC[F.tid] = 0u;
    __syncthreads();
    XcdBarrier bar = xcd_barrier_post((unsigned*)(ws + WS_CTL + 768 * KiB), MISC);
#ifndef PHMASK
#define PHMASK 0xfff
#endif
#define IN(k) (((PHMASK >> (k)) & 1) && lo <= (k) && (k) < hi)
#define SEAM(k) do { if ((k) + 1 < hi) { if (hi > NPHASES) grid.sync(); else xcd_barrier(bar); } } while (0)
#ifndef DBLMASK
#define DBLMASK 0
#endif
#define REPS(k) for (int rep = 0; rep < (((DBLMASK >> (k)) & 1) ? 2 : 1); ++rep)
    float* dummy = ctl + 8 * T;

    if (IN(0)) { REPS(0) p0_prologue(F); SEAM(0); }
    if (IN(1)) {
        REPS(1) { pg8::Gemm g{(const bf16*)(ws + WS_XB), (const bf16*)(ws + WS_WIN), T, NIN, D}; pg8::StaticOrder S; S.init(T, NIN, F.G, F.bid);
          fill_rs_table(F, T / 256, NIN / 256, (const float*)(ws + WS_RS0), false);
          EpiZ E{(bf16*)(ws + WS_ZR), (bf16*)(ws + WS_SU), (const float*)(F.lds + RS_TAB_OFF), rep ? dummy : sg1, rep ? dummy + T : sg2};
          pg8::gemm_phase<EpiZ, pg8::StaticOrder>(glds, g, S, E, nullptr); }
        { const int lb = F.bid - 192;
          if (lb >= 0 && lb < 56) tr_run(F, lb * NWAVES + F.wid, 56 * NWAVES, TR_LATE0, TR_DN0 - TR_LATE0, 1 << 30, 0); }
        { const int b = F.bid - (F.G - 8); const bool isk = b >= 0 && b < 4, isv = b >= 4 && b < 8;
          if (isk) { pg8::Gemm g{(const bf16*)(ws + WS_MB), (const bf16*)(ws + WS_WK), MEM, D, D}; FewOrder S{0, b, true}; EpiBf E{(bf16*)(ws + WS_KB), 256, nullptr, rone, 256 * 256};
              pg8::gemm_phase<EpiBf, FewOrder>(glds, g, S, E, nullptr); }
          if (isv) { pg8::Gemm g{(const bf16*)(ws + WS_MB), (const bf16*)(ws + WS_WV), MEM, D, D}; FewOrder S{0, b - 4, true}; EpiBf E{(bf16*)(ws + WS_VT), 256, nullptr, rone, 256 * 256};
              pg8::gemm_phase<EpiBf, FewOrder>(glds, g, S, E, nullptr); } }
        SEAM(1); }
    if (IN(2)) { REPS(2) prep_phase(F); SEAM(2); }
    if (IN(3)) { REPS(3) scan_pass1(F); SEAM(3); }
    if (IN(4)) {
        REPS(4) { if (F.bid < 32) scan_pass2(F, F.bid, F.wid & 3, (float*)F.lds, F.wid < 4);
        else if (F.bid < 48) {
            const int fu = F.bid - 32, fh = fu >> 2, fpm = fu & 3;
            pg8::Gemm g{(const bf16*)(ws + WS_WOTH) + (size_t)fh * D * 256, (const bf16*)(ws + WS_VT) + (size_t)fh * 256 * 256, D, 256, 256}; FewOrder S{fpm, 0, true};
            EpiBf E{(bf16*)(ws + WS_WO) + fh * 256, D, nullptr, rone};
            pg8::gemm_phase<EpiBf, FewOrder>(glds, g, S, E, nullptr); }
        else if (F.bid < 64) {
            const int fu = F.bid - 48, fh = fu >> 2, fpn = fu & 3;
            pg8::Gemm g{(const bf16*)(ws + WS_KB) + (size_t)fh * 256 * 256, (const bf16*)(ws + WS_WQ) + (size_t)fh * D * 256, 256, D, 256}; FewOrder S{0, fpn, true};
            EpiBf E{(bf16*)(ws + WS_WK) + (size_t)fh * 256 * D, D, nullptr, rone};
            pg8::gemm_phase<EpiBf, FewOrder>(glds, g, S, E, nullptr); }
        else sgu_items(F, (F.bid - 64) * NWAVES + F.wid, (F.G - 64) * NWAVES); }
        SEAM(4); }
    if (IN(5)) { REPS(5) scan_pass3(F); SEAM(5); }
    if (IN(6)) {
        REPS(6) { pg8::Gemm g{(const bf16*)(ws + WS_MIX), (const bf16*)(ws + WS_WOUT), T, D, D}; pg8::StaticOrder S; S.init(T, D, F.G, F.bid);
        EpiRes E{F.in[0], nullptr, (bf16*)(ws + WS_XB), rep ? dummy : ss1};
        pg8::gemm_phase<EpiRes, pg8::StaticOrder>(glds, g, S, E, nullptr); } SEAM(6); }
    if (IN(7)) {
        pg8::Gemm g{(const bf16*)(ws + WS_XB), (const bf16*)(ws + WS_WK), T, D, D}; pg8::StaticOrder S; S.init(T, D, F.G, F.bid);
        EpiSoftmax E{(bf16*)(ws + WS_OB), ss1};
        pg8::gemm_phase<EpiSoftmax, pg8::StaticOrder>(glds, g, S, E, nullptr); SEAM(7); }
    if (IN(9)) {
        pg8::Gemm g{(const bf16*)(ws + WS_OB), (const bf16*)(ws + WS_WO), T, D, D}; pg8::StaticOrder S; S.init(T, D, F.G, F.bid);
        EpiRes E{nullptr, (const bf16*)(ws + WS_XB), (bf16*)(ws + WS_XB), ss2};
        pg8::gemm_phase<EpiRes, pg8::StaticOrder>(glds, g, S, E, nullptr); SEAM(9); }
    if (IN(10)) {
        pg8::Gemm g{(const bf16*)(ws + WS_XB), (const bf16*)(ws + WS_WGU), T, 2 * FF, D}; pg8::StaticOrder S; S.init(T, 2 * FF, F.G, F.bid);
        fill_rs_table(F, T / 256, 2 * FF / 256, ss2, true);
        EpiSwi E{(bf16*)(ws + WS_HFF), (const float*)(F.lds + RS_TAB_OFF)};
        REPS(10) pg8::gemm_phase<EpiSwi, pg8::StaticOrder>(glds, g, S, E, nullptr);
        if (F.bid >= 128) tr_run(F, (F.bid - 128) * NWAVES + F.wid, (F.G - 128) * NWAVES, TR_DN0, TR_I_DN, 1 << 30, 0);
        SEAM(10); }
    if (IN(11)) {
        pg8::Gemm g{(const bf16*)(ws + WS_HFF), (const bf16*)(ws + WS_WD), T, D, FF}; pg8::StaticOrder S; S.init(T, D, F.G, F.bid);
        EpiFinal E{(const bf16*)(ws + WS_XB), F.out, ss3, (unsigned*)(ctl + 10 * T), F.in[30]};
        pg8::gemm_phase<EpiFinal, pg8::StaticOrder>(glds, g, S, E, nullptr); }
#ifdef SYNCX
    for (int i = 0; i < SYNCX; ++i) xcd_barrier(bar);
#endif
#undef IN
#undef SEAM
}

extern "C" void kernel_launch(void* const* d_in, const int* in_sizes, int n_in, void* d_out, int out_size, void* d_ws, size_t ws_size, hipStream_t stream) {
    static int grid = 0;
    if (grid == 0) {
        if (n_in != 31 || in_sizes[0] != T * D || out_size != T * D || ws_size < WS_END) { fprintf(stderr, "kernel_launch: unexpected shapes (n_in %d, in0 %d, out %d, ws %zu)\n", n_in, n_in > 0 ? in_sizes[0] : -1, out_size, ws_size); grid = -1; return; }
        int dev = 0, cus = 0, per_cu = 0;
        if (hipGetDevice(&dev) != hipSuccess || hipDeviceGetAttribute(&cus, hipDeviceAttributeMultiprocessorCount, dev) != hipSuccess) { grid = -1; return; }
        if (hipFuncSetAttribute((const void*)hybrid_fwd, hipFuncAttributeMaxDynamicSharedMemorySize, LDS_BYTES) != hipSuccess) { fprintf(stderr, "kernel_launch: hipFuncSetAttribute failed\n"); grid = -1; return; }
        if (hipOccupancyMaxActiveBlocksPerMultiprocessor(&per_cu, (const void*)hybrid_fwd, NTHR, LDS_BYTES) != hipSuccess || per_cu < 1) { fprintf(stderr, "kernel_launch: occupancy query says %d blocks per CU\n", per_cu); per_cu = 1; }
        (void)hipGetLastError();
        grid = cus * per_cu;
    }
    if (grid < 0) return;
    if (hipMemsetAsync((char*)d_ws + WS_CTL, 0, CTL_BYTES, stream) != hipSuccess) { fprintf(stderr, "kernel_launch: memset failed\n"); return; }
    Args a{};
    for (int i = 0; i < 31; ++i) a.in[i] = (const float*)d_in[i];
    a.out = (float*)d_out; a.ws = (unsigned char*)d_ws;
#if MK_PER_PHASE
    for (int p = 0; p < NPHASES; ++p) { a.ph_lo = p; a.ph_hi = p + 1; hipLaunchKernelGGL(hybrid_fwd, dim3(grid), dim3(NTHR), LDS_BYTES, stream, a); }
#else
    a.ph_lo = 0; a.ph_hi = NPHASES;
    void* kargs[] = {&a};
    hipError_t e = hipLaunchCooperativeKernel((const void*)hybrid_fwd, dim3(grid), dim3(NTHR), kargs, LDS_BYTES, stream);
    if (e != hipSuccess) fprintf(stderr, "kernel_launch: cooperative launch failed: %s (grid %d)\n", hipGetErrorString(e), grid);
#endif
}
```
